# Optimizing an MI355X kernel written in HIP

```python
import jax, jax.numpy as jnp
from jax import lax
import numpy as np

D_MODEL = 1024
BATCH = 2
SEQ = 8192
DEPTH = 2

MEM_LEN = 256
HEAD_DIM = D_MODEL // 16
H_NA = 6
H_DIL = 6
H_MEM = 4
W_NA = H_NA * HEAD_DIM
W_DIL = H_DIL * HEAD_DIM
W_MEM = H_MEM * HEAD_DIM
MIX_WIDTH = W_NA + W_DIL + W_MEM
IN_WIDTH = 3 * W_NA + 3 * W_DIL + W_MEM
GRID_W = 64
NA_KH = 8
NA_KW = 16
NA_QROWS = 2
RPB_H = 2 * NA_KH - 1
RPB_W = 2 * NA_KW - 1
DIL_CFG = ((128, 1), (512, 4), (2048, 16))
DIL_QBLOCK = 128
ROPE_THETA = 10000.0
D_FF = 2816
N_EXPERTS = 8
TOP_K = 2
D_FF_EXPERT = 3584
MOE_BLOCK = 256
N_DENSE = (DEPTH + 1) // 2
N_MOE = DEPTH // 2
RMS_EPS = 1e-6
NEG_INF = -1e30

kernel_name = "hybrid_na_dilated_mem_moe_encoder"


def rms_norm(x, g):
    xf = x.astype(jnp.float32)
    y = xf * lax.rsqrt(jnp.mean(xf * xf, axis=-1, keepdims=True) + RMS_EPS)
    return (y * g.astype(jnp.float32)).astype(x.dtype)


def apply_rope(x):
    T = x.shape[1]
    half = HEAD_DIM // 2
    inv_freq = jnp.power(ROPE_THETA, -(2.0 / HEAD_DIM) * jnp.arange(half, dtype=jnp.float32))
    ang = jnp.arange(T, dtype=jnp.float32)[:, None] * inv_freq[None, :]
    cos = jnp.cos(ang)[None, :, None, :]
    sin = jnp.sin(ang)[None, :, None, :]
    xf = x.astype(jnp.float32)
    x1, x2 = xf[..., :half], xf[..., half:]
    return jnp.concatenate([x1 * cos - x2 * sin, x1 * sin + x2 * cos], axis=-1).astype(x.dtype)


def neighborhood_attention(q, k, v, rpb):
    B, T, H, Dh = q.shape
    rows = T // GRID_W
    kh = min(NA_KH, rows)
    kw = NA_KW
    r = jnp.arange(rows, dtype=jnp.int32)
    row_idx = jnp.clip(r - kh // 2, 0, rows - kh)[:, None] + jnp.arange(kh, dtype=jnp.int32)[None, :]
    c = jnp.arange(GRID_W, dtype=jnp.int32)
    col_idx = jnp.clip(c - kw // 2, 0, GRID_W - kw)[:, None] + jnp.arange(kw, dtype=jnp.int32)[None, :]
    row_rel = row_idx - r[:, None] + (NA_KH - 1)
    col_rel = col_idx - c[:, None] + (NA_KW - 1)
    tok_idx = row_idx[:, None, :, None] * GRID_W + col_idx[None, :, None, :]
    bias_idx = row_rel[:, None, :, None] * RPB_W + col_rel[None, :, None, :]
    rpb_flat = rpb.reshape(H, RPB_H * RPB_W)
    qg = q.reshape(B, rows, GRID_W, H, Dh)
    scale = Dh ** -0.5
    n_blk = rows // NA_QROWS
    tok_blocks = tok_idx.reshape(n_blk, NA_QROWS, GRID_W, kh, kw)
    bias_blocks = bias_idx.reshape(n_blk, NA_QROWS, GRID_W, kh, kw)
    q_blocks = jnp.moveaxis(qg.reshape(B, n_blk, NA_QROWS, GRID_W, H, Dh), 1, 0)

    def row_block(args):
        q_blk, ti, bi = args
        k_nb = jnp.take(k, ti, axis=1)
        v_nb = jnp.take(v, ti, axis=1)
        logits = jnp.einsum('brchd,brcijhd->bhrcij', q_blk, k_nb).astype(jnp.float32) * scale
        bias = jnp.take(rpb_flat, bi, axis=1)
        logits = logits + bias[None].astype(jnp.float32)
        shp = logits.shape
        p = jax.nn.softmax(logits.reshape(shp[:4] + (kh * kw,)), axis=-1).reshape(shp)
        return jnp.einsum('bhrcij,brcijhd->brchd', p.astype(v.dtype), v_nb)

    outs = lax.map(row_block, (q_blocks, tok_blocks, bias_blocks))
    return jnp.moveaxis(outs, 0, 1).reshape(B, T, H, Dh)


def dilated_mixture_attention(q, k, v):
    B, T, H, Dh = q.shape
    scale = Dh ** -0.5
    offsets = []
    for w, d in DIL_CFG:
        n_side = (w // 2) // d
        offsets.append(d * jnp.arange(-n_side, n_side + 1, dtype=jnp.int32))
    n_blk = T // DIL_QBLOCK
    q_blocks = jnp.moveaxis(q.reshape(B, n_blk, DIL_QBLOCK, H, Dh), 1, 0)
    starts = jnp.arange(n_blk, dtype=jnp.int32) * DIL_QBLOCK

    def q_block(args):
        q_blk, t0 = args
        t = t0 + jnp.arange(DIL_QBLOCK, dtype=jnp.int32)
        outs, lses = [], []
        for off in offsets:
            pos = t[:, None] + off[None, :]
            valid = (pos >= 0) & (pos < T)
            pc = jnp.clip(pos, 0, T - 1)
            kk = jnp.take(k, pc, axis=1)
            vv = jnp.take(v, pc, axis=1)
            s = jnp.einsum('bqhd,bqkhd->bhqk', q_blk, kk).astype(jnp.float32) * scale
            s = jnp.where(valid[None, None], s, NEG_INF)
            m = jnp.max(s, axis=-1, keepdims=True)
            p = jnp.exp(s - m)
            l = jnp.sum(p, axis=-1, keepdims=True)
            o = jnp.einsum('bhqk,bqkhd->bhqd', (p / l).astype(v.dtype), vv)
            outs.append(o.astype(jnp.float32))
            lses.append((m + jnp.log(l))[..., 0])
        wts = jax.nn.softmax(jnp.stack(lses), axis=0)
        o = jnp.sum(wts[..., None] * jnp.stack(outs), axis=0)
        return jnp.transpose(o, (0, 2, 1, 3)).astype(q.dtype)

    outs = lax.map(q_block, (q_blocks, starts))
    return jnp.moveaxis(outs, 0, 1).reshape(B, T, H, Dh)


def memory_attention(q, km, vm):
    s = jnp.einsum('bthd,bmhd->bhtm', q, km).astype(jnp.float32) * (HEAD_DIM ** -0.5)
    p = jax.nn.softmax(s, axis=-1)
    return jnp.einsum('bhtm,bmhd->bthd', p.astype(vm.dtype), vm)


def swiglu(x, w_gate, w_up, w_down):
    return (jax.nn.silu(x @ w_gate) * (x @ w_up)) @ w_down


def moe_swiglu(x, w_router, w_gate, w_up, w_down):
    B, T, D = x.shape
    N = B * T
    NK = N * TOP_K
    xf = x.reshape(N, D)
    logits = (xf @ w_router).astype(jnp.float32)
    top_logit, top_idx = lax.top_k(logits, TOP_K)
    gates = jax.nn.softmax(top_logit, axis=-1)
    e_flat = top_idx.reshape(NK).astype(jnp.int32)
    tok_flat = jnp.broadcast_to(jnp.arange(N, dtype=jnp.int32)[:, None], (N, TOP_K)).reshape(NK)
    g_flat = gates.reshape(NK)
    order = jnp.argsort(e_flat)
    e_s = e_flat[order]
    tok_s = tok_flat[order]
    g_s = g_flat[order]
    counts = jnp.sum((e_flat[:, None] == jnp.arange(N_EXPERTS, dtype=jnp.int32)[None, :]).astype(jnp.int32), axis=0)
    padded = (counts + MOE_BLOCK - 1) // MOE_BLOCK * MOE_BLOCK
    start = jnp.cumsum(counts) - counts
    pend = jnp.cumsum(padded)
    pstart = pend - padded
    dest = pstart[e_s] + (jnp.arange(NK, dtype=jnp.int32) - start[e_s])
    P = NK + N_EXPERTS * MOE_BLOCK
    row_tok = jnp.full((P,), N, jnp.int32).at[dest].set(tok_s)
    row_gate = jnp.zeros((P,), jnp.float32).at[dest].set(g_s)
    n_blk = P // MOE_BLOCK
    blk_start = jnp.arange(n_blk, dtype=jnp.int32) * MOE_BLOCK
    blk_expert = jnp.minimum(
        jnp.sum((blk_start[:, None] >= pend[None, :]).astype(jnp.int32), axis=1),
        N_EXPERTS - 1)
    x_pad = jnp.concatenate([xf, jnp.zeros((1, D), xf.dtype)], axis=0)
    x_rows = jnp.take(x_pad, row_tok, axis=0).reshape(n_blk, MOE_BLOCK, D)

    def expert_block(args):
        xb, e = args
        return swiglu(xb, w_gate[e], w_up[e], w_down[e])

    y = lax.map(expert_block, (x_rows, blk_expert)).reshape(P, D)
    y = y * row_gate[:, None].astype(y.dtype)
    out = jax.ops.segment_sum(y, row_tok, num_segments=N + 1)[:N]
    return out.reshape(B, T, D)


def setup_inputs(seed: int = 0) -> dict:
    key = jax.random.key(seed)
    ks = jax.random.split(key, 24)
    f32 = jnp.float32

    def nrm(k, shape, scale):
        return jax.random.normal(k, shape, f32) * scale

    def gain(k, shape):
        return 1.0 + 0.05 * jax.random.normal(k, shape, f32)

    return {
        "x": nrm(ks[0], (BATCH, SEQ, D_MODEL), 1.0),
        "mem": nrm(ks[1], (BATCH, MEM_LEN, D_MODEL), 1.0),
        "g_attn": gain(ks[2], (DEPTH, D_MODEL)),
        "w_in": nrm(ks[3], (DEPTH, D_MODEL, IN_WIDTH), D_MODEL ** -0.5),
        "g_qk_na": gain(ks[4], (DEPTH, 2, HEAD_DIM)),
        "rpb_na": nrm(ks[5], (DEPTH, H_NA, RPB_H, RPB_W), 0.1),
        "g_qk_dil": gain(ks[6], (DEPTH, 2, HEAD_DIM)),
        "g_mem": gain(ks[7], (DEPTH, D_MODEL)),
        "w_mem_kv": nrm(ks[8], (DEPTH, D_MODEL, 2 * W_MEM), D_MODEL ** -0.5),
        "g_qk_mem": gain(ks[9], (DEPTH, 2, HEAD_DIM)),
        "g_out": gain(ks[10], (DEPTH, MIX_WIDTH)),
        "w_out": nrm(ks[11], (DEPTH, MIX_WIDTH, D_MODEL), MIX_WIDTH ** -0.5),
        "g_ffn": gain(ks[12], (DEPTH, D_MODEL)),
        "w_gate_dense": nrm(ks[13], (N_DENSE, D_MODEL, D_FF), D_MODEL ** -0.5),
        "w_up_dense": nrm(ks[14], (N_DENSE, D_MODEL, D_FF), D_MODEL ** -0.5),
        "w_down_dense": nrm(ks[15], (N_DENSE, D_FF, D_MODEL), D_FF ** -0.5),
        "w_router": nrm(ks[16], (N_MOE, D_MODEL, N_EXPERTS), D_MODEL ** -0.5),
        "w_gate_moe": nrm(ks[17], (N_MOE, N_EXPERTS, D_MODEL, D_FF_EXPERT), D_MODEL ** -0.5),
        "w_up_moe": nrm(ks[18], (N_MOE, N_EXPERTS, D_MODEL, D_FF_EXPERT), D_MODEL ** -0.5),
        "w_down_moe": nrm(ks[19], (N_MOE, N_EXPERTS, D_FF_EXPERT, D_MODEL), D_FF_EXPERT ** -0.5),
    }


def reference(x, mem, g_attn, w_in, g_qk_na, rpb_na, g_qk_dil, g_mem, w_mem_kv, g_qk_mem,
              g_out, w_out, g_ffn, w_gate_dense, w_up_dense, w_down_dense, w_router,
              w_gate_moe, w_up_moe, w_down_moe):
    B, T, _ = x.shape
    M = mem.shape[1]
    o1 = W_NA
    o2 = 2 * W_NA
    o3 = 3 * W_NA
    o4 = o3 + W_DIL
    o5 = o3 + 2 * W_DIL
    o6 = o3 + 3 * W_DIL
    h = x
    for layer in range(DEPTH):
        u = rms_norm(h, g_attn[layer])
        proj = u @ w_in[layer]
        qa = proj[..., :o1]
        ka = proj[..., o1:o2]
        va = proj[..., o2:o3]
        qb = proj[..., o3:o4]
        kb = proj[..., o4:o5]
        vb = proj[..., o5:o6]
        qm = proj[..., o6:]

        qa = rms_norm(qa.reshape(B, T, H_NA, HEAD_DIM), g_qk_na[layer, 0])
        ka = rms_norm(ka.reshape(B, T, H_NA, HEAD_DIM), g_qk_na[layer, 1])
        va = va.reshape(B, T, H_NA, HEAD_DIM)
        o_na = neighborhood_attention(qa, ka, va, rpb_na[layer])

        qb = apply_rope(rms_norm(qb.reshape(B, T, H_DIL, HEAD_DIM), g_qk_dil[layer, 0]))
        kb = apply_rope(rms_norm(kb.reshape(B, T, H_DIL, HEAD_DIM), g_qk_dil[layer, 1]))
        vb = vb.reshape(B, T, H_DIL, HEAD_DIM)
        o_dil = dilated_mixture_attention(qb, kb, vb)

        mem_n = rms_norm(mem, g_mem[layer])
        kv_m = mem_n @ w_mem_kv[layer]
        km = rms_norm(kv_m[..., :W_MEM].reshape(B, M, H_MEM, HEAD_DIM), g_qk_mem[layer, 1])
        vm = kv_m[..., W_MEM:].reshape(B, M, H_MEM, HEAD_DIM)
        qm = rms_norm(qm.reshape(B, T, H_MEM, HEAD_DIM), g_qk_mem[layer, 0])
        o_mem = memory_attention(qm, km, vm)

        go = g_out[layer]
        mixed = jnp.concatenate([
            rms_norm(o_na.reshape(B, T, W_NA), go[:W_NA]),
            rms_norm(o_dil.reshape(B, T, W_DIL), go[W_NA:W_NA + W_DIL]),
            rms_norm(o_mem.reshape(B, T, W_MEM), go[W_NA + W_DIL:]),
        ], axis=-1)
        h = h + mixed @ w_out[layer]

        u = rms_norm(h, g_ffn[layer])
        i = layer // 2
        if layer % 2 == 0:
            f = swiglu(u, w_gate_dense[i], w_up_dense[i], w_down_dense[i])
        else:
            f = moe_swiglu(u, w_router[i], w_gate_moe[i], w_up_moe[i], w_down_moe[i])
        h = h + f
    return h
```

```cpp
#include <hip/hip_runtime.h>
#include <hip/hip_cooperative_groups.h>
#include <cstdio>
#include <cstdint>
namespace cg = cooperative_groups;

#ifndef MK_N_LAUNCHES
#define MK_N_LAUNCHES 0
#endif

constexpr int D = 1024, SEQ = 8192, NTOK = 16384, MEMLEN = 256, NMEM = 512;
constexpr int HD = 64;
constexpr int IN_W = 2560;
constexpr int DFF = 2816, NEXP = 8, DFFE = 3584;
constexpr int PMAX = 34816;
constexpr int QKV_QA = 0, QKV_KA = 384, QKV_VA = 768, QKV_QB = 1152, QKV_KB = 1536, QKV_VB = 1920, QKV_QM = 2304;
constexpr float RMS_EPS = 1e-6f;
constexpr float LOG2E = 1.4426950408889634f;
constexpr float QSCALE = 0.125f * LOG2E;

#define LAS __attribute__((address_space(3)))
#define GAS __attribute__((address_space(1)))
typedef unsigned short bf16_t;
typedef short bf16x8 __attribute__((ext_vector_type(8)));
typedef float f32x4 __attribute__((ext_vector_type(4)));
typedef float f32x2 __attribute__((ext_vector_type(2)));
typedef unsigned u32x4 __attribute__((ext_vector_type(4)));
typedef unsigned u32x2 __attribute__((ext_vector_type(2)));
typedef __bf16 bf16x2_t __attribute__((ext_vector_type(2)));

__device__ __forceinline__ unsigned pk_bf16(float lo, float hi) { f32x2 v = {lo, hi}; bf16x2_t b = __builtin_convertvector(v, bf16x2_t); return __builtin_bit_cast(unsigned, b); }
__device__ __forceinline__ float bf_lo(unsigned u) { return __uint_as_float(u << 16); }
__device__ __forceinline__ float bf_hi(unsigned u) { return __uint_as_float(u & 0xffff0000u); }
__device__ __forceinline__ float wave_sum(float v) {
#pragma unroll
    for (int o = 1; o < 64; o <<= 1) v += __shfl_xor(v, o);
    return v;
}
__device__ __forceinline__ float ssq16(const float* p) {
    const f32x4* q = (const f32x4*)p; const f32x4 a = q[0], b = q[1], c = q[2], d = q[3];
    const f32x4 s = (a + b) + (c + d); return (s[0] + s[1]) + (s[2] + s[3]);
}

constexpr size_t al256(size_t x) { return (x + 255) & ~(size_t)255; }
constexpr size_t WS_CTL = 0, CTL_BYTES = 1u << 16;
constexpr size_t SSQ_BYTES = al256((size_t)(NTOK + 1) * 16 * 4);
constexpr size_t WS_SSQ = WS_CTL + CTL_BYTES;
constexpr size_t WS_SSQMEM = WS_SSQ + 4 * SSQ_BYTES;
constexpr size_t WS_SSQH = WS_SSQMEM + al256((size_t)NMEM * 16 * 4);
constexpr size_t WS_ROPE = WS_SSQH + al256((size_t)NTOK * 16 * 4);
constexpr size_t WS_MEMBF = WS_ROPE + al256((size_t)SEQ * 64 * 4);
constexpr size_t WS_MEMKV = WS_MEMBF + al256((size_t)NMEM * D * 2);
constexpr size_t WS_EIDX = WS_MEMKV + al256((size_t)2 * NMEM * 512 * 2);
constexpr size_t WS_GATE = WS_EIDX + al256((size_t)NTOK * 4);
constexpr size_t WS_POS = WS_GATE + al256((size_t)NTOK * 8);
constexpr size_t WS_ROWTOK = WS_POS + al256((size_t)NTOK * 8);
constexpr size_t WS_ROWGATE = WS_ROWTOK + al256((size_t)PMAX * 4);
constexpr size_t WS_CNT = WS_ROWGATE + al256((size_t)PMAX * 4);
constexpr size_t WS_WGU_M = al256(WS_CNT + 256);
constexpr size_t WS_WD_M = WS_WGU_M + (size_t)NEXP * 2 * DFFE * D * 2;
constexpr size_t WS_HB = WS_WD_M + (size_t)NEXP * D * DFFE * 2;
constexpr size_t WS_R = WS_HB + al256((size_t)(NTOK + 1) * D * 2);
constexpr size_t WS_WIN = WS_R;
constexpr size_t WS_WMEM = WS_WIN + (size_t)2 * IN_W * D * 2;
constexpr size_t WS_WOUT = WS_WMEM + (size_t)2 * 512 * D * 2;
constexpr size_t WS_WGU_D = WS_WOUT + (size_t)2 * D * D * 2;
constexpr size_t WS_WD_D = WS_WGU_D + (size_t)2 * DFF * D * 2;
constexpr size_t WS_QKV = WS_WD_D + (size_t)D * DFF * 2;
constexpr size_t WS_O = WS_QKV + (size_t)NTOK * IN_W * 2;
constexpr size_t WS_HD = WS_O + (size_t)NTOK * D * 2;
constexpr size_t WS_R_END1 = WS_HD + (size_t)NTOK * DFF * 2;
constexpr size_t WS_HM = WS_R;
constexpr size_t WS_R_END2 = WS_HM + (size_t)PMAX * DFFE * 2;
constexpr size_t WS_Y = WS_WGU_M;
constexpr size_t WS_END = WS_R_END1 > WS_R_END2 ? WS_R_END1 : WS_R_END2;
static_assert(WS_END <= (size_t)469762048, "workspace map exceeds 4 x the largest input tensor");
static_assert((size_t)PMAX * D * 2 <= (size_t)NEXP * 2 * DFFE * D * 2, "Y overlay");

constexpr int RING_BYTES = 131072;
constexpr int LDS_BYTES = 147456;

namespace pg8 {
constexpr int BM = 256, BK = 64, HALF = 128, HTB = HALF * BK * 2, NXCD = 8, WGM = 8;
__host__ __device__ __forceinline__ int lds_byte(int r, int c) { const int st = (r >> 4) * 2 + (c >> 5), rr = r & 15, cc = c & 31, ob = rr * 64 + cc * 2; return st * 1024 + (ob ^ (((ob >> 9) & 1) << 5)); }
__host__ __device__ __forceinline__ void stage_rc(int b, int& R, int& C) { const int st = b / 1024, sb = b % 1024, swz = sb ^ (((sb >> 9) & 1) << 5); R = (st >> 1) * 16 + swz / 64; C = (st & 1) * 32 + (swz % 64) / 2; }
__host__ __device__ __forceinline__ int perm32(int rho) { const int n = rho >> 4, i = rho & 15; return 8 * (i >> 2) + 4 * n + (i & 3); }

struct Unit { int pm, pn, kind, aux; const char* A; const char* B; const int* rows; };

__device__ __forceinline__ void tile_order(int L, int nM, int nN, int& pm, int& pn) {
    const int nwg = nM * nN; int wgid = L;
    { const int q = nwg / NXCD, r = nwg % NXCD, xcd = wgid % NXCD, off = wgid / NXCD; wgid = (xcd < r ? xcd * (q + 1) : r * (q + 1) + (xcd - r) * q) + off; }
    const int nig = WGM * nN, gid = wgid / nig, fm = gid * WGM, gsz = (nM - fm) < WGM ? (nM - fm) : WGM;
    pm = fm + ((wgid % nig) % gsz); pn = (wgid % nig) / gsz;
}

template <class Epi, class Sched, bool GATHER, bool ALIGN_EPI>
__device__ __forceinline__ void gemm_phase(LAS unsigned char* lds, const int K, const Sched& S, const Epi& E) {
    int tid = threadIdx.x; asm volatile("" : "+v"(tid));
    const int wid = __builtin_amdgcn_readfirstlane(tid >> 6), lane = tid & 63, wr = wid >> 2, wc = wid & 3, fr = lane & 15, fq = lane >> 4;
    const int nt = K / BK;
    int RA[2], CA[2]; unsigned voffB[2];
#pragma unroll
    for (int i = 0; i < 2; ++i) { int R, C; stage_rc(tid * 16 + i * 8192, R, C); const int Rb = Epi::PERM ? ((R & ~31) + perm32(R & 31)) : R;
        RA[i] = R; CA[i] = C; voffB[i] = (unsigned)(Rb * K + C) * 2u; }
    const size_t kstep = (size_t)(BK * 2);
    const size_t hstep = (size_t)HALF * K * 2;
    const unsigned ldsw = (unsigned)wid * 1024u;
    const int aoff = lds_byte(wr * 64 + fr, fq * 8), boff = lds_byte(wc * 32 + fr, fq * 8);
#define PG8_SA(b, h) (((b) * 2 + (h)) * HTB)
#define PG8_SB(b, h) ((4 + (b) * 2 + (h)) * HTB)
#define PG8_STAGE(bufoff, gbase, voff) do { _Pragma("unroll") for (int _i = 0; _i < 2; ++_i) \
        __builtin_amdgcn_global_load_lds((const unsigned*)((const char*)(gbase) + (voff)[_i]), (LAS unsigned*)(lds + (bufoff) + ldsw + _i * 8192), 16, 0, 0); } while (0)
#define PG8_LDA(dst, b, h) do { _Pragma("unroll") for (int m = 0; m < 4; ++m) _Pragma("unroll") for (int k = 0; k < 2; ++k) dst[m][k] = *(const LAS bf16x8*)(lds + PG8_SA(b, h) + aoff + m * 2048 + k * 1024); } while (0)
#define PG8_LDB(dst, b, h) do { _Pragma("unroll") for (int n = 0; n < 2; ++n) _Pragma("unroll") for (int k = 0; k < 2; ++k) dst[n][k] = *(const LAS bf16x8*)(lds + PG8_SB(b, h) + boff + n * 2048 + k * 1024); } while (0)
#define PG8_MMA(ai, bj, At, Bt) do { __builtin_amdgcn_s_setprio(1); _Pragma("unroll") for (int m = 0; m < 4; ++m) _Pragma("unroll") for (int n = 0; n < 2; ++n) _Pragma("unroll") for (int k = 0; k < 2; ++k) \
        acc[ai][bj][m][n] = __builtin_amdgcn_mfma_f32_16x16x32_bf16(Bt[n][k], At[m][k], acc[ai][bj][m][n], 0, 0, 0); __builtin_amdgcn_s_setprio(0); } while (0)
#define PG8_WAIT_V(n) asm volatile("s_waitcnt vmcnt(" #n ")" ::: "memory")
#define PG8_WAIT_L(n) asm volatile("s_waitcnt lgkmcnt(" #n ")" ::: "memory")
#define PG8_BAR __builtin_amdgcn_s_barrier()
#define PG8_SCHED __builtin_amdgcn_sched_barrier(0)
#define PG8_OFFS(u, off) do { _Pragma("unroll") for (int _h = 0; _h < 2; ++_h) _Pragma("unroll") for (int _i = 0; _i < 2; ++_i) { \
        if constexpr (GATHER) off[_h][_i] = (unsigned)(u).rows[_h * HALF + RA[_i]] * (unsigned)(K * 2) + (unsigned)(CA[_i] * 2); \
        else off[_h][_i] = (unsigned)((_h * HALF + RA[_i]) * K + CA[_i]) * 2u; } } while (0)
    Unit cur, nxt; int ui = 0;
    if (!S.next(0, cur)) return;
    f32x4 acc[2][2][4][2];
#pragma unroll
    for (int a = 0; a < 2; ++a)
#pragma unroll
        for (int b = 0; b < 2; ++b)
#pragma unroll
            for (int m = 0; m < 4; ++m)
#pragma unroll
                for (int n = 0; n < 2; ++n) acc[a][b][m][n] = (f32x4){0.f, 0.f, 0.f, 0.f};
    bf16x8 At[4][2], B0[2][2], B1[2][2];
    unsigned coff[2][2], noff[2][2];
    PG8_OFFS(cur, coff);
    const char* cA = cur.A; const char* cB = cur.B;
    PG8_STAGE(PG8_SB(0, 0), cB, voffB); PG8_STAGE(PG8_SB(0, 1), cB + hstep, voffB); PG8_STAGE(PG8_SA(0, 0), cA, coff[0]); PG8_STAGE(PG8_SA(0, 1), cA, coff[1]);
    if (wr == 1) PG8_BAR;
    PG8_WAIT_V(2); PG8_BAR;
    PG8_STAGE(PG8_SB(1, 0), cB + kstep, voffB); PG8_STAGE(PG8_SA(1, 0), cA + kstep, coff[0]); PG8_STAGE(PG8_SB(1, 1), cB + hstep + kstep, voffB);
    PG8_WAIT_V(6); PG8_BAR;
    for (;;) {
        const bool has_next = S.next(ui + 1, nxt);
        if (has_next) { PG8_OFFS(nxt, noff); }
        else {
#pragma unroll
            for (int h = 0; h < 2; ++h)
#pragma unroll
                for (int i = 0; i < 2; ++i) noff[h][i] = coff[h][i];
        }
        const char* nA = has_next ? nxt.A : cA; const char* nB = has_next ? nxt.B : cB;
        for (int t = 0; t < nt; t += 2) {
            const bool last = (t == nt - 2);
            const char* a1 = cA + (size_t)(t + 1) * kstep;
            const char* a2 = last ? nA : cA + (size_t)(t + 2) * kstep; const char* b2 = last ? nB : cB + (size_t)(t + 2) * kstep;
            const char* a3 = a2 + kstep; const char* b3 = b2 + kstep;
            unsigned o2[2][2];
#pragma unroll
            for (int h = 0; h < 2; ++h)
#pragma unroll
                for (int i = 0; i < 2; ++i) o2[h][i] = last ? noff[h][i] : coff[h][i];
            PG8_LDB(B0, 0, 0); PG8_LDB(B1, 0, 1); PG8_SCHED; PG8_LDA(At, 0, 0); PG8_STAGE(PG8_SA(1, 1), a1, coff[1]);
            PG8_WAIT_V(8); PG8_WAIT_L(0); PG8_BAR; PG8_MMA(0, 0, At, B0); PG8_MMA(0, 1, At, B1); PG8_BAR; PG8_SCHED;
            PG8_LDA(At, 0, 1); PG8_STAGE(PG8_SB(0, 0), b2, voffB); PG8_STAGE(PG8_SB(0, 1), b2 + hstep, voffB); PG8_STAGE(PG8_SA(0, 0), a2, o2[0]);
            PG8_WAIT_V(8); PG8_WAIT_L(0); PG8_BAR; PG8_MMA(1, 0, At, B0); PG8_MMA(1, 1, At, B1); PG8_BAR; PG8_SCHED;
            PG8_LDB(B0, 1, 0); PG8_LDB(B1, 1, 1); PG8_SCHED; PG8_LDA(At, 1, 0); PG8_STAGE(PG8_SA(0, 1), a2, o2[1]);
            PG8_WAIT_V(8); PG8_WAIT_L(0); PG8_BAR; PG8_MMA(0, 0, At, B0); PG8_MMA(0, 1, At, B1); PG8_BAR; PG8_SCHED;
            PG8_LDA(At, 1, 1); PG8_STAGE(PG8_SB(1, 0), b3, voffB); PG8_STAGE(PG8_SB(1, 1), b3 + hstep, voffB); PG8_STAGE(PG8_SA(1, 0), a3, o2[0]);
            PG8_WAIT_V(8); PG8_WAIT_L(0); PG8_BAR; PG8_MMA(1, 0, At, B0); PG8_MMA(1, 1, At, B1); PG8_BAR; PG8_SCHED;
        }
        if constexpr (ALIGN_EPI) { if (wr == 0) PG8_BAR; }
        E(acc, cur, wr, wc, fr, fq);
        if (!has_next) break;
#pragma unroll
        for (int a = 0; a < 2; ++a)
#pragma unroll
            for (int b = 0; b < 2; ++b)
#pragma unroll
                for (int m = 0; m < 4; ++m)
#pragma unroll
                    for (int n = 0; n < 2; ++n) acc[a][b][m][n] = (f32x4){0.f, 0.f, 0.f, 0.f};
        cur = nxt; cA = nA; cB = nB; ++ui;
#pragma unroll
        for (int h = 0; h < 2; ++h)
#pragma unroll
            for (int i = 0; i < 2; ++i) coff[h][i] = noff[h][i];
        if constexpr (ALIGN_EPI) { if (wr == 1) PG8_BAR; }
    }
    PG8_WAIT_V(0);
    if constexpr (!ALIGN_EPI) { if (wr == 0) PG8_BAR; }
    PG8_BAR;
#undef PG8_SA
#undef PG8_SB
#undef PG8_STAGE
#undef PG8_LDA
#undef PG8_LDB
#undef PG8_MMA
#undef PG8_WAIT_V
#undef PG8_WAIT_L
#undef PG8_BAR
#undef PG8_SCHED
#undef PG8_OFFS
}
}
using pg8::Unit;

struct SchedReg {
    const char* A; const char* B; int nM, nN, K, G, c; int nExtra; const char* memA; const char* memB;
    __device__ __forceinline__ bool next(int i, Unit& u) const {
        const int L = i * G + c, nwg = nM * nN;
        if (L < nwg) { int pm, pn; pg8::tile_order(L, nM, nN, pm, pn); u.pm = pm; u.pn = pn; u.kind = 0; u.aux = 0;
            u.A = A + (size_t)pm * 256 * K * 2; u.B = B + (size_t)pn * 256 * K * 2; u.rows = nullptr; return true; }
        const int x = L - nwg; if (x >= nExtra) return false;
        const int layer = x >> 2, pm = (x >> 1) & 1, pn = x & 1;
        u.pm = pm; u.pn = pn; u.kind = 1; u.aux = layer; u.A = memA + (size_t)pm * 256 * K * 2; u.B = memB + ((size_t)layer * 512 + (size_t)pn * 256) * K * 2; u.rows = nullptr; return true;
    }
};
struct SchedMoE {
    const char* A; const char* B; const int* rowtok; int K, G, c, nN; size_t bstride;
    int bstart[NEXP + 1];
    bool gather;
    __device__ __forceinline__ void init(const int* cnt) { int s = 0;
#pragma unroll
        for (int e = 0; e < NEXP; ++e) { bstart[e] = s; s += (cnt[e] + 255) >> 8; } bstart[NEXP] = s; }
    __device__ __forceinline__ bool next(int i, Unit& u) const {
        const int L = i * G + c; const int total = bstart[NEXP] * nN; if (L >= total) return false;
        int e = 0, bs = bstart[0], be = bstart[1];
#pragma unroll
        for (int k = 1; k < NEXP; ++k) if (L >= bstart[k] * nN) { e = k; bs = bstart[k]; be = bstart[k + 1]; }
        const int r = L - bs * nN, nb = be - bs;
        const int pn = r / nb, rb = bs + (r % nb);
        u.pm = rb; u.pn = pn; u.kind = 0; u.aux = e;
        u.A = gather ? A : A + (size_t)rb * 256 * K * 2; u.B = B + (size_t)e * bstride + (size_t)pn * 256 * K * 2; u.rows = rowtok + rb * 256; return true;
    }
};

struct EpiQKV {
    static constexpr bool PERM = true;
    bf16_t* qkv; const float* ssq; const float* g_na; const float* g_dil; const float* g_mem;
    const float* rope; bf16_t* memkv; const float* ssqmem; const float* g_mem_all;
    __device__ __forceinline__ void operator()(const f32x4 (&acc)[2][2][4][2], const Unit& u, int wr, int wc, int fr, int fq) const {
        const float* gain = nullptr; bool do_rope = false; float sc = 1.f; bf16_t* out; int ldc, col0; const float* sq;
        if (u.kind == 0) {
            const int head = 4 * u.pn + wc; out = qkv; ldc = IN_W; col0 = head * 64; sq = ssq;
            if (head < 6) { gain = g_na; sc = QSCALE; }
            else if (head < 12) { gain = g_na + 64; }
            else if (head < 18) { }
            else if (head < 24) { gain = g_dil; do_rope = true; sc = QSCALE; }
            else if (head < 30) { gain = g_dil + 64; do_rope = true; }
            else if (head < 36) { }
            else { gain = g_mem; sc = QSCALE; }
        } else {
            out = memkv + (size_t)u.aux * NMEM * 512; ldc = 512; col0 = 256 * u.pn + 64 * wc; sq = ssqmem;
            if (u.pn == 0) gain = g_mem_all + u.aux * 128 + 64;
        }
        f32x4 gv[2][2];
#pragma unroll
        for (int bj = 0; bj < 2; ++bj)
#pragma unroll
            for (int n = 0; n < 2; ++n) gv[bj][n] = gain ? *(const f32x4*)(gain + 32 * bj + 8 * fq + 4 * n) : (f32x4){1.f, 1.f, 1.f, 1.f};
#pragma unroll
        for (int ai = 0; ai < 2; ++ai)
#pragma unroll
            for (int m = 0; m < 4; ++m) {
                const int row = u.pm * 256 + ai * 128 + wr * 64 + m * 16 + fr;
                const float rs = rsqrtf(ssq16(sq + (size_t)row * 16) * (1.f / D) + RMS_EPS);
                f32x4 v[2][2];
#pragma unroll
                for (int bj = 0; bj < 2; ++bj)
#pragma unroll
                    for (int n = 0; n < 2; ++n) v[bj][n] = acc[ai][bj][m][n] * rs;
                if (gain) {
                    float ms = 0.f;
#pragma unroll
                    for (int bj = 0; bj < 2; ++bj)
#pragma unroll
                        for (int n = 0; n < 2; ++n) { const f32x4 x = v[bj][n]; ms += (x[0] * x[0] + x[1] * x[1]) + (x[2] * x[2] + x[3] * x[3]); }
                    ms += __shfl_xor(ms, 16); ms += __shfl_xor(ms, 32);
                    const float r2 = rsqrtf(ms * (1.f / HD) + RMS_EPS);
#pragma unroll
                    for (int bj = 0; bj < 2; ++bj)
#pragma unroll
                        for (int n = 0; n < 2; ++n) v[bj][n] = v[bj][n] * r2 * gv[bj][n];
                }
                if (do_rope) {
                    const float* rp = rope + (size_t)(row & (SEQ - 1)) * 64 + 8 * fq;
#pragma unroll
                    for (int n = 0; n < 2; ++n) { const f32x4 cs = *(const f32x4*)(rp + 4 * n), sn = *(const f32x4*)(rp + 32 + 4 * n);
                        const f32x4 x1 = v[0][n], x2 = v[1][n]; v[0][n] = x1 * cs - x2 * sn; v[1][n] = x1 * sn + x2 * cs; }
                }
                bf16_t* rowp = out + (size_t)row * ldc + col0 + 8 * fq;
#pragma unroll
                for (int bj = 0; bj < 2; ++bj) { const f32x4 a = v[bj][0] * sc, b = v[bj][1] * sc; u32x4 w;
                    w.x = pk_bf16(a[0], a[1]); w.y = pk_bf16(a[2], a[3]); w.z = pk_bf16(b[0], b[1]); w.w = pk_bf16(b[2], b[3]);
                    *(u32x4*)(rowp + 32 * bj) = w; }
                asm volatile("" ::: "memory");
            }
    }
};
struct EpiResid {
    static constexpr bool PERM = false;
    const float* base; float* out; bf16_t* hb; float* ssq_out;
    __device__ __forceinline__ void operator()(const f32x4 (&acc)[2][2][4][2], const Unit& u, int wr, int wc, int fr, int fq) const {
        const int col0 = u.pn * 256 + wc * 32 + 4 * fq;
#pragma unroll
        for (int ai = 0; ai < 2; ++ai)
#pragma unroll
            for (int m = 0; m < 4; ++m) {
                const int row = u.pm * 256 + ai * 128 + wr * 64 + m * 16 + fr; const size_t off = (size_t)row * D + col0; float s = 0.f;
#pragma unroll
                for (int bj = 0; bj < 2; ++bj)
#pragma unroll
                    for (int n = 0; n < 2; ++n) { const f32x4 b = *(const f32x4*)(base + off + bj * 128 + n * 16); const f32x4 h = b + acc[ai][bj][m][n];
                        *(f32x4*)(out + off + bj * 128 + n * 16) = h; u32x2 w; w.x = pk_bf16(h[0], h[1]); w.y = pk_bf16(h[2], h[3]); *(u32x2*)(hb + off + bj * 128 + n * 16) = w;
                        s += (h[0] * h[0] + h[1] * h[1]) + (h[2] * h[2] + h[3] * h[3]); }
                s += __shfl_xor(s, 16); s += __shfl_xor(s, 32);
                if (fq == 0) ssq_out[(size_t)row * 16 + 4 * u.pn + wc] = s;
                asm volatile("" ::: "memory");
            }
    }
};
struct EpiSwiGLU {
    static constexpr bool PERM = true;
    bf16_t* H; int ldh; const float* ssq; bool moe;
    __device__ __forceinline__ void operator()(const f32x4 (&acc)[2][2][4][2], const Unit& u, int wr, int wc, int fr, int fq) const {
        const int col0 = u.pn * 128 + wc * 32 + 8 * fq;
#pragma unroll
        for (int ai = 0; ai < 2; ++ai)
#pragma unroll
            for (int m = 0; m < 4; ++m) {
                const int rl = ai * 128 + wr * 64 + m * 16 + fr, row = u.pm * 256 + rl;
                const int tok = moe ? u.rows[rl] : row;
                const float rs = rsqrtf(ssq16(ssq + (size_t)tok * 16) * (1.f / D) + RMS_EPS);
                u32x4 w; unsigned wv[4];
#pragma unroll
                for (int n = 0; n < 2; ++n) { const f32x4 g = acc[ai][0][m][n] * rs, up = acc[ai][1][m][n] * rs; float o[4];
#pragma unroll
                    for (int e = 0; e < 4; ++e) o[e] = g[e] * __builtin_amdgcn_rcpf(1.f + __builtin_amdgcn_exp2f(-g[e] * LOG2E)) * up[e];
                    wv[2 * n] = pk_bf16(o[0], o[1]); wv[2 * n + 1] = pk_bf16(o[2], o[3]); }
                w.x = wv[0]; w.y = wv[1]; w.z = wv[2]; w.w = wv[3];
                *(u32x4*)(H + (size_t)row * ldh + col0) = w;
                asm volatile("" ::: "memory");
            }
    }
};
struct EpiMoEDown {
    static constexpr bool PERM = true;
    bf16_t* Y; const float* rowgate;
    __device__ __forceinline__ void operator()(const f32x4 (&acc)[2][2][4][2], const Unit& u, int wr, int wc, int fr, int fq) const {
        const int col0 = u.pn * 256 + wc * 32 + 8 * fq;
#pragma unroll
        for (int ai = 0; ai < 2; ++ai)
#pragma unroll
            for (int m = 0; m < 4; ++m) {
                const int row = u.pm * 256 + ai * 128 + wr * 64 + m * 16 + fr; const float g = rowgate[row];
#pragma unroll
                for (int bj = 0; bj < 2; ++bj) { const f32x4 a = acc[ai][bj][m][0] * g, b = acc[ai][bj][m][1] * g; u32x4 w;
                    w.x = pk_bf16(a[0], a[1]); w.y = pk_bf16(a[2], a[3]); w.z = pk_bf16(b[0], b[1]); w.w = pk_bf16(b[2], b[3]);
                    *(u32x4*)(Y + (size_t)row * D + col0 + bj * 128) = w; }
            }
    }
};

struct Args {
    const float* x; const float* mem; const float* g_attn; const float* w_in; const float* g_qk_na; const float* rpb_na; const float* g_qk_dil; const float* g_mem;
    const float* w_mem_kv; const float* g_qk_mem; const float* g_out; const float* w_out; const float* g_ffn; const float* w_gate_d; const float* w_up_d; const float* w_down_d;
    const float* w_router; const float* w_gate_m; const float* w_up_m; const float* w_down_m;
    float* out; unsigned char* ws; int ph_lo, ph_hi;
};

__device__ __forceinline__ void conv_item(const float* W, int K, int N, const float* gain, bf16_t* WT, int k0, int n0, int dst_row0, LAS float* scr, int lane) {
    const int r8 = lane >> 3, c4 = (lane & 7) * 4;
#pragma unroll
    for (int i = 0; i < 8; ++i) { const int kk = 8 * i + r8; const f32x4 v = *(const f32x4*)(W + (size_t)(k0 + kk) * N + n0 + c4);
        const float g = gain ? gain[k0 + kk] : 1.f; LAS float* s = scr + kk * 33 + c4; s[0] = v[0] * g; s[1] = v[1] * g; s[2] = v[2] * g; s[3] = v[3] * g; }
    asm volatile("s_waitcnt lgkmcnt(0)" ::: "memory");
    const int c = lane & 7;
#pragma unroll
    for (int j = 0; j < 4; ++j) { const int n = (lane >> 3) + 8 * j; const LAS float* s = scr + (8 * c) * 33 + n;
        u32x4 o; o.x = pk_bf16(s[0 * 33], s[1 * 33]); o.y = pk_bf16(s[2 * 33], s[3 * 33]); o.z = pk_bf16(s[4 * 33], s[5 * 33]); o.w = pk_bf16(s[6 * 33], s[7 * 33]);
        *(u32x4*)(WT + (size_t)(dst_row0 + n) * K + k0 + 8 * c) = o; }
    asm volatile("s_waitcnt lgkmcnt(0)" ::: "memory");
}
__device__ __forceinline__ int map_head(int n) { const int head = n >> 6, d = n & 63; return 256 * (head >> 2) + 128 * (d >> 5) + 32 * (head & 3) + (d & 31); }
__device__ __forceinline__ int map_gate(int n) { return 256 * (n >> 7) + (n & 127); }
__device__ __forceinline__ int map_up(int n) { return 256 * (n >> 7) + 128 + (n & 127); }

__device__ __forceinline__ void attn_key(const bf16_t* kp, const bf16_t* vp, const float (&q)[64], float bias, float& m, float& l, float (&o)[64]) {
    float s = bias;
#pragma unroll
    for (int c = 0; c < 8; ++c) { const u32x4 kk = *(const u32x4*)(kp + 8 * c);
        s += q[8 * c + 0] * bf_lo(kk.x) + q[8 * c + 1] * bf_hi(kk.x) + q[8 * c + 2] * bf_lo(kk.y) + q[8 * c + 3] * bf_hi(kk.y)
           + q[8 * c + 4] * bf_lo(kk.z) + q[8 * c + 5] * bf_hi(kk.z) + q[8 * c + 6] * bf_lo(kk.w) + q[8 * c + 7] * bf_hi(kk.w); }
    const float mn = fmaxf(m, s), a = exp2f(m - mn), p = exp2f(s - mn);
    l = l * a + p; m = mn;
#pragma unroll
    for (int c = 0; c < 8; ++c) { const u32x4 vv = *(const u32x4*)(vp + 8 * c);
        o[8 * c + 0] = o[8 * c + 0] * a + p * bf_lo(vv.x); o[8 * c + 1] = o[8 * c + 1] * a + p * bf_hi(vv.x);
        o[8 * c + 2] = o[8 * c + 2] * a + p * bf_lo(vv.y); o[8 * c + 3] = o[8 * c + 3] * a + p * bf_hi(vv.y);
        o[8 * c + 4] = o[8 * c + 4] * a + p * bf_lo(vv.z); o[8 * c + 5] = o[8 * c + 5] * a + p * bf_hi(vv.z);
        o[8 * c + 6] = o[8 * c + 6] * a + p * bf_lo(vv.w); o[8 * c + 7] = o[8 * c + 7] * a + p * bf_hi(vv.w); }
}
__device__ __forceinline__ void attn_scalar_phase(const bf16_t* qkv, const bf16_t* memkv, const float* rpb, bf16_t* O, float* ssqh, int G) {
    for (int idx = blockIdx.x * 512 + threadIdx.x; idx < NTOK * 16; idx += G * 512) {
        const int head = idx / NTOK, tok = idx % NTOK, b = tok / SEQ, t = tok % SEQ;
        int qcol; if (head < 6) qcol = QKV_QA + 64 * head; else if (head < 12) qcol = QKV_QB + 64 * (head - 6); else qcol = QKV_QM + 64 * (head - 12);
        float q[64], o[64];
        { const bf16_t* qp = qkv + (size_t)tok * IN_W + qcol;
#pragma unroll
          for (int c = 0; c < 8; ++c) { const u32x4 kk = *(const u32x4*)(qp + 8 * c); q[8 * c + 0] = bf_lo(kk.x); q[8 * c + 1] = bf_hi(kk.x); q[8 * c + 2] = bf_lo(kk.y); q[8 * c + 3] = bf_hi(kk.y);
              q[8 * c + 4] = bf_lo(kk.z); q[8 * c + 5] = bf_hi(kk.z); q[8 * c + 6] = bf_lo(kk.w); q[8 * c + 7] = bf_hi(kk.w); } }
#pragma unroll
        for (int d = 0; d < 64; ++d) o[d] = 0.f;
        float m = -1e30f, l = 0.f;
        if (head < 6) {
            const int r = t >> 6, c = t & 63; int rs = r - 4; rs = rs < 0 ? 0 : (rs > 120 ? 120 : rs); int cs = c - 8; cs = cs < 0 ? 0 : (cs > 48 ? 48 : cs);
            const float* bp = rpb + head * 465;
            for (int i = 0; i < 8; ++i) for (int j = 0; j < 16; ++j) {
                const int kt = b * SEQ + (rs + i) * 64 + cs + j; const float bias = bp[(rs + i - r + 7) * 31 + (cs + j - c + 15)] * LOG2E;
                attn_key(qkv + (size_t)kt * IN_W + QKV_KA + 64 * head, qkv + (size_t)kt * IN_W + QKV_VA + 64 * head, q, bias, m, l, o); }
        } else if (head < 12) {
            const int hh = head - 6;
            for (int g = 0; g < 3; ++g) { const int dd = g == 0 ? 1 : (g == 1 ? 4 : 16);
                for (int j = -64; j <= 64; ++j) { const int pos = t + dd * j; if (pos < 0 || pos >= SEQ) continue; const int kt = b * SEQ + pos;
                    attn_key(qkv + (size_t)kt * IN_W + QKV_KB + 64 * hh, qkv + (size_t)kt * IN_W + QKV_VB + 64 * hh, q, 0.f, m, l, o); } }
        } else {
            const int hh = head - 12;
            for (int j = 0; j < MEMLEN; ++j) { const bf16_t* kp = memkv + (size_t)(b * MEMLEN + j) * 512 + 64 * hh; attn_key(kp, kp + 256, q, 0.f, m, l, o); }
        }
        const float il = 1.f / l; float ss = 0.f; bf16_t* op = O + (size_t)tok * D + 64 * head;
#pragma unroll
        for (int c = 0; c < 8; ++c) { float v[8];
#pragma unroll
            for (int e = 0; e < 8; ++e) { v[e] = o[8 * c + e] * il; ss += v[e] * v[e]; }
            u32x4 w; w.x = pk_bf16(v[0], v[1]); w.y = pk_bf16(v[2], v[3]); w.z = pk_bf16(v[4], v[5]); w.w = pk_bf16(v[6], v[7]); *(u32x4*)(op + 8 * c) = w; }
        ssqh[(size_t)tok * 16 + head] = ss;
    }
}

constexpr int NPHASE = 16;
__global__ void __launch_bounds__(512, 2) mk_fwd(Args a) {
    extern __shared__ __attribute__((aligned(16))) unsigned char lds_raw[];
    LAS unsigned char* lds = (LAS unsigned char*)lds_raw;
    const int tid = threadIdx.x, lane = tid & 63, wave = __builtin_amdgcn_readfirstlane(tid >> 6);
    const int G = gridDim.x, bx = blockIdx.x;
    const int vcu = (G % 8 == 0) ? (bx % 8) * (G / 8) + bx / 8 : bx;
    const int gw = vcu * 8 + wave, NGW = G * 8;
    unsigned char* ws = a.ws;
#define SSQV(i) ((float*)(ws + WS_SSQ + (size_t)(i) * SSQ_BYTES))
    float* ssqmem = (float*)(ws + WS_SSQMEM); float* ssqh = (float*)(ws + WS_SSQH); float* rope = (float*)(ws + WS_ROPE);
    bf16_t* membf = (bf16_t*)(ws + WS_MEMBF); bf16_t* memkv = (bf16_t*)(ws + WS_MEMKV);
    int* eidx = (int*)(ws + WS_EIDX); float* gate = (float*)(ws + WS_GATE); int* pos = (int*)(ws + WS_POS); int* rowtok = (int*)(ws + WS_ROWTOK); float* rowgate = (float*)(ws + WS_ROWGATE); int* cnt = (int*)(ws + WS_CNT);
    bf16_t* Wgu_m = (bf16_t*)(ws + WS_WGU_M); bf16_t* Wd_m = (bf16_t*)(ws + WS_WD_M); bf16_t* Hb = (bf16_t*)(ws + WS_HB);
    bf16_t* Win = (bf16_t*)(ws + WS_WIN); bf16_t* Wmem = (bf16_t*)(ws + WS_WMEM); bf16_t* Wout = (bf16_t*)(ws + WS_WOUT); bf16_t* Wgu_d = (bf16_t*)(ws + WS_WGU_D); bf16_t* Wd_d = (bf16_t*)(ws + WS_WD_D);
    bf16_t* QKV = (bf16_t*)(ws + WS_QKV); bf16_t* Ob = (bf16_t*)(ws + WS_O); bf16_t* Hd = (bf16_t*)(ws + WS_HD); bf16_t* Hm = (bf16_t*)(ws + WS_HM); bf16_t* Yb = (bf16_t*)(ws + WS_Y);

#if MK_N_LAUNCHES == 1
    cg::grid_group grid = cg::this_grid();
#define GRID_BAR() grid.sync()
#else
#define GRID_BAR() do { } while (0)
#endif
    const int lo = a.ph_lo, hi = a.ph_hi;
#ifndef PHMASK
#define PHMASK 0xffffffu
#endif
#define IN(k) (((PHMASK >> ((k) > 6 && (k) < 11 ? (k) - 6 : (k))) & 1u) && lo <= (k) && (k) < hi)
#define SEAM(k) do { if (IN(k) && IN((k) + 1)) GRID_BAR(); } while (0)

    if (IN(0)) {
        LAS float* scr = (LAS float*)(lds + wave * 16384);
        constexpr int I_IN = 16 * 80, I_MEM = 16 * 16, I_OUT = 16 * 32, I_GD = 16 * 88, I_DD = 44 * 32, I_GM = 16 * 112, I_DM = 56 * 32;
        constexpr int T0 = 2 * I_IN, T1 = T0 + 2 * I_MEM, T2 = T1 + 2 * I_OUT, T3 = T2 + 2 * I_GD, T4 = T3 + I_DD, T5 = T4 + 2 * NEXP * I_GM, T6 = T5 + NEXP * I_DM;
        for (int it = gw; it < T6; it += NGW) {
            if (it < T0) { const int l = it / I_IN, r = it % I_IN, kb = r / 80, nb = r % 80;
                conv_item(a.w_in + (size_t)l * D * IN_W, D, IN_W, a.g_attn + l * D, Win + (size_t)l * IN_W * D, 64 * kb, 32 * nb, map_head(32 * nb), scr, lane); }
            else if (it < T1) { const int q = it - T0, l = q / I_MEM, r = q % I_MEM, kb = r / 16, nb = r % 16;
                conv_item(a.w_mem_kv + (size_t)l * D * 512, D, 512, a.g_mem + l * D, Wmem + (size_t)l * 512 * D, 64 * kb, 32 * nb, map_head(32 * nb), scr, lane); }
            else if (it < T2) { const int q = it - T1, l = q / I_OUT, r = q % I_OUT, kb = r / 32, nb = r % 32;
                conv_item(a.w_out + (size_t)l * D * D, D, D, a.g_out + l * D, Wout + (size_t)l * D * D, 64 * kb, 32 * nb, 32 * nb, scr, lane); }
            else if (it < T3) { const int q = it - T2, up = q / I_GD, r = q % I_GD, kb = r / 88, nb = r % 88;
                conv_item(up ? a.w_up_d : a.w_gate_d, D, DFF, a.g_ffn, Wgu_d, 64 * kb, 32 * nb, up ? map_up(32 * nb) : map_gate(32 * nb), scr, lane); }
            else if (it < T4) { const int r = it - T3, kb = r / 32, nb = r % 32;
                conv_item(a.w_down_d, DFF, D, nullptr, Wd_d, 64 * kb, 32 * nb, 32 * nb, scr, lane); }
            else if (it < T5) { const int q = it - T4, e = q / (2 * I_GM), q2 = q % (2 * I_GM), up = q2 / I_GM, r = q2 % I_GM, kb = r / 112, nb = r % 112;
                conv_item((up ? a.w_up_m : a.w_gate_m) + (size_t)e * D * DFFE, D, DFFE, a.g_ffn + D, Wgu_m + (size_t)e * 2 * DFFE * D, 64 * kb, 32 * nb, up ? map_up(32 * nb) : map_gate(32 * nb), scr, lane); }
            else { const int q = it - T5, e = q / I_DM, r = q % I_DM, kb = r / 32, nb = r % 32;
                conv_item(a.w_down_m + (size_t)e * DFFE * D, DFFE, D, nullptr, Wd_m + (size_t)e * D * DFFE, 64 * kb, 32 * nb, 32 * nb, scr, lane); }
        }
        for (int m = gw; m < NTOK + NMEM; m += NGW) {
            const bool isx = m < NTOK; const float* src = isx ? a.x + (size_t)m * D : a.mem + (size_t)(m - NTOK) * D;
            bf16_t* dst = isx ? Hb + (size_t)m * D : membf + (size_t)(m - NTOK) * D; float* sq = isx ? SSQV(0) + (size_t)m * 16 : ssqmem + (size_t)(m - NTOK) * 16;
            const f32x4* xr = (const f32x4*)src + lane; float s = 0.f; f32x4 v[4];
#pragma unroll
            for (int j = 0; j < 4; ++j) { v[j] = xr[64 * j]; s += (v[j][0] * v[j][0] + v[j][1] * v[j][1]) + (v[j][2] * v[j][2] + v[j][3] * v[j][3]); }
            s = wave_sum(s);
#pragma unroll
            for (int j = 0; j < 4; ++j) { u32x2 w; w.x = pk_bf16(v[j][0], v[j][1]); w.y = pk_bf16(v[j][2], v[j][3]); ((u32x2*)dst)[lane + 64 * j] = w; }
            if (lane < 16) sq[lane] = lane == 0 ? s : 0.f;
        }
        if (gw == 0) { for (int j = lane; j < D / 2; j += 64) ((unsigned*)(Hb + (size_t)NTOK * D))[j] = 0u;
            if (lane < 16) for (int v = 0; v < 4; ++v) SSQV(v)[(size_t)NTOK * 16 + lane] = lane == 0 ? (float)D : 0.f; }
        for (int i = bx * 512 + tid; i < SEQ * 32; i += G * 512) { const int t = i >> 5, f = i & 31;
            const float inv = powf(10000.0f, -(2.0f / 64.0f) * (float)f); const float ang = (float)t * inv;
            rope[(size_t)t * 64 + f] = (float)cos((double)ang); rope[(size_t)t * 64 + 32 + f] = (float)sin((double)ang); }
    }
    SEAM(0);

#pragma unroll
    for (int layer = 0; layer < 2; ++layer) {
        const int pb = 1 + 6 * layer;
        const float* ssq_in = SSQV(layer == 0 ? 0 : 2); float* ssq_mid = SSQV(layer == 0 ? 1 : 3);
        if (IN(pb)) {
            SchedReg S; S.A = (const char*)Hb; S.B = (const char*)(Win + (size_t)layer * IN_W * D); S.nM = NTOK / 256; S.nN = IN_W / 256; S.K = D; S.G = G; S.c = bx;
            S.nExtra = layer == 0 ? 8 : 0; S.memA = (const char*)membf; S.memB = (const char*)Wmem;
            EpiQKV E; E.qkv = QKV; E.ssq = ssq_in; E.g_na = a.g_qk_na + layer * 128; E.g_dil = a.g_qk_dil + layer * 128; E.g_mem = a.g_qk_mem + layer * 128;
            E.rope = rope; E.memkv = memkv; E.ssqmem = ssqmem; E.g_mem_all = a.g_qk_mem;
            pg8::gemm_phase<EpiQKV, SchedReg, false, true>(lds, D, S, E);
        }
        SEAM(pb);
        if (IN(pb + 1)) attn_scalar_phase(QKV, memkv + (size_t)layer * NMEM * 512, a.rpb_na + layer * 6 * 465, Ob, ssqh, G);
        SEAM(pb + 1);
        if (IN(pb + 2)) {
            for (int m = gw; m < NTOK; m += NGW) {
                const float hv = lane < 16 ? ssqh[(size_t)m * 16 + lane] : 0.f;
                float s0 = lane < 6 ? hv : 0.f, s1 = (lane >= 6 && lane < 12) ? hv : 0.f, s2 = (lane >= 12 && lane < 16) ? hv : 0.f;
                s0 = wave_sum(s0); s1 = wave_sum(s1); s2 = wave_sum(s2);
                const float r0 = rsqrtf(s0 * (1.f / 384.f) + RMS_EPS), r1 = rsqrtf(s1 * (1.f / 384.f) + RMS_EPS), r2 = rsqrtf(s2 * (1.f / 256.f) + RMS_EPS);
                u32x4* p = (u32x4*)(Ob + (size_t)m * D);
#pragma unroll
                for (int j = 0; j < 2; ++j) { const int ch = lane + 64 * j; const int col = ch * 8; const float r = col < 384 ? r0 : (col < 768 ? r1 : r2);
                    u32x4 w = p[ch]; w.x = pk_bf16(bf_lo(w.x) * r, bf_hi(w.x) * r); w.y = pk_bf16(bf_lo(w.y) * r, bf_hi(w.y) * r); w.z = pk_bf16(bf_lo(w.z) * r, bf_hi(w.z) * r); w.w = pk_bf16(bf_lo(w.w) * r, bf_hi(w.w) * r); p[ch] = w; }
            }
        }
        SEAM(pb + 2);
        if (IN(pb + 3)) {
            SchedReg S; S.A = (const char*)Ob; S.B = (const char*)(Wout + (size_t)layer * D * D); S.nM = NTOK / 256; S.nN = D / 256; S.K = D; S.G = G; S.c = bx; S.nExtra = 0; S.memA = nullptr; S.memB = nullptr;
            EpiResid E; E.base = layer == 0 ? a.x : a.out; E.out = a.out; E.hb = Hb; E.ssq_out = ssq_mid;
            pg8::gemm_phase<EpiResid, SchedReg, false, true>(lds, D, S, E);
        }
        SEAM(pb + 3);
        if (layer == 0) {
            if (IN(5)) {
                SchedReg S; S.A = (const char*)Hb; S.B = (const char*)Wgu_d; S.nM = NTOK / 256; S.nN = 2 * DFF / 256; S.K = D; S.G = G; S.c = bx; S.nExtra = 0; S.memA = nullptr; S.memB = nullptr;
                EpiSwiGLU E; E.H = Hd; E.ldh = DFF; E.ssq = ssq_mid; E.moe = false;
                pg8::gemm_phase<EpiSwiGLU, SchedReg, false, true>(lds, D, S, E);
            }
            SEAM(5);
            if (IN(6)) {
                SchedReg S; S.A = (const char*)Hd; S.B = (const char*)Wd_d; S.nM = NTOK / 256; S.nN = D / 256; S.K = DFF; S.G = G; S.c = bx; S.nExtra = 0; S.memA = nullptr; S.memB = nullptr;
                EpiResid E; E.base = a.out; E.out = a.out; E.hb = Hb; E.ssq_out = SSQV(2);
                pg8::gemm_phase<EpiResid, SchedReg, false, true>(lds, DFF, S, E);
            }
            SEAM(6);
        }
    }
    if (IN(11)) {
        float w[16][8];
#pragma unroll
        for (int j = 0; j < 4; ++j)
#pragma unroll
            for (int e4 = 0; e4 < 4; ++e4) { const int k = 4 * lane + 256 * j + e4; const float g = a.g_ffn[D + k]; const f32x4 w0 = *(const f32x4*)(a.w_router + (size_t)k * 8), w1 = *(const f32x4*)(a.w_router + (size_t)k * 8 + 4);
                w[4 * j + e4][0] = w0[0] * g; w[4 * j + e4][1] = w0[1] * g; w[4 * j + e4][2] = w0[2] * g; w[4 * j + e4][3] = w0[3] * g;
                w[4 * j + e4][4] = w1[0] * g; w[4 * j + e4][5] = w1[1] * g; w[4 * j + e4][6] = w1[2] * g; w[4 * j + e4][7] = w1[3] * g; }
        for (int m = gw; m < NTOK; m += NGW) {
            const f32x4* xr = (const f32x4*)(a.out + (size_t)m * D) + lane; float s = 0.f; float lg[8];
#pragma unroll
            for (int e = 0; e < 8; ++e) lg[e] = 0.f;
#pragma unroll
            for (int j = 0; j < 4; ++j) { const f32x4 v = xr[64 * j]; s += (v[0] * v[0] + v[1] * v[1]) + (v[2] * v[2] + v[3] * v[3]);
#pragma unroll
                for (int e4 = 0; e4 < 4; ++e4)
#pragma unroll
                    for (int e = 0; e < 8; ++e) lg[e] += v[e4] * w[4 * j + e4][e]; }
            s = wave_sum(s); const float rs = rsqrtf(s * (1.f / D) + RMS_EPS);
#pragma unroll
            for (int e = 0; e < 8; ++e) lg[e] = wave_sum(lg[e]) * rs;
            int e1 = 0; float l1 = lg[0];
#pragma unroll
            for (int e = 1; e < 8; ++e) if (lg[e] > l1) { l1 = lg[e]; e1 = e; }
            int e2 = -1; float l2 = -3.0e38f;
#pragma unroll
            for (int e = 0; e < 8; ++e) if (e != e1 && lg[e] > l2) { l2 = lg[e]; e2 = e; }
            const float p2 = expf(l2 - l1), g1 = 1.f / (1.f + p2), g2 = p2 * g1;
            if (lane == 0) { eidx[m] = e1 | (e2 << 8); gate[2 * m] = g1; gate[2 * m + 1] = g2; }
        }
    }
    SEAM(11);
    if (IN(12)) {
        LAS int* sh = (LAS int*)lds;
        int c8[8];
#pragma unroll
        for (int e = 0; e < 8; ++e) c8[e] = 0;
        const int t0 = tid * 32;
        for (int i = 0; i < 32; ++i) { const int ev = eidx[t0 + i]; const int e1 = ev & 255, e2 = ev >> 8;
#pragma unroll
            for (int e = 0; e < 8; ++e) c8[e] += (e1 == e) + (e2 == e); }
        int pre[8];
#pragma unroll
        for (int e = 0; e < 8; ++e) { int v = c8[e];
#pragma unroll
            for (int o = 1; o < 64; o <<= 1) { const int n = __shfl_up(v, o); if (lane >= o) v += n; }
            pre[e] = v - c8[e]; if (lane == 63) sh[wave * 8 + e] = v; }
        __syncthreads();
        int tot[8], pstart[8];
#pragma unroll
        for (int e = 0; e < 8; ++e) { int s = 0, before = 0;
            for (int w2 = 0; w2 < 8; ++w2) { const int v = sh[w2 * 8 + e]; if (w2 < wave) before += v; s += v; }
            pre[e] += before; tot[e] = s; }
        { int s = 0;
#pragma unroll
          for (int e = 0; e < 8; ++e) { pstart[e] = s; s += ((tot[e] + 255) >> 8) << 8; } }
        if ((tid % G) == bx) {
            int run[8];
#pragma unroll
            for (int e = 0; e < 8; ++e) run[e] = pstart[e] + pre[e];
            for (int i = 0; i < 32; ++i) { const int t = t0 + i; const int ev = eidx[t]; const int e1 = ev & 255, e2 = ev >> 8; int d1 = 0, d2 = 0;
#pragma unroll
                for (int e = 0; e < 8; ++e) { if (e1 == e) { d1 = run[e]; run[e]++; } }
#pragma unroll
                for (int e = 0; e < 8; ++e) { if (e2 == e) { d2 = run[e]; run[e]++; } }
                rowtok[d1] = t; rowgate[d1] = gate[2 * t]; pos[2 * t] = d1;
                rowtok[d2] = t; rowgate[d2] = gate[2 * t + 1]; pos[2 * t + 1] = d2; }
        }
        if (bx < 8) { const int e = bx; int te = 0, ps = 0;
#pragma unroll
            for (int k = 0; k < 8; ++k) if (k == e) { te = tot[k]; ps = pstart[k]; }
            const int padded = ((te + 255) >> 8) << 8;
            for (int r = te + tid; r < padded; r += 512) { rowtok[ps + r] = NTOK; rowgate[ps + r] = 0.f; } }
        if (bx == 0 && tid == 0) {
#pragma unroll
            for (int e = 0; e < 8; ++e) cnt[e] = tot[e]; }
        __syncthreads();
    }
    SEAM(12);
    if (IN(13)) {
        SchedMoE S; S.A = (const char*)Hb; S.B = (const char*)Wgu_m; S.rowtok = rowtok; S.K = D; S.G = G; S.c = bx; S.nN = 2 * DFFE / 256; S.bstride = (size_t)2 * DFFE * D * 2; S.gather = true; S.init(cnt);
        EpiSwiGLU E; E.H = Hm; E.ldh = DFFE; E.ssq = SSQV(3); E.moe = true;
        pg8::gemm_phase<EpiSwiGLU, SchedMoE, true, true>(lds, D, S, E);
    }
    SEAM(13);
    if (IN(14)) {
        SchedMoE S; S.A = (const char*)Hm; S.B = (const char*)Wd_m; S.rowtok = rowtok; S.K = DFFE; S.G = G; S.c = bx; S.nN = D / 256; S.bstride = (size_t)D * DFFE * 2; S.gather = false; S.init(cnt);
        EpiMoEDown E; E.Y = Yb; E.rowgate = rowgate;
        pg8::gemm_phase<EpiMoEDown, SchedMoE, false, true>(lds, DFFE, S, E);
    }
    SEAM(14);
    if (IN(15)) {
        for (int m = gw; m < NTOK; m += NGW) {
            const int p0 = pos[2 * m], p1 = pos[2 * m + 1];
            f32x4* o = (f32x4*)(a.out + (size_t)m * D); const u32x2* y0 = (const u32x2*)(Yb + (size_t)p0 * D); const u32x2* y1 = (const u32x2*)(Yb + (size_t)p1 * D);
#pragma unroll
            for (int j = 0; j < 4; ++j) { const int ch = lane + 64 * j; f32x4 h = o[ch]; const u32x2 a0 = y0[ch], a1 = y1[ch];
                h[0] += bf_lo(a0.x) + bf_lo(a1.x); h[1] += bf_hi(a0.x) + bf_hi(a1.x); h[2] += bf_lo(a0.y) + bf_lo(a1.y); h[3] += bf_hi(a0.y) + bf_hi(a1.y); o[ch] = h; }
        }
    }
#undef IN
#undef SEAM
#undef GRID_BAR
}

extern "C" void kernel_launch(void* const* d_in, const int* in_sizes, int n_in, void* d_out, int out_size, void* d_ws, size_t ws_size, hipStream_t stream) {
    static int grid = 0;
    if (grid == 0) {
        if (n_in != 20 || out_size != NTOK * D || ws_size < WS_END) { fprintf(stderr, "kernel_launch: unexpected shapes (n_in %d out %d ws %zu need %zu)\n", n_in, out_size, ws_size, (size_t)WS_END); grid = -1; return; }
        int dev = 0, cus = 0, per_cu = 0;
        (void)hipGetDevice(&dev); (void)hipDeviceGetAttribute(&cus, hipDeviceAttributeMultiprocessorCount, dev);
        if (hipFuncSetAttribute((const void*)mk_fwd, hipFuncAttributeMaxDynamicSharedMemorySize, LDS_BYTES) != hipSuccess) { fprintf(stderr, "kernel_launch: hipFuncSetAttribute failed\n"); grid = -1; return; }
        (void)hipOccupancyMaxActiveBlocksPerMultiprocessor(&per_cu, (const void*)mk_fwd, 512, LDS_BYTES);
        (void)hipGetLastError();
        if (per_cu < 1) { fprintf(stderr, "kernel_launch: occupancy query says %d blocks per CU\n", per_cu); per_cu = 1; }
        grid = cus;
    }
    if (grid < 0) return;
    (void)hipMemsetAsync((char*)d_ws + WS_CTL, 0, CTL_BYTES, stream);
    Args a{};
    a.x = (const float*)d_in[0]; a.mem = (const float*)d_in[1]; a.g_attn = (const float*)d_in[2]; a.w_in = (const float*)d_in[3]; a.g_qk_na = (const float*)d_in[4]; a.rpb_na = (const float*)d_in[5];
    a.g_qk_dil = (const float*)d_in[6]; a.g_mem = (const float*)d_in[7]; a.w_mem_kv = (const float*)d_in[8]; a.g_qk_mem = (const float*)d_in[9]; a.g_out = (const float*)d_in[10]; a.w_out = (const float*)d_in[11];
    a.g_ffn = (const float*)d_in[12]; a.w_gate_d = (const float*)d_in[13]; a.w_up_d = (const float*)d_in[14]; a.w_down_d = (const float*)d_in[15]; a.w_router = (const float*)d_in[16];
    a.w_gate_m = (const float*)d_in[17]; a.w_up_m = (const float*)d_in[18]; a.w_down_m = (const float*)d_in[19];
    a.out = (float*)d_out; a.ws = (unsigned char*)d_ws;
#if MK_N_LAUNCHES == 1
    a.ph_lo = 0; a.ph_hi = NPHASE;
    void* args[] = {&a};
    hipError_t e = hipLaunchCooperativeKernel((const void*)mk_fwd, dim3(grid), dim3(512), args, LDS_BYTES, stream);
    if (e != hipSuccess) fprintf(stderr, "cooperative launch failed: %s (grid %d)\n", hipGetErrorString(e), grid);
#else
    for (int p = 0; p < NPHASE; ++p) { a.ph_lo = p; a.ph_hi = p + 1; hipLaunchKernelGGL(mk_fwd, dim3(grid), dim3(512), LDS_BYTES, stream, a); }
#endif
}
```

```cpp
#include <hip/hip_runtime.h>
#include <hip/hip_cooperative_groups.h>
#include <cstdio>
#include <cstdint>
namespace cg = cooperative_groups;

#ifndef MK_N_LAUNCHES
#define MK_N_LAUNCHES 1
#endif
#ifndef DENSE_FP8_UP
#define DENSE_FP8_UP 0
#endif
#ifndef DENSE_FP8_DN
#define DENSE_FP8_DN 1
#endif

constexpr int D = 1024, SEQ = 8192, NTOK = 16384, MEMLEN = 256, NMEM = 512;
constexpr int HD = 64;
constexpr int IN_W = 2560;
constexpr int DFF = 2816, NEXP = 8, DFFE = 3584;
constexpr int PMAX = 34816;
constexpr int YPART_ROWS = PMAX - 2 * NTOK;
constexpr size_t YPART_STRIDE = (size_t)YPART_ROWS * 1024 * 2, YPART_OFF = (size_t)128 << 20;
constexpr int QKV_QA = 0, QKV_KA = 384, QKV_VA = 768, QKV_QB = 1152, QKV_KB = 1536, QKV_VB = 1920, QKV_QM = 2304;
constexpr float RMS_EPS = 1e-6f;
constexpr float LOG2E = 1.4426950408889634f;
constexpr float QSCALE = 0.125f * LOG2E;
constexpr float W8_UP = 64.f, W8_DN = 128.f, H8_SC = 8.f;

#define LAS __attribute__((address_space(3)))
#define GAS __attribute__((address_space(1)))
typedef unsigned short bf16_t;
typedef short bf16x8 __attribute__((ext_vector_type(8)));
typedef float f32x4 __attribute__((ext_vector_type(4)));
typedef float f32x2 __attribute__((ext_vector_type(2)));
typedef unsigned u32x4 __attribute__((ext_vector_type(4)));
typedef unsigned u32x2 __attribute__((ext_vector_type(2)));
typedef __bf16 bf16x2_t __attribute__((ext_vector_type(2)));

__device__ __forceinline__ unsigned pk_bf16(float lo, float hi) { f32x2 v = {lo, hi}; bf16x2_t b = __builtin_convertvector(v, bf16x2_t); return __builtin_bit_cast(unsigned, b); }
__device__ __forceinline__ unsigned pk4_fp8(float a, float b, float c, float d) { int w = 0; w = __builtin_amdgcn_cvt_pk_fp8_f32(a, b, w, false); w = __builtin_amdgcn_cvt_pk_fp8_f32(c, d, w, true); return (unsigned)w; }
__device__ __forceinline__ void st16_wt(void* p, u32x4 v) { asm volatile("global_store_dwordx4 %0, %1, off sc1\n\ts_nop 1" :: "v"(p), "v"(v) : "memory"); }
__device__ __forceinline__ float bf_lo(unsigned u) { return __uint_as_float(u << 16); }
__device__ __forceinline__ float bf_hi(unsigned u) { return __uint_as_float(u & 0xffff0000u); }
__device__ __forceinline__ float sum_x32(float v) { auto r = __builtin_amdgcn_permlane32_swap(__float_as_uint(v), __float_as_uint(v), false, false); return __uint_as_float(r[0]) + __uint_as_float(r[1]); }
__device__ __forceinline__ float sum_x16(float v) { auto r = __builtin_amdgcn_permlane16_swap(__float_as_uint(v), __float_as_uint(v), false, false); return __uint_as_float(r[0]) + __uint_as_float(r[1]); }
template <int K> __device__ __forceinline__ float swz_xor(float v) { return __uint_as_float((unsigned)__builtin_amdgcn_ds_swizzle((int)__float_as_uint(v), (K << 10) | 0x1f)); }
__device__ __forceinline__ float wave_sum(float v) { v += swz_xor<1>(v); v += swz_xor<2>(v); v += swz_xor<4>(v); v += swz_xor<8>(v); v = sum_x16(v); return sum_x32(v); }
__device__ __forceinline__ float ssq16(const float* p) {
    const f32x4* q = (const f32x4*)p; const f32x4 a = q[0], b = q[1], c = q[2], d = q[3];
    const f32x4 s = (a + b) + (c + d); return (s[0] + s[1]) + (s[2] + s[3]);
}

__device__ __forceinline__ int lane_id_now() { int l; asm volatile("v_mbcnt_lo_u32_b32 %0, -1, 0\n\tv_mbcnt_hi_u32_b32 %0, -1, %0" : "=v"(l)); return l; }
constexpr size_t al256(size_t x) { return (x + 255) & ~(size_t)255; }
constexpr size_t WS_CTL = 0, CTL_BYTES = 1u << 16;
constexpr size_t SSQ_BYTES = al256((size_t)(NTOK + 1) * 4 * 4);
constexpr size_t WS_SSQ = WS_CTL + CTL_BYTES;
constexpr size_t WS_SSQMEM = WS_SSQ + 4 * SSQ_BYTES;
constexpr size_t WS_SSQH = WS_SSQMEM + al256((size_t)NMEM * 4 * 4);
constexpr size_t WS_ROPE = WS_SSQH + al256((size_t)NTOK * 16 * 4);
constexpr size_t WS_MEMBF = WS_ROPE + al256((size_t)SEQ * 64 * 4);
constexpr size_t WS_MEMKV = WS_MEMBF + al256((size_t)NMEM * D * 2);
constexpr size_t WS_EIDX = WS_MEMKV + al256((size_t)2 * NMEM * 512 * 2);
constexpr size_t WS_GATE = WS_EIDX + al256((size_t)NTOK * 4);
constexpr size_t WS_POS = WS_GATE + al256((size_t)NTOK * 8);
constexpr size_t WS_ROWTOK = WS_POS + al256((size_t)NTOK * 8);
constexpr size_t WS_ROWGATE = WS_ROWTOK + al256((size_t)PMAX * 4);
constexpr size_t WS_CNT = WS_ROWGATE + al256((size_t)PMAX * 4);
constexpr size_t WS_RSTD3 = al256(WS_CNT + 256);
constexpr size_t WS_ROWRSTD = WS_RSTD3 + al256((size_t)NTOK * 4);
constexpr size_t WS_WGU_M = WS_ROWRSTD + al256((size_t)PMAX * 4);
constexpr size_t WS_WD_M = WS_WGU_M + (size_t)NEXP * 2 * DFFE * D;
constexpr size_t WS_HB = WS_WD_M + (size_t)NEXP * D * DFFE;
constexpr size_t WS_HB8 = WS_HB + al256((size_t)(NTOK + 1) * D * 2);
constexpr size_t WS_Y = WS_HB8 + al256((size_t)(NTOK + 1) * D);
constexpr size_t WS_R = WS_Y + (size_t)PMAX * D * 2;
constexpr size_t WS_WIN = WS_R;
constexpr size_t WS_WMEM = WS_WIN + (size_t)2 * IN_W * D * 2;
constexpr size_t WS_WOUT = WS_WMEM + (size_t)2 * 512 * D * 2;
constexpr size_t WS_WGU_D = WS_WOUT + (size_t)2 * D * D * 2;
constexpr size_t WS_WD_D = WS_WGU_D + (size_t)2 * DFF * D * 2;
constexpr size_t WS_QKV = WS_WD_D + (size_t)D * DFF * 2;
constexpr size_t WS_O = WS_QKV + (size_t)NTOK * IN_W * 2;
constexpr size_t WS_HD = WS_O + (size_t)NTOK * D * 2;
constexpr size_t WS_R_END1 = WS_HD + (size_t)NTOK * DFF * 2;
constexpr size_t WS_HM = WS_R;
constexpr size_t WS_R_END2 = WS_HM + (size_t)PMAX * DFFE;
constexpr size_t WS_END = WS_R_END1 > WS_R_END2 ? WS_R_END1 : WS_R_END2;
static_assert(WS_END <= (size_t)469762048, "workspace map exceeds 4 x the largest input tensor");

constexpr int RING_BYTES = 131072;
constexpr int LDS_BYTES = 163840;

namespace pg8 {
constexpr int BM = 256, BK = 64, HALF = 128, HTB = HALF * BK * 2, NXCD = 8, WGM = 8;
__host__ __device__ __forceinline__ int lds_byte(int r, int c) { const int st = (r >> 4) * 2 + (c >> 5), rr = r & 15, cc = c & 31, ob = rr * 64 + cc * 2; return st * 1024 + (ob ^ (((ob >> 9) & 1) << 5)); }
__host__ __device__ __forceinline__ void stage_rc(int b, int& R, int& C) { const int st = b / 1024, sb = b % 1024, swz = sb ^ (((sb >> 9) & 1) << 5); R = (st >> 1) * 16 + swz / 64; C = (st & 1) * 32 + (swz % 64) / 2; }
__host__ __device__ __forceinline__ int perm32(int rho) { const int n = rho >> 4, i = rho & 15; return 8 * (i >> 2) + 4 * n + (i & 3); }

struct Unit { int pm, pn, kind, aux; const char* A; const char* B; const int* rows; int nt2, part; };

__device__ __forceinline__ void tile_order(int L, int nM, int nN, int& pm, int& pn) {
    const int nwg = nM * nN; int wgid = L;
    { const int q = nwg / NXCD, r = nwg % NXCD, xcd = wgid % NXCD, off = wgid / NXCD; wgid = (xcd < r ? xcd * (q + 1) : r * (q + 1) + (xcd - r) * q) + off; }
    const int nig = WGM * nN, gid = wgid / nig, fm = gid * WGM, gsz = (nM - fm) < WGM ? (nM - fm) : WGM;
    pm = fm + ((wgid % nig) % gsz); pn = (wgid % nig) / gsz;
}

__host__ __device__ __forceinline__ int g8(int r) { return ((r >> 1) & 7) ^ ((((r >> 2) ^ (r >> 3)) & 1) << 1); }
__host__ __device__ __forceinline__ void stage_rc8(int b, int& R, int& C) { const int p = b >> 4, row = p >> 3, phys = p & 7; R = row; C = (phys ^ g8(row & 15)) * 8; }
typedef int v8i_t __attribute__((ext_vector_type(8)));
typedef int v4i_t __attribute__((ext_vector_type(4)));
template <class Epi, class Sched, bool GATHER, bool ALIGN_EPI, bool FP8 = false, bool SK = false, bool PUB = false>
__device__ __forceinline__ void gemm_phase(LAS unsigned char* lds, const int K, const Sched& S, const Epi& E, const int wave_in) {
    int tid = wave_in * 64 + lane_id_now(); asm volatile("" : "+v"(tid));
    const int wid = __builtin_amdgcn_readfirstlane(tid >> 6), lane = tid & 63, wr = wid >> 2, wc = wid & 3, fr = lane & 15, fq = lane >> 4;
    const int nt = K / BK;
    int RA[2], CA[2]; unsigned voffB[2];
#pragma unroll
    for (int i = 0; i < 2; ++i) { int R, C; if constexpr (FP8) stage_rc8(tid * 16 + i * 8192, R, C); else stage_rc(tid * 16 + i * 8192, R, C); const int Rb = Epi::PERM ? ((R & ~31) + perm32(R & 31)) : R;
        RA[i] = R; CA[i] = C; voffB[i] = (unsigned)(Rb * K + C) * 2u; }
    const size_t kstep = (size_t)(BK * 2);
    const size_t hstep = (size_t)HALF * K * 2;
    const unsigned ldsw = (unsigned)wid * 1024u;
    int aoffk[2], boffk[2];
    if constexpr (FP8) { const int gx = g8(fr);
        aoffk[0] = (wr * 64 + fr) * 128 + (((2 * fq) ^ gx) << 4); aoffk[1] = (wr * 64 + fr) * 128 + (((2 * fq + 1) ^ gx) << 4);
        boffk[0] = (wc * 32 + fr) * 128 + (((2 * fq) ^ gx) << 4); boffk[1] = (wc * 32 + fr) * 128 + (((2 * fq + 1) ^ gx) << 4); }
    else { aoffk[0] = lds_byte(wr * 64 + fr, fq * 8); aoffk[1] = aoffk[0] + 1024; boffk[0] = lds_byte(wc * 32 + fr, fq * 8); boffk[1] = boffk[0] + 1024; }
#define PG8_SA(b, h) (((b) * 2 + (h)) * HTB)
#define PG8_SB(b, h) ((4 + (b) * 2 + (h)) * HTB)
#define PG8_STAGE(bufoff, gbase, voff) do { _Pragma("unroll") for (int _i = 0; _i < 2; ++_i) \
        __builtin_amdgcn_global_load_lds((const unsigned*)((const char*)(gbase) + (voff)[_i]), (LAS unsigned*)(lds + (bufoff) + ldsw + _i * 8192), 16, 0, 0); } while (0)
#define PG8_LDA(dst, dst8, b, h) do { _Pragma("unroll") for (int m = 0; m < 4; ++m) { \
        if constexpr (FP8) { const v4i_t lo_ = *(const LAS v4i_t*)(lds + PG8_SA(b, h) + aoffk[0] + m * 2048), hi_ = *(const LAS v4i_t*)(lds + PG8_SA(b, h) + aoffk[1] + m * 2048); dst8[m] = __builtin_shufflevector(lo_, hi_, 0, 1, 2, 3, 4, 5, 6, 7); } \
        else { _Pragma("unroll") for (int k = 0; k < 2; ++k) dst[m][k] = *(const LAS bf16x8*)(lds + PG8_SA(b, h) + aoffk[k] + m * 2048); } } } while (0)
#define PG8_LDB(dst, dst8, b, h) do { _Pragma("unroll") for (int n = 0; n < 2; ++n) { \
        if constexpr (FP8) { const v4i_t lo_ = *(const LAS v4i_t*)(lds + PG8_SB(b, h) + boffk[0] + n * 2048), hi_ = *(const LAS v4i_t*)(lds + PG8_SB(b, h) + boffk[1] + n * 2048); dst8[n] = __builtin_shufflevector(lo_, hi_, 0, 1, 2, 3, 4, 5, 6, 7); } \
        else { _Pragma("unroll") for (int k = 0; k < 2; ++k) dst[n][k] = *(const LAS bf16x8*)(lds + PG8_SB(b, h) + boffk[k] + n * 2048); } } } while (0)
#define PG8_MMA(ai, bj, At, Bt, At8, Bt8) do { __builtin_amdgcn_s_setprio(1); _Pragma("unroll") for (int m = 0; m < 4; ++m) _Pragma("unroll") for (int n = 0; n < 2; ++n) { \
        if constexpr (FP8) asm volatile("v_mfma_scale_f32_16x16x128_f8f6f4 %0, %1, %2, %0, %3, %3 op_sel_hi:[0,0,0]" : "+v"(acc[ai][bj][m][n]) : "v"(Bt8[n]), "v"(At8[m]), "v"(sc8));   \
        else { _Pragma("unroll") for (int k = 0; k < 2; ++k) acc[ai][bj][m][n] = __builtin_amdgcn_mfma_f32_16x16x32_bf16(Bt[n][k], At[m][k], acc[ai][bj][m][n], 0, 0, 0); } } \
        __builtin_amdgcn_s_setprio(0); } while (0)
#define PG8_WAIT_V(n) asm volatile("s_waitcnt vmcnt(" #n ")" ::: "memory")
#define PG8_WAIT_L(n) asm volatile("s_waitcnt lgkmcnt(" #n ")" ::: "memory")
#define PG8_BAR __builtin_amdgcn_s_barrier()
#define PG8_SCHED __builtin_amdgcn_sched_barrier(0)
#define PG8_OFFS(u, off) do { _Pragma("unroll") for (int _h = 0; _h < 2; ++_h) _Pragma("unroll") for (int _i = 0; _i < 2; ++_i) { \
        if constexpr (GATHER) off[_h][_i] = (unsigned)(u).rows[_h * HALF + RA[_i]] * (unsigned)(K * 2) + (unsigned)(CA[_i] * 2); \
        else off[_h][_i] = (unsigned)((_h * HALF + RA[_i]) * K + CA[_i]) * 2u; } } while (0)
    constexpr int AB = Epi::AUX_BYTES; constexpr int ROWS_OFF = 131072 + 6144, AUX_OFF = 131072 + 9216;
#define PG8_AUX(u, slot) do { if constexpr (AB != 0) { if (wid < 4) { const int t_ = wave_in * 64 + lane_id_now();   const char* src_ = E.aux_src(u) + (size_t)t_ * AB; LAS unsigned* dst_ = (LAS unsigned*)(lds + AUX_OFF + (slot) * 4096 + wid * (64 * AB)); \
        if constexpr (AB == 16) __builtin_amdgcn_global_load_lds((const unsigned*)src_, dst_, 16, 0, 0); else __builtin_amdgcn_global_load_lds((const unsigned*)src_, dst_, 4, 0, 0); } } } while (0)
#define PG8_ROWS(u, slot) do { if constexpr (GATHER) { if (wid < 4) { const int t_ = wave_in * 64 + lane_id_now(); __builtin_amdgcn_global_load_lds((const unsigned*)((u).rows + t_), (LAS unsigned*)(lds + ROWS_OFF + (slot) * 1024 + wid * 256), 4, 0, 0); } } } while (0)
    int cs = 0, ns = 1;
    Unit cur, nxt; int ui = 0;
    if (!S.next(0, cur)) return;
    f32x4 acc[2][2][4][2];
#pragma unroll
    for (int a = 0; a < 2; ++a)
#pragma unroll
        for (int b = 0; b < 2; ++b)
#pragma unroll
            for (int m = 0; m < 4; ++m)
#pragma unroll
                for (int n = 0; n < 2; ++n) acc[a][b][m][n] = (f32x4){0.f, 0.f, 0.f, 0.f};
    bf16x8 At[4][2], B0[2][2], B1[2][2];
    v8i_t At8[4], B08[2], B18[2];
    int sc8 = 0x7f7f7f7f; asm volatile("" : "+v"(sc8));
    unsigned coff[2][2], noff[2][2];
    PG8_OFFS(cur, coff);
    const char* cA = cur.A; const char* cB = cur.B;
    PG8_AUX(cur, 0);
    PG8_STAGE(PG8_SB(0, 0), cB, voffB); PG8_STAGE(PG8_SB(0, 1), cB + hstep, voffB); PG8_STAGE(PG8_SA(0, 0), cA, coff[0]); PG8_STAGE(PG8_SA(0, 1), cA, coff[1]);
    if (wr == 1) PG8_BAR;
    PG8_WAIT_V(2); PG8_BAR;
    PG8_STAGE(PG8_SB(1, 0), cB + kstep, voffB); PG8_STAGE(PG8_SA(1, 0), cA + kstep, coff[0]); PG8_STAGE(PG8_SB(1, 1), cB + hstep + kstep, voffB);
    PG8_WAIT_V(6); PG8_BAR;
    for (;;) {
        const bool has_next = S.next(ui + 1, nxt);
        ns = cs == 2 ? 0 : cs + 1;
#pragma unroll
        for (int h = 0; h < 2; ++h)
#pragma unroll
            for (int i = 0; i < 2; ++i) noff[h][i] = coff[h][i];
        if (has_next) { PG8_AUX(nxt, ns); if constexpr (GATHER) { PG8_ROWS(nxt, ns); } else { PG8_OFFS(nxt, noff); } }
        const char* nA = has_next ? nxt.A : cA; const char* nB = has_next ? nxt.B : cB;
        const int ntc = (SK && cur.nt2) ? 2 * cur.nt2 : nt;
        for (int t = 0; t < ntc; t += 2) {
            const bool last = (t == ntc - 2);
            const char* a1 = cA + (size_t)(t + 1) * kstep;
            const char* a2 = last ? nA : cA + (size_t)(t + 2) * kstep; const char* b2 = last ? nB : cB + (size_t)(t + 2) * kstep;
            const char* a3 = a2 + kstep; const char* b3 = b2 + kstep;
            if constexpr (GATHER) { if (last && has_next) { const LAS int* rt_ = (const LAS int*)(lds + ROWS_OFF + ns * 1024);
#pragma unroll
                for (int h = 0; h < 2; ++h)
#pragma unroll
                    for (int i = 0; i < 2; ++i) noff[h][i] = (unsigned)rt_[h * HALF + RA[i]] * (unsigned)(K * 2) + (unsigned)(CA[i] * 2); } }
            unsigned o2[2][2];
#pragma unroll
            for (int h = 0; h < 2; ++h)
#pragma unroll
                for (int i = 0; i < 2; ++i) o2[h][i] = last ? noff[h][i] : coff[h][i];
            PG8_LDB(B0, B08, 0, 0); PG8_LDB(B1, B18, 0, 1); PG8_SCHED; PG8_LDA(At, At8, 0, 0); PG8_STAGE(PG8_SA(1, 1), a1, coff[1]);
            PG8_WAIT_V(8); PG8_WAIT_L(0); PG8_BAR; PG8_MMA(0, 0, At, B0, At8, B08); PG8_MMA(0, 1, At, B1, At8, B18); PG8_BAR; PG8_SCHED;
            PG8_LDA(At, At8, 0, 1); PG8_STAGE(PG8_SB(0, 0), b2, voffB); PG8_STAGE(PG8_SB(0, 1), b2 + hstep, voffB); PG8_STAGE(PG8_SA(0, 0), a2, o2[0]);
            PG8_WAIT_V(8); PG8_WAIT_L(0); PG8_BAR; PG8_MMA(1, 0, At, B0, At8, B08); PG8_MMA(1, 1, At, B1, At8, B18); PG8_BAR; PG8_SCHED;
            PG8_LDB(B0, B08, 1, 0); PG8_LDB(B1, B18, 1, 1); PG8_SCHED; PG8_LDA(At, At8, 1, 0); PG8_STAGE(PG8_SA(0, 1), a2, o2[1]);
            PG8_WAIT_V(8); PG8_WAIT_L(0); PG8_BAR; PG8_MMA(0, 0, At, B0, At8, B08); PG8_MMA(0, 1, At, B1, At8, B18); PG8_BAR; PG8_SCHED;
            PG8_LDA(At, At8, 1, 1); PG8_STAGE(PG8_SB(1, 0), b3, voffB); PG8_STAGE(PG8_SB(1, 1), b3 + hstep, voffB); PG8_STAGE(PG8_SA(1, 0), a3, o2[0]);
            PG8_WAIT_V(8); PG8_WAIT_L(0); PG8_BAR; PG8_MMA(1, 0, At, B0, At8, B08); PG8_MMA(1, 1, At, B1, At8, B18); PG8_BAR; PG8_SCHED;
        }
        if constexpr (FP8) asm volatile("s_nop 15\n\ts_nop 15" ::: "memory");
        if constexpr (ALIGN_EPI) { if (wr == 0) PG8_BAR; }
        E(acc, cur, wr, wc, fr, fq, (const LAS unsigned char*)(lds + AUX_OFF + cs * 4096));
        if constexpr (PUB) { const int pi_ = S.pub_index(cur); if (pi_ >= 0) {
            asm volatile("s_waitcnt vmcnt(0)" ::: "memory"); __syncthreads();
            if (wid == 0 && lane_id_now() == 0) __hip_atomic_store(S.pub + pi_, 1u, __ATOMIC_RELAXED, __HIP_MEMORY_SCOPE_AGENT); } }
        cs = ns;
        if (!has_next) break;
#pragma unroll
        for (int a = 0; a < 2; ++a)
#pragma unroll
            for (int b = 0; b < 2; ++b)
#pragma unroll
                for (int m = 0; m < 4; ++m)
#pragma unroll
                    for (int n = 0; n < 2; ++n) acc[a][b][m][n] = (f32x4){0.f, 0.f, 0.f, 0.f};
        cur = nxt; cA = nA; cB = nB; ++ui;
#pragma unroll
        for (int h = 0; h < 2; ++h)
#pragma unroll
            for (int i = 0; i < 2; ++i) coff[h][i] = noff[h][i];
        if constexpr (ALIGN_EPI) { if (wr == 1) PG8_BAR; }
    }
    PG8_WAIT_V(0);
    if constexpr (!ALIGN_EPI) { if (wr == 0) PG8_BAR; }
    PG8_BAR;
#undef PG8_SA
#undef PG8_SB
#undef PG8_STAGE
#undef PG8_LDA
#undef PG8_LDB
#undef PG8_MMA
#undef PG8_WAIT_V
#undef PG8_WAIT_L
#undef PG8_BAR
#undef PG8_SCHED
#undef PG8_OFFS
#undef PG8_AUX
#undef PG8_ROWS
}
}
using pg8::Unit;

struct SchedReg {
    const char* A; const char* B; int nM, nN, K, G, c; int nExtra; const char* memA; const char* memB;
    bool memfirst; unsigned* pub;
    __device__ __forceinline__ bool next(int i, Unit& u) const {
        const int L0 = i * G + c, nwg = nM * nN;
        if (memfirst ? (L0 >= nExtra && L0 < nExtra + nwg) : (L0 < nwg)) { const int L = memfirst ? L0 - nExtra : L0; int pm, pn; pg8::tile_order(L, nM, nN, pm, pn);
            if (memfirst) pn = pn == 0 ? nN - 1 : pn - 1;
            u.pm = pm; u.pn = pn; u.kind = 0; u.aux = 0;
            u.A = A + (size_t)pm * 256 * K * 2; u.B = B + (size_t)pn * 256 * K * 2; u.rows = nullptr; u.nt2 = 0; u.part = 0; return true; }
        const int x = memfirst ? L0 : L0 - nwg; if (x < 0 || x >= nExtra) return false;
        const int layer = x >> 2, pm = (x >> 1) & 1, pn = x & 1;
        u.pm = pm; u.pn = pn; u.kind = 1; u.aux = layer; u.A = memA + (size_t)pm * 256 * K * 2; u.B = memB + ((size_t)layer * 512 + (size_t)pn * 256) * K * 2; u.rows = nullptr; u.nt2 = 0; u.part = 0; return true;
    }
    __device__ __forceinline__ int pub_index(const Unit& u) const { return u.kind == 1 ? 64 + u.aux * 4 + u.pm * 2 + u.pn : (u.pn == nN - 1 ? u.pm : -1); }
};
#ifndef SKEW_CONV
#define SKEW_CONV 1
#endif
#ifndef TEST_S4_MIN_IDLE
#define TEST_S4_MIN_IDLE 32
#endif
#ifndef TEST_FORCE_SP
#define TEST_FORCE_SP 0
#endif
__device__ __forceinline__ int splitk_factor(int Rn, int G) { if (TEST_FORCE_SP) return G != 256 ? 1 : TEST_FORCE_SP; return G != 256 ? 1 : (Rn * 14 <= G ? 14 : (Rn * 7 <= G ? 7 : (Rn * 2 <= G ? 2 : 1))); }
struct SchedMoE {
    const char* A; const char* B; const int* rowtok; int K, G, c, nN; size_t bstride;
    int bstart[NEXP + 1];
    bool gather; bool streamk; int cx;
    __device__ __forceinline__ void init(const int* cnt) { int s = 0;
#pragma unroll
        for (int e = 0; e < NEXP; ++e) { bstart[e] = s; s += (__builtin_amdgcn_readfirstlane(cnt[e]) + 255) >> 8; } bstart[NEXP] = s; }
    __device__ __forceinline__ bool next(int i, Unit& u) const {
        const int total = bstart[NEXP] * nN; int L, t0 = 0, len = 0, part = 0, kd = 0;
        if (streamk) {
            const int nfr = total / G, Rn = total - nfr * G;
            if (i < nfr) L = i * G + ((G & 7) == 0 ? (c & 7) * (G >> 3) + (c >> 3) : c);
            else { const int NT2 = K / 128, Sp = splitk_factor(Rn, G);
                const int q_ = (i - nfr) * G + cx; if (q_ >= Rn * Sp) return false;
                const int ku = q_ / Rn; L = nfr * G + (q_ - ku * Rn); len = NT2 / Sp; t0 = ku * len; part = Sp > 1 ? 1 : 0; kd = ku; }
        } else { L = i * G + ((G & 7) == 0 ? (c & 7) * (G >> 3) + (c >> 3) : c); if (L >= total) return false; }
        int e = 0, bs = bstart[0], be = bstart[1];
#pragma unroll
        for (int k = 1; k < NEXP; ++k) if (L >= bstart[k] * nN) { e = k; bs = bstart[k]; be = bstart[k + 1]; }
        const int r = L - bs * nN, nb = be - bs;
        const int pg = r / (nb * 4), rem = r - pg * (nb * 4);
        const int pn = 4 * pg + (rem & 3), rb = bs + (rem >> 2);
        u.pm = rb; u.pn = pn; u.kind = kd; u.aux = e;
        u.A = (gather ? A : A + (size_t)rb * 256 * K * 2) + (size_t)t0 * 256; u.B = B + (size_t)e * bstride + (size_t)pn * 256 * K * 2 + (size_t)t0 * 256; u.rows = rowtok + rb * 256; u.nt2 = len; u.part = part; return true;
    }
};

#define SCHED_FENCE() __builtin_amdgcn_sched_barrier(0)
constexpr int EPI_LDS_OFF = RING_BYTES + 1024;
__device__ __forceinline__ void rows_rstd(float (&rs)[8], const LAS unsigned char* aux, const int (&rl)[8]) {
    f32x4 t[8];
#pragma unroll
    for (int g = 0; g < 8; ++g) t[g] = *(const LAS f32x4*)(aux + rl[g] * 16);
#pragma unroll
    for (int g = 0; g < 8; ++g) rs[g] = rsqrtf(((t[g][0] + t[g][1]) + (t[g][2] + t[g][3])) * (1.f / D) + RMS_EPS);
}
struct EpiQKV {
    static constexpr bool PERM = true; static constexpr int AUX_BYTES = 16;
    int wt_pn;
    long mem_delta;
    __device__ __forceinline__ const char* aux_src(const Unit& u) const { return (const char*)ssq + (u.kind == 0 ? 0L : mem_delta) + (size_t)u.pm * 256 * 16; }
    bf16_t* qkv; const float* ssq; const float* g_na; const float* g_dil; const float* g_mem;
    const float* rope; bf16_t* memkv; const float* ssqmem; const float* g_mem_all;
    LAS unsigned char* lds;
    __device__ __forceinline__ void operator()(f32x4 (&acc)[2][2][4][2], const Unit& u, int wr, int wc, int fr, int fq, const LAS unsigned char* aux) const {
        const float* gain = nullptr; bool do_rope = false; float sc = 1.f; bf16_t* out; int ldc, col0; const float* sq;
        if (u.kind == 0) {
            const int head = 4 * u.pn + wc; out = qkv + (size_t)head * NTOK * 64; ldc = 64; col0 = 0; sq = ssq;
            if (head < 6) { gain = g_na; sc = QSCALE; }
            else if (head < 12) { gain = g_na + 64; }
            else if (head < 18) { }
            else if (head < 24) { gain = g_dil; do_rope = true; sc = QSCALE; }
            else if (head < 30) { gain = g_dil + 64; do_rope = true; }
            else if (head < 36) { }
            else { gain = g_mem; sc = QSCALE; }
        } else {
            out = memkv + (size_t)u.aux * NMEM * 512; ldc = 512; col0 = 256 * u.pn + 64 * wc; sq = ssqmem;
            if (u.pn == 0) gain = g_mem_all + u.aux * 128 + 64;
        }
        int tok[8], rl[8]; (void)sq;
#pragma unroll
        for (int g = 0; g < 8; ++g) { rl[g] = (g >> 2) * 128 + wr * 64 + (g & 3) * 16 + fr; tok[g] = u.pm * 256 + rl[g]; }
        float rs[8]; rows_rstd(rs, aux, rl);
        f32x4 gv[2][2];
#pragma unroll
        for (int bj = 0; bj < 2; ++bj)
#pragma unroll
            for (int n = 0; n < 2; ++n) gv[bj][n] = gain ? *(const f32x4*)(gain + 32 * bj + 8 * fq + 4 * n) * sc : (f32x4){sc, sc, sc, sc};
#pragma unroll
        for (int g = 0; g < 8; ++g) {
            const int ai = g >> 2, m = g & 3; float r2 = rs[g];
            if (gain) {
                float ms = 0.f;
#pragma unroll
                for (int bj = 0; bj < 2; ++bj)
#pragma unroll
                    for (int n = 0; n < 2; ++n) { const f32x4 x = acc[ai][bj][m][n]; ms += (x[0] * x[0] + x[1] * x[1]) + (x[2] * x[2] + x[3] * x[3]); }
                ms = sum_x16(ms); ms = sum_x32(ms);
                r2 = rs[g] * rsqrtf(ms * rs[g] * rs[g] * (1.f / HD) + RMS_EPS);
            }
#pragma unroll
            for (int bj = 0; bj < 2; ++bj)
#pragma unroll
                for (int n = 0; n < 2; ++n) acc[ai][bj][m][n] = acc[ai][bj][m][n] * r2 * gv[bj][n];
        }
        u32x4 P[8][2];
        if (do_rope) {
            f32x4 rc[2][4];
#define ROPE_LD(g, slot) do { const float* rp_ = rope + (size_t)(tok[g] & (SEQ - 1)) * 64 + 8 * fq; rc[slot][0] = *(const f32x4*)(rp_); rc[slot][1] = *(const f32x4*)(rp_ + 4); rc[slot][2] = *(const f32x4*)(rp_ + 32); rc[slot][3] = *(const f32x4*)(rp_ + 36); } while (0)
            ROPE_LD(0, 0); ROPE_LD(1, 1);
#pragma unroll
            for (int g = 0; g < 8; ++g) { const int ai = g >> 2, m = g & 3;
#pragma unroll
                for (int n = 0; n < 2; ++n) { const f32x4 cs = rc[g & 1][n], sn = rc[g & 1][2 + n]; const f32x4 x1 = acc[ai][0][m][n], x2 = acc[ai][1][m][n];
                    acc[ai][0][m][n] = x1 * cs - x2 * sn; acc[ai][1][m][n] = x1 * sn + x2 * cs; }
                SCHED_FENCE();
                if (g + 2 < 8) { ROPE_LD(g + 2, g & 1); }
                SCHED_FENCE();
            }
#undef ROPE_LD
        }
#pragma unroll
        for (int g = 0; g < 8; ++g) { const int ai = g >> 2, m = g & 3;
#pragma unroll
            for (int bj = 0; bj < 2; ++bj) { const f32x4 a = acc[ai][bj][m][0], b = acc[ai][bj][m][1];
                P[g][bj].x = pk_bf16(a[0], a[1]); P[g][bj].y = pk_bf16(a[2], a[3]); P[g][bj].z = pk_bf16(b[0], b[1]); P[g][bj].w = pk_bf16(b[2], b[3]); } }
        if (u.kind == 1 || u.pn == wt_pn) {
#pragma unroll
            for (int g = 0; g < 8; ++g) { bf16_t* rowp = out + (size_t)tok[g] * ldc + col0 + 8 * fq; st16_wt(rowp, P[g][0]); st16_wt(rowp + 32, P[g][1]); }
        } else {
#pragma unroll
            for (int g = 0; g < 8; ++g) { bf16_t* rowp = out + (size_t)tok[g] * ldc + col0 + 8 * fq; *(u32x4*)(rowp) = P[g][0]; *(u32x4*)(rowp + 32) = P[g][1]; }
        }
    }
};
struct EpiResid {
    static constexpr bool PERM = true; static constexpr int AUX_BYTES = 0;
    __device__ __forceinline__ const char* aux_src(const Unit&) const { return nullptr; }
    bf16_t* hb; float* ssq_out; LAS unsigned char* lds; unsigned char* hb8; float asc;
    __device__ __forceinline__ void operator()(f32x4 (&acc)[2][2][4][2], const Unit& u, int wr, int wc, int fr, int fq, const LAS unsigned char*) const {
        const int col0 = u.pn * 256 + wc * 32 + 8 * fq;
        u32x4 rb[4][2];
#define RES_LD(g, slot) do { const bf16_t* p_ = hb + (size_t)(u.pm * 256 + ((g) >> 2) * 128 + wr * 64 + ((g) & 3) * 16 + fr) * D + col0; rb[slot][0] = *(const u32x4*)p_; rb[slot][1] = *(const u32x4*)(p_ + 128); } while (0)
        RES_LD(0, 0); RES_LD(1, 1); RES_LD(2, 2); RES_LD(3, 3);
        LAS float* red = (LAS float*)(lds + EPI_LDS_OFF);
#pragma unroll
        for (int g = 0; g < 8; ++g) { const int ai = g >> 2, m = g & 3; float s = 0.f;
#pragma unroll
            for (int bj = 0; bj < 2; ++bj) { const u32x4 r = rb[g & 3][bj];
                f32x4 h0 = acc[ai][bj][m][0] * asc, h1 = acc[ai][bj][m][1] * asc;
                h0[0] += bf_lo(r.x); h0[1] += bf_hi(r.x); h0[2] += bf_lo(r.y); h0[3] += bf_hi(r.y); h1[0] += bf_lo(r.z); h1[1] += bf_hi(r.z); h1[2] += bf_lo(r.w); h1[3] += bf_hi(r.w);
                acc[ai][bj][m][0] = h0; acc[ai][bj][m][1] = h1;
                s += ((h0[0] * h0[0] + h0[1] * h0[1]) + (h0[2] * h0[2] + h0[3] * h0[3])) + ((h1[0] * h1[0] + h1[1] * h1[1]) + (h1[2] * h1[2] + h1[3] * h1[3])); }
            SCHED_FENCE();
            if (g + 4 < 8) { RES_LD(g + 4, g & 3); }
            SCHED_FENCE();
            s = sum_x16(s); s = sum_x32(s);
            if (fq == 0) red[(ai * 128 + wr * 64 + m * 16 + fr) * 4 + wc] = s; }
#undef RES_LD
        asm volatile("s_waitcnt lgkmcnt(0)" ::: "memory"); __builtin_amdgcn_s_barrier(); asm volatile("" ::: "memory");
        { const int t = (wr * 4 + wc) * 64 + fq * 16 + fr; if (t < 256) { const f32x4 p = *(const LAS f32x4*)(red + t * 4); ssq_out[(size_t)(u.pm * 256 + t) * 4 + u.pn] = (p[0] + p[1]) + (p[2] + p[3]); } }
#pragma unroll
        for (int g = 0; g < 8; ++g) { const int ai = g >> 2, m = g & 3; const size_t off = (size_t)(u.pm * 256 + ai * 128 + wr * 64 + m * 16 + fr) * D + col0;
#pragma unroll
            for (int bj = 0; bj < 2; ++bj) { const f32x4 h0 = acc[ai][bj][m][0], h1 = acc[ai][bj][m][1];
                u32x4 w; w.x = pk_bf16(h0[0], h0[1]); w.y = pk_bf16(h0[2], h0[3]); w.z = pk_bf16(h1[0], h1[1]); w.w = pk_bf16(h1[2], h1[3]); *(u32x4*)(hb + off + bj * 128) = w;
                if (hb8) { u32x2 w8; w8.x = pk4_fp8(h0[0], h0[1], h0[2], h0[3]); w8.y = pk4_fp8(h1[0], h1[1], h1[2], h1[3]); *(u32x2*)(hb8 + off + bj * 128) = w8; } } }
        asm volatile("s_waitcnt lgkmcnt(0)" ::: "memory"); __builtin_amdgcn_s_barrier(); asm volatile("" ::: "memory");
    }
};
template <bool MOE> struct EpiSwiGLU {
    static constexpr bool PERM = true; static constexpr int AUX_BYTES = MOE ? 4 : 16;
    bf16_t* H; int ldh; const float* ssq; const float* rowrstd; unsigned char* H8; float ascale, oscale;
    __device__ __forceinline__ const char* aux_src(const Unit& u) const { return MOE ? (const char*)(rowrstd + (size_t)u.pm * 256) : (const char*)(ssq + (size_t)u.pm * 256 * 4); }
    __device__ __forceinline__ void operator()(f32x4 (&acc)[2][2][4][2], const Unit& u, int wr, int wc, int fr, int fq, const LAS unsigned char* aux) const {
        const int col0 = u.pn * 128 + wc * 32 + 8 * fq;
        int rl[8];
#pragma unroll
        for (int g = 0; g < 8; ++g) rl[g] = (g >> 2) * 128 + wr * 64 + (g & 3) * 16 + fr;
        float rs[8];
        if constexpr (MOE) {
#pragma unroll
            for (int g = 0; g < 8; ++g) rs[g] = *(const LAS float*)(aux + rl[g] * 4);
        } else rows_rstd(rs, aux, rl);
#pragma unroll
        for (int g = 0; g < 8; ++g) { const int ai = g >> 2, m = g & 3; unsigned wv[4];
            const float a_ = rs[g] * ascale, ic_ = __builtin_amdgcn_rcpf(a_ * a_ * (H8 ? oscale : 1.f)); const f32x2 aL2 = {-a_ * LOG2E, -a_ * LOG2E}, ic2 = {ic_, ic_};
#pragma unroll
            for (int n = 0; n < 2; ++n) { const f32x4 G4 = acc[ai][0][m][n], U4 = acc[ai][1][m][n]; float o[4];
#pragma unroll
                for (int h = 0; h < 2; ++h) { const f32x2 Gh = {G4[2 * h], G4[2 * h + 1]}, Uh = {U4[2 * h], U4[2 * h + 1]}; const f32x2 p = Gh * Uh, x = Gh * aL2;
                    f32x2 e; e.x = __builtin_amdgcn_exp2f(x.x); e.y = __builtin_amdgcn_exp2f(x.y); const f32x2 d = e * ic2 + ic2;
                    f32x2 r; r.x = __builtin_amdgcn_rcpf(d.x); r.y = __builtin_amdgcn_rcpf(d.y); const f32x2 q = p * r; o[2 * h] = q.x; o[2 * h + 1] = q.y; }
                if (H8) { wv[n] = pk4_fp8(__builtin_amdgcn_fmed3f(o[0], -448.f, 448.f), __builtin_amdgcn_fmed3f(o[1], -448.f, 448.f), __builtin_amdgcn_fmed3f(o[2], -448.f, 448.f), __builtin_amdgcn_fmed3f(o[3], -448.f, 448.f)); }
                else { wv[2 * n] = pk_bf16(o[0], o[1]); wv[2 * n + 1] = pk_bf16(o[2], o[3]); } }
            if (H8) { u32x2 w2; w2.x = wv[0]; w2.y = wv[1]; *(u32x2*)(H8 + (size_t)(u.pm * 256 + rl[g]) * ldh + col0) = w2; }
            else { u32x4 w4; w4.x = wv[0]; w4.y = wv[1]; w4.z = wv[2]; w4.w = wv[3]; *(u32x4*)(H + (size_t)(u.pm * 256 + rl[g]) * ldh + col0) = w4; }
            SCHED_FENCE(); }
    }
};
struct EpiMoEDown {
    static constexpr bool PERM = true; static constexpr int AUX_BYTES = 4, STORES = 16;
    __device__ __forceinline__ const char* aux_src(const Unit& u) const { return (const char*)(rowgate + (size_t)u.pm * 256); }
    bf16_t* Y; const float* rowgate; float sc; long pdelta;
    __device__ __forceinline__ void operator()(f32x4 (&acc)[2][2][4][2], const Unit& u, int wr, int wc, int fr, int fq, const LAS unsigned char* aux) const {
        const int col0 = u.pn * 256 + wc * 32 + 8 * fq;
        float gt[8];
#pragma unroll
        for (int g = 0; g < 8; ++g) gt[g] = *(const LAS float*)(aux + ((g >> 2) * 128 + wr * 64 + (g & 3) * 16 + fr) * 4) * sc;
        u32x4 W[8][2];
#pragma unroll
        for (int g = 0; g < 8; ++g) { const int ai = g >> 2, m = g & 3;
#pragma unroll
            for (int bj = 0; bj < 2; ++bj) { const f32x4 a = acc[ai][bj][m][0] * gt[g], b = acc[ai][bj][m][1] * gt[g];
                W[g][bj].x = pk_bf16(a[0], a[1]); W[g][bj].y = pk_bf16(a[2], a[3]); W[g][bj].z = pk_bf16(b[0], b[1]); W[g][bj].w = pk_bf16(b[2], b[3]); } }
        char* yo = (char*)Y + (u.part == 1 ? pdelta + (long)u.kind * (long)YPART_STRIDE : 0L);
#pragma unroll
        for (int g = 0; g < 8; ++g) { const int row = u.pm * 256 + (g >> 2) * 128 + wr * 64 + (g & 3) * 16 + fr; bf16_t* yp = (bf16_t*)yo + (size_t)row * D + col0; *(u32x4*)yp = W[g][0]; *(u32x4*)(yp + 128) = W[g][1]; }
    }
};

#define XB_TMO      128
#define XB_XCNT(j)  (256  + 64 * (j))
#define XB_XSUB(j)  (1280 + 64 * (j))
#define XB_XGEN(j)  (2304 + 64 * (j))
#define XB_TOP      3328
#define XB_TOPGEN   3392
#define XCD_BAR_WORDS 3456
#define XB_SPIN_CAP (1u << 20)
__device__ __forceinline__ unsigned xb_ld(unsigned* p)              { return __hip_atomic_load(p, __ATOMIC_RELAXED, __HIP_MEMORY_SCOPE_AGENT); }
__device__ __forceinline__ unsigned xb_add(unsigned* p, unsigned v) { return __hip_atomic_fetch_add(p, v, __ATOMIC_RELAXED, __HIP_MEMORY_SCOPE_AGENT); }
__device__ __forceinline__ unsigned xb_xcc_id() { return (unsigned)__builtin_amdgcn_s_getreg((3 << 11) | 20) & 0xFu; }
#define XB_SPIN(cond, bar) do { unsigned _sp = 0; while (cond) { __builtin_amdgcn_s_sleep(1); \
    if ((++_sp & 255u) == 0u) { if (xb_ld(&(bar)[XB_TMO])) break; if (_sp > XB_SPIN_CAP) { atomicAdd(&(bar)[XB_TMO], 1u); break; } } } } while (0)
struct XcdBarrier { unsigned* bar; unsigned x; volatile LAS unsigned* st; int w; };
__device__ __forceinline__ XcdBarrier xcd_barrier_post(unsigned* bar, volatile LAS unsigned* st, int wave) {
    XcdBarrier b; b.bar = bar; b.x = xb_xcc_id(); b.st = st; b.w = wave;
    if (wave == 0 && lane_id_now() == 0) (void)xb_add(&bar[XB_XCNT(b.x)], 1u);
    return b;
}
__device__ __forceinline__ void xcd_barrier_complete(unsigned* bar, unsigned x, unsigned& nloc, unsigned& nx) {
    const unsigned G = gridDim.x * gridDim.y * gridDim.z;
    unsigned sum, cnt, mine, sp = 0u;
    for (;;) {
        sum = 0u; cnt = 0u; mine = 0u;
#pragma unroll
        for (unsigned j = 0; j < 16; ++j) { const unsigned c = xb_ld(&bar[XB_XCNT(j)]); sum += c; cnt += (c > 0u) ? 1u : 0u; mine = (j == x) ? c : mine; }
        if (sum == G) break;
        __builtin_amdgcn_s_sleep(1);
        if ((++sp & 255u) == 0u) { if (xb_ld(&bar[XB_TMO])) break; if (sp > XB_SPIN_CAP) { atomicAdd(&bar[XB_TMO], 1u); break; } }
    }
    nloc = mine > 0u ? mine : 1u; nx = cnt > 0u ? cnt : 1u;
}
__device__ __forceinline__ void xcd_barrier(const XcdBarrier& b) {
    asm volatile("s_waitcnt vmcnt(0)" ::: "memory");
    __syncthreads();
    if (b.w == 0 && lane_id_now() == 0) {
        unsigned* bar = b.bar;
        __builtin_amdgcn_s_waitcnt(0);
        unsigned nloc = b.st[0], nx = b.st[1];
        if (nloc == 0u) { xcd_barrier_complete(bar, b.x, nloc, nx); b.st[0] = nloc; b.st[1] = nx; }
        const unsigned old = xb_add(&bar[XB_XSUB(b.x)], 1u);
        const unsigned gen = old / nloc;
        if (old + 1u == (gen + 1u) * nloc) {
            __builtin_amdgcn_fence(__ATOMIC_RELEASE, "agent");
            asm volatile("s_waitcnt vmcnt(0)" ::: "memory");
            const unsigned og = xb_add(&bar[XB_TOP], 1u);
            const unsigned tg = og / nx;
            if (og + 1u == (tg + 1u) * nx) xb_add(&bar[XB_TOPGEN], 1u);
            else XB_SPIN(xb_ld(&bar[XB_TOPGEN]) == tg, bar);
            __builtin_amdgcn_fence(__ATOMIC_ACQUIRE, "agent");
            xb_add(&bar[XB_XGEN(b.x)], 1u);
            asm volatile("s_waitcnt vmcnt(0)" ::: "memory");
        } else {
            XB_SPIN(xb_ld(&bar[XB_XGEN(b.x)]) == gen, bar);
            __builtin_amdgcn_fence(__ATOMIC_ACQUIRE, "agent");
            asm volatile("s_waitcnt vmcnt(0)" ::: "memory");
        }
    }
    __syncthreads();
}
constexpr int CW_BAR = 1024;
constexpr int MISC_OFF = RING_BYTES + 320;
static_assert((CW_BAR + XCD_BAR_WORDS) * 4 <= (int)CTL_BYTES, "barrier words inside the memset region");

struct Args {
    const float* x; const float* mem; const float* g_attn; const float* w_in; const float* g_qk_na; const float* rpb_na; const float* g_qk_dil; const float* g_mem;
    const float* w_mem_kv; const float* g_qk_mem; const float* g_out; const float* w_out; const float* g_ffn; const float* w_gate_d; const float* w_up_d; const float* w_down_d;
    const float* w_router; const float* w_gate_m; const float* w_up_m; const float* w_down_m;
    float* out; unsigned char* ws; int ph_lo, ph_hi;
};

__device__ __forceinline__ void conv_item(const float* W, int K, int N, const float* gain, bf16_t* WT, int k0, int n0, int dst_row0, LAS float* scr, int lane) {
    const int r8 = lane >> 3, c4 = (lane & 7) * 4;
#pragma unroll
    for (int i = 0; i < 8; ++i) { const int kk = 8 * i + r8; const f32x4 v = *(const f32x4*)(W + (size_t)(k0 + kk) * N + n0 + c4);
        const float g = gain ? gain[k0 + kk] : 1.f; LAS float* s = scr + kk * 33 + c4; s[0] = v[0] * g; s[1] = v[1] * g; s[2] = v[2] * g; s[3] = v[3] * g; }
    asm volatile("s_waitcnt lgkmcnt(0)" ::: "memory");
    const int c = lane & 7;
#pragma unroll
    for (int j = 0; j < 4; ++j) { const int n = (lane >> 3) + 8 * j; const LAS float* s = scr + (8 * c) * 33 + n;
        u32x4 o; o.x = pk_bf16(s[0 * 33], s[1 * 33]); o.y = pk_bf16(s[2 * 33], s[3 * 33]); o.z = pk_bf16(s[4 * 33], s[5 * 33]); o.w = pk_bf16(s[6 * 33], s[7 * 33]);
        *(u32x4*)(WT + (size_t)(dst_row0 + n) * K + k0 + 8 * c) = o; }
    asm volatile("s_waitcnt lgkmcnt(0)" ::: "memory");
}
__device__ __forceinline__ void conv_item8(const float* W, int K, int N, const float* gain, float scale, unsigned char* WT, int k0, int n0, int dst_row0, LAS float* scr, int lane) {
    const int r8 = lane >> 3, c4 = (lane & 7) * 4;
#pragma unroll
    for (int i = 0; i < 8; ++i) { const int kk = 8 * i + r8; const f32x4 v = *(const f32x4*)(W + (size_t)(k0 + kk) * N + n0 + c4);
        const float g = (gain ? gain[k0 + kk] : 1.f) * scale; LAS float* s = scr + kk * 33 + c4; s[0] = v[0] * g; s[1] = v[1] * g; s[2] = v[2] * g; s[3] = v[3] * g; }
    asm volatile("s_waitcnt lgkmcnt(0)" ::: "memory");
    const int c = lane & 7;
#pragma unroll
    for (int j = 0; j < 4; ++j) { const int n = (lane >> 3) + 8 * j; const LAS float* s = scr + (8 * c) * 33 + n;
        u32x2 o; o.x = pk4_fp8(s[0 * 33], s[1 * 33], s[2 * 33], s[3 * 33]); o.y = pk4_fp8(s[4 * 33], s[5 * 33], s[6 * 33], s[7 * 33]);
        *(u32x2*)(WT + (size_t)(dst_row0 + n) * K + k0 + 8 * c) = o; }
    asm volatile("s_waitcnt lgkmcnt(0)" ::: "memory");
}
__device__ __forceinline__ int map_head(int n) { const int head = n >> 6, d = n & 63; return 256 * (head >> 2) + 128 * (d >> 5) + 32 * (head & 3) + (d & 31); }
__device__ __forceinline__ int map_gate(int n) { return 256 * (n >> 7) + (n & 127); }
__device__ __forceinline__ int map_up(int n) { return 256 * (n >> 7) + 128 + (n & 127); }

__device__ __forceinline__ void attn_key(const bf16_t* kp, const bf16_t* vp, const float (&q)[64], float bias, float& m, float& l, float (&o)[64]) {
    float s = bias;
#pragma unroll
    for (int c = 0; c < 8; ++c) { const u32x4 kk = *(const u32x4*)(kp + 8 * c);
        s += q[8 * c + 0] * bf_lo(kk.x) + q[8 * c + 1] * bf_hi(kk.x) + q[8 * c + 2] * bf_lo(kk.y) + q[8 * c + 3] * bf_hi(kk.y)
           + q[8 * c + 4] * bf_lo(kk.z) + q[8 * c + 5] * bf_hi(kk.z) + q[8 * c + 6] * bf_lo(kk.w) + q[8 * c + 7] * bf_hi(kk.w); }
    const float mn = fmaxf(m, s), a = exp2f(m - mn), p = exp2f(s - mn);
    l = l * a + p; m = mn;
#pragma unroll
    for (int c = 0; c < 8; ++c) { const u32x4 vv = *(const u32x4*)(vp + 8 * c);
        o[8 * c + 0] = o[8 * c + 0] * a + p * bf_lo(vv.x); o[8 * c + 1] = o[8 * c + 1] * a + p * bf_hi(vv.x);
        o[8 * c + 2] = o[8 * c + 2] * a + p * bf_lo(vv.y); o[8 * c + 3] = o[8 * c + 3] * a + p * bf_hi(vv.y);
        o[8 * c + 4] = o[8 * c + 4] * a + p * bf_lo(vv.z); o[8 * c + 5] = o[8 * c + 5] * a + p * bf_hi(vv.z);
        o[8 * c + 6] = o[8 * c + 6] * a + p * bf_lo(vv.w); o[8 * c + 7] = o[8 * c + 7] * a + p * bf_hi(vv.w); }
}
__device__ __forceinline__ void attn_scalar_phase(const bf16_t* qkv, const bf16_t* memkv, const float* rpb, bf16_t* O, float* ssqh, int G) {
    int tidp = threadIdx.x; asm volatile("" : "+v"(tidp));
    for (int idx = blockIdx.x * 512 + tidp; idx < NTOK * 16; idx += G * 512) {
        const int head = idx / NTOK, tok = idx % NTOK, b = tok / SEQ, t = tok % SEQ;
        int qcol; if (head < 6) qcol = QKV_QA + 64 * head; else if (head < 12) qcol = QKV_QB + 64 * (head - 6); else qcol = QKV_QM + 64 * (head - 12);
        float q[64], o[64];
        { const bf16_t* qp = qkv + (size_t)tok * IN_W + qcol;
#pragma unroll
          for (int c = 0; c < 8; ++c) { const u32x4 kk = *(const u32x4*)(qp + 8 * c); q[8 * c + 0] = bf_lo(kk.x); q[8 * c + 1] = bf_hi(kk.x); q[8 * c + 2] = bf_lo(kk.y); q[8 * c + 3] = bf_hi(kk.y);
              q[8 * c + 4] = bf_lo(kk.z); q[8 * c + 5] = bf_hi(kk.z); q[8 * c + 6] = bf_lo(kk.w); q[8 * c + 7] = bf_hi(kk.w); } }
#pragma unroll
        for (int d = 0; d < 64; ++d) o[d] = 0.f;
        float m = -1e30f, l = 0.f;
        if (head < 6) {
            const int r = t >> 6, c = t & 63; int rs = r - 4; rs = rs < 0 ? 0 : (rs > 120 ? 120 : rs); int cs = c - 8; cs = cs < 0 ? 0 : (cs > 48 ? 48 : cs);
            const float* bp = rpb + head * 465;
            for (int i = 0; i < 8; ++i) for (int j = 0; j < 16; ++j) {
                const int kt = b * SEQ + (rs + i) * 64 + cs + j; const float bias = bp[(rs + i - r + 7) * 31 + (cs + j - c + 15)] * LOG2E;
                attn_key(qkv + (size_t)kt * IN_W + QKV_KA + 64 * head, qkv + (size_t)kt * IN_W + QKV_VA + 64 * head, q, bias, m, l, o); }
        } else if (head < 12) {
            const int hh = head - 6;
            for (int g = 0; g < 3; ++g) { const int dd = g == 0 ? 1 : (g == 1 ? 4 : 16);
                for (int j = -64; j <= 64; ++j) { const int pos = t + dd * j; if (pos < 0 || pos >= SEQ) continue; const int kt = b * SEQ + pos;
                    attn_key(qkv + (size_t)kt * IN_W + QKV_KB + 64 * hh, qkv + (size_t)kt * IN_W + QKV_VB + 64 * hh, q, 0.f, m, l, o); } }
        } else {
            const int hh = head - 12;
            for (int j = 0; j < MEMLEN; ++j) { const bf16_t* kp = memkv + (size_t)(b * MEMLEN + j) * 512 + 64 * hh; attn_key(kp, kp + 256, q, 0.f, m, l, o); }
        }
        const float il = 1.f / l; float ss = 0.f; bf16_t* op = O + (size_t)tok * D + 64 * head;
#pragma unroll
        for (int c = 0; c < 8; ++c) { float v[8];
#pragma unroll
            for (int e = 0; e < 8; ++e) { v[e] = o[8 * c + e] * il; ss += v[e] * v[e]; }
            u32x4 w; w.x = pk_bf16(v[0], v[1]); w.y = pk_bf16(v[2], v[3]); w.z = pk_bf16(v[4], v[5]); w.w = pk_bf16(v[6], v[7]); *(u32x4*)(op + 8 * c) = w; }
        ssqh[(size_t)tok * 16 + head] = ss;
    }
}

typedef float f32x16 __attribute__((ext_vector_type(16)));
typedef short s16x4 __attribute__((ext_vector_type(4)));
typedef short v4i16_t __attribute__((ext_vector_type(4)));
#define MFMA32(a, b, c) __builtin_amdgcn_mfma_f32_32x32x16_bf16((a), (b), (c), 0, 0, 0)
__device__ __forceinline__ s16x4 tr_read(const LAS unsigned char* p) { return __builtin_bit_cast(s16x4, __builtin_amdgcn_ds_read_tr16_b64_v4i16((LAS v4i16_t*)p)); }
constexpr int ATT_TAB_OFF = 139264;
struct AttnSt { f32x16 o0, o1; float m, l; bf16x8 q[4]; };

template <int MODE, bool LDSRES = false, bool ONESET = false>
__device__ __forceinline__ void attn_blocks(AttnSt& st, LAS unsigned char* vbuf, const bf16_t* kb, const bf16_t* vb, const int pitch, const int tokbase,
                                            const int t0, const int blockstep, const int dstep, const int tmax, const int nblk, const int lane_in,
                                            const int p0, const int p1, const int p2, const LAS float* tab) {
    int lane_o = lane_in; asm volatile("" : "+v"(lane_o)); const int lane = lane_o;
    const int r32 = lane & 31, hi = lane >> 5;
    const int vkey = lane >> 3, vch = lane & 7;
    const int w0 = vkey * 128 + (((vch >> 2) ^ ((lane >> 4) & 1)) << 6) + (vch & 3) * 16;
    const int q4 = (lane & 15) >> 2;
    const int rb0 = (4 * hi + q4) * 128 + (((q4 >> 1) & 1) << 6) + 32 * ((lane >> 4) & 1) + 8 * (lane & 3);
    u32x4 kA[4], kB[4], vA[4], vB[4];
    const int wk0 = vkey * 128 + ((vch ^ (vkey >> 1)) << 4), wk1 = vkey * 128 + ((vch ^ (vkey >> 1) ^ 4) << 4);
    const int kx = (r32 >> 1) & 7;
    const int rk0 = r32 * 128 + (((0 + hi) ^ kx) << 4), rk1 = r32 * 128 + (((2 + hi) ^ kx) << 4), rk2 = r32 * 128 + (((4 + hi) ^ kx) << 4), rk3 = r32 * 128 + (((6 + hi) ^ kx) << 4);
#define ATT_TOK(j, i) (tokbase + min(max(t0 + (j) * blockstep + (i) * dstep, 0), tmax))
#define ATT_LOAD(j, KR, VR) do { \
        _Pragma("unroll") for (int i_ = 0; i_ < 4; ++i_) { const size_t ro_ = (size_t)ATT_TOK(j, vkey + 8 * i_) * pitch + 8 * vch; KR[i_] = *(const u32x4*)(kb + ro_); VR[i_] = *(const u32x4*)(vb + ro_); } } while (0)
#define ATT_QK(S, ks_) do { \
        const bf16x8 kf0 = *(const LAS bf16x8*)((ks_) + rk0), kf1 = *(const LAS bf16x8*)((ks_) + rk1), kf2 = *(const LAS bf16x8*)((ks_) + rk2), kf3 = *(const LAS bf16x8*)((ks_) + rk3); \
        _Pragma("unroll") for (int r = 0; r < 16; ++r) S[r] = 0.f; \
        S = MFMA32(kf0, st.q[0], S); S = MFMA32(kf1, st.q[1], S); S = MFMA32(kf2, st.q[2], S); S = MFMA32(kf3, st.q[3], S); } while (0)
#define ATT_MASK(S, j) do { \
        int mlo = 0, mcnt = 32; \
        if (MODE == 0) { mlo = -p1; mcnt = ((unsigned)(p0 + (j)) < 8u) ? 16 : 0; } \
        else if (MODE == 1) { const int b0_ = p0 + 32 * (j); mlo = max(p2 - 64, 0) - b0_; mcnt = max(min(p2 + 64, p1 - 1) - b0_ - mlo + 1, 0); } \
        const bool allv = (MODE == 2) || __all(mlo <= 0 && mlo + mcnt >= 32); \
        if (MODE == 0) { _Pragma("unroll") for (int r = 0; r < 16; ++r) S[r] += tab[p2 + 64 * (j) + (r & 3) + 8 * (r >> 2) + 4 * hi]; } \
        if (!allv) { const int e0_ = 4 * hi - mlo; \
            _Pragma("unroll") for (int r = 0; r < 16; ++r) S[r] = ((unsigned)(e0_ + (r & 3) + 8 * (r >> 2)) < (unsigned)mcnt) ? S[r] : -INFINITY; } } while (0)
#define ATT_MAX16(S) fmaxf(fmaxf(fmaxf(fmaxf(S[0], S[1]), fmaxf(S[2], S[3])), fmaxf(fmaxf(S[4], S[5]), fmaxf(S[6], S[7]))), fmaxf(fmaxf(fmaxf(S[8], S[9]), fmaxf(S[10], S[11])), fmaxf(fmaxf(S[12], S[13]), fmaxf(S[14], S[15]))))
#define ATT_SUM16(S) ((((S[0] + S[1]) + (S[2] + S[3])) + ((S[4] + S[5]) + (S[6] + S[7]))) + (((S[8] + S[9]) + (S[10] + S[11])) + ((S[12] + S[13]) + (S[14] + S[15]))))
#define ATT_PV(S, vs_) do { \
        bf16x8 pb[2]; \
        _Pragma("unroll") for (int s = 0; s < 2; ++s) { u32x4 w; w.x = pk_bf16(S[8 * s + 0], S[8 * s + 1]); w.y = pk_bf16(S[8 * s + 2], S[8 * s + 3]); w.z = pk_bf16(S[8 * s + 4], S[8 * s + 5]); w.w = pk_bf16(S[8 * s + 6], S[8 * s + 7]); \
            pb[s] = __builtin_bit_cast(bf16x8, w); } \
        _Pragma("unroll") for (int s = 0; s < 2; ++s) { \
            const s16x4 a0 = tr_read((vs_) + rb0 + s * 2048), a1 = tr_read((vs_) + rb0 + s * 2048 + 1024); \
            const s16x4 b0 = tr_read((vs_) + (rb0 ^ 64) + s * 2048), b1 = tr_read((vs_) + (rb0 ^ 64) + s * 2048 + 1024); \
            const bf16x8 va = (bf16x8){a0[0], a0[1], a0[2], a0[3], a1[0], a1[1], a1[2], a1[3]}; \
            const bf16x8 vb8 = (bf16x8){b0[0], b0[1], b0[2], b0[3], b1[0], b1[1], b1[2], b1[3]}; \
            st.o0 = MFMA32(va, pb[s], st.o0); st.o1 = MFMA32(vb8, pb[s], st.o1); } } while (0)
#define ATT_BODY(j, KR, VR) do { \
        LAS unsigned char* ks = LDSRES ? vbuf + (j) * 8192 : vbuf; LAS unsigned char* vs = ks + 4096; \
        if constexpr (!LDSRES) { \
        *(LAS u32x4*)(ks + wk0) = KR[0]; *(LAS u32x4*)(ks + wk1 + 1024) = KR[1]; *(LAS u32x4*)(ks + wk0 + 2048) = KR[2]; *(LAS u32x4*)(ks + wk1 + 3072) = KR[3]; \
        _Pragma("unroll") for (int i = 0; i < 4; ++i) *(LAS u32x4*)(vs + w0 + i * 1024) = VR[i]; \
        if ((j) + (ONESET ? 1 : 2) < nblk) { ATT_LOAD((j) + (ONESET ? 1 : 2), KR, VR); } } \
        f32x16 S; ATT_QK(S, ks); ATT_MASK(S, (j)); \
        float bm = ATT_MAX16(S); \
        { auto rr_ = __builtin_amdgcn_permlane32_swap(__float_as_uint(bm), __float_as_uint(bm), false, false); bm = fmaxf(__uint_as_float(rr_[0]), __uint_as_float(rr_[1])); } \
        const float mn = fmaxf(st.m, bm), alpha = __builtin_amdgcn_exp2f(st.m - mn); st.m = mn; \
        _Pragma("unroll") for (int r = 0; r < 16; ++r) S[r] = __builtin_amdgcn_exp2f(S[r] - mn); \
        st.l = st.l * alpha + ATT_SUM16(S); \
        if (__any(alpha != 1.f)) { _Pragma("unroll") for (int r = 0; r < 16; ++r) { st.o0[r] *= alpha; st.o1[r] *= alpha; } } \
        ATT_PV(S, vs); \
    } while (0)
#define ATT_BODY2(j) do { \
        LAS unsigned char* ks0 = vbuf + (j) * 8192; LAS unsigned char* ks1 = ks0 + 8192; \
        f32x16 S0, S1; ATT_QK(S0, ks0); ATT_QK(S1, ks1); ATT_MASK(S0, (j)); ATT_MASK(S1, (j) + 1); \
        float bm = fmaxf(ATT_MAX16(S0), ATT_MAX16(S1)); \
        { auto rr_ = __builtin_amdgcn_permlane32_swap(__float_as_uint(bm), __float_as_uint(bm), false, false); bm = fmaxf(__uint_as_float(rr_[0]), __uint_as_float(rr_[1])); } \
        const float mn = fmaxf(st.m, bm), alpha = __builtin_amdgcn_exp2f(st.m - mn); st.m = mn; \
        _Pragma("unroll") for (int r = 0; r < 16; ++r) { S0[r] = __builtin_amdgcn_exp2f(S0[r] - mn); S1[r] = __builtin_amdgcn_exp2f(S1[r] - mn); } \
        st.l = st.l * alpha + (ATT_SUM16(S0) + ATT_SUM16(S1)); \
        if (__any(alpha != 1.f)) { _Pragma("unroll") for (int r = 0; r < 16; ++r) { st.o0[r] *= alpha; st.o1[r] *= alpha; } } \
        ATT_PV(S0, ks0 + 4096); ATT_PV(S1, ks1 + 4096); \
    } while (0)
    if constexpr (LDSRES) {
        for (int j = 0; j < nblk; ++j) ATT_BODY(j, kA, vA);
    } else if constexpr (ONESET) {
        ATT_LOAD(0, kA, vA);
        for (int j = 0; j < nblk; ++j) ATT_BODY(j, kA, vA);
    } else {
        ATT_LOAD(0, kA, vA); if (nblk > 1) { ATT_LOAD(1, kB, vB); }
        for (int j = 0; j < nblk; j += 2) {
            ATT_BODY(j, kA, vA);
            if (j + 1 < nblk) ATT_BODY(j + 1, kB, vB);
        }
    }
#undef ATT_BODY
#undef ATT_BODY2
#undef ATT_QK
#undef ATT_MASK
#undef ATT_MAX16
#undef ATT_SUM16
#undef ATT_PV
#undef ATT_TOK
#undef ATT_LOAD
}

constexpr int COOP_MEM = 256, COOP_DIL = 1152, COOP_NA = 384;
constexpr int ATT_Q_NA = 384;
constexpr int ATT_STG_OFF = 98304;
struct TileQ { int tb, sa, sb, headg, pat; const bf16_t* qbase; };
__device__ __forceinline__ void coop_tile(int it, int wave, const bf16_t* qkv, TileQ& t, int& decq0, int& dd) {
    if (it < COOP_MEM) { const int b = it >> 7, h = (it >> 5) & 3, grp = it & 31; t.tb = b * SEQ + 256 * grp + 32 * wave; t.sa = 16; t.sb = 1; t.headg = 12 + h; t.pat = -1; t.qbase = qkv + (size_t)(QKV_QM / 64 + h) * NTOK * 64; decq0 = 0; dd = 1; }
    else if (it >= COOP_MEM + COOP_DIL) { const int x = 8 * (it - COOP_MEM - COOP_DIL) + wave, b = x / 1536, rem = x % 1536, h = rem >> 8, rp = (rem >> 2) & 63, cgp = rem & 3;
        t.tb = b * SEQ + 2 * rp * 64 + 16 * cgp; t.sa = 64; t.sb = 1; t.headg = h; t.pat = -1; t.qbase = qkv + (size_t)(QKV_QA / 64 + h) * NTOK * 64; decq0 = x; dd = 1; }
    else { const int x = it - COOP_MEM, hb = x / 96, r = x % 96, grp = r & 31, b = hb / 6, h = hb % 6, pat = r >> 5;
        const int d = pat == 0 ? 1 : (pat == 1 ? 4 : 16), cls = pat == 0 ? 0 : (pat == 1 ? (grp >> 3) : (grp >> 1)), g0 = pat == 0 ? 256 * grp : (pat == 1 ? 256 * (grp & 7) : 256 * (grp & 1));
        decq0 = g0 + 32 * wave; dd = d; t.tb = b * SEQ + cls + d * decq0; t.sa = 16 * d; t.sb = d; t.headg = 6 + h; t.pat = pat; t.qbase = qkv + (size_t)(QKV_QB / 64 + h) * NTOK * 64; }
}
__device__ __forceinline__ void attn_epilogue(const AttnSt& st, const TileQ& t, LAS unsigned char* stg, bf16_t* O, bf16_t* PO, float* Pml, int lane_in) {
    int lane = lane_in; asm volatile("" : "+v"(lane));
    const int r32 = lane & 31, hi = lane >> 5;
    const float lt = sum_x32(st.l), inv = t.pat < 0 ? 1.f / lt : 1.f;
    LAS unsigned char* wrow = stg + r32 * 128; const int sx = r32 & 15;
#pragma unroll
    for (int g = 0; g < 4; ++g) {
        u32x2 w0v; w0v.x = pk_bf16(st.o0[4 * g] * inv, st.o0[4 * g + 1] * inv); w0v.y = pk_bf16(st.o0[4 * g + 2] * inv, st.o0[4 * g + 3] * inv); *(LAS u32x2*)(wrow + (((2 * g + hi) ^ sx) << 3)) = w0v;
        u32x2 w1v; w1v.x = pk_bf16(st.o1[4 * g] * inv, st.o1[4 * g + 1] * inv); w1v.y = pk_bf16(st.o1[4 * g + 2] * inv, st.o1[4 * g + 3] * inv); *(LAS u32x2*)(wrow + (((8 + 2 * g + hi) ^ sx) << 3)) = w1v;
    }
    if (t.pat >= 0 && hi == 0) { const int tok = t.tb + t.sa * (r32 >> 4) + t.sb * (r32 & 15); f32x2 ml; ml[0] = st.m; ml[1] = lt; *(f32x2*)(Pml + (((size_t)t.pat * NTOK + tok) * 6 + (t.headg - 6)) * 2) = ml; }
    const int c = lane & 7;
#pragma unroll
    for (int i = 0; i < 4; ++i) {
        const int row = 8 * i + (lane >> 3), sr = row & 15, p0 = (2 * c) ^ sr;
        u32x4 v = *(const LAS u32x4*)(stg + row * 128 + ((p0 & ~1) << 3));
        if (sr & 1) { const unsigned tx = v.x, ty = v.y; v.x = v.z; v.y = v.w; v.z = tx; v.w = ty; }
        const int tok = t.tb + t.sa * (row >> 4) + t.sb * (row & 15);
        bf16_t* dst = t.pat < 0 ? O + (size_t)tok * D + 64 * t.headg + 8 * c : PO + ((size_t)t.pat * NTOK + tok) * 384 + 64 * (t.headg - 6) + 8 * c;
        *(u32x4*)dst = v;
    }
}
__device__ __forceinline__ void attn_mem_items(LAS unsigned char* lds, const bf16_t* qkv, const bf16_t* memkv, bf16_t* O, unsigned* pub, const int nkvflags, int wave, int first, int stride) {
    int tid = wave * 64 + lane_id_now(); asm volatile("" : "+v"(tid));
    const int lane = tid & 63, r32 = lane & 31, hi = lane >> 5;
    LAS unsigned char* stg = lds + ATT_STG_OFF + wave * 4096;
    const int ckey = (tid >> 3) & 31, cwhich = tid >> 8, cdch = tid & 7;
    const int cdst = cwhich ? 4096 + ckey * 128 + (((cdch >> 2) ^ ((ckey >> 1) & 1)) << 6) + (cdch & 3) * 16 : ckey * 128 + ((cdch ^ ((ckey >> 1) & 7)) << 4);
    for (int it = first; it < COOP_MEM; it += stride) {
        const int b_ = it >> 7, h_ = (it >> 5) & 3, panel = b_ * (SEQ / 256) + (it & 31);
        if (wave == 0 && lane_id_now() == 0) { unsigned sp_ = 0;
            while (__hip_atomic_load(pub + panel, __ATOMIC_RELAXED, __HIP_MEMORY_SCOPE_AGENT) == 0u) { __builtin_amdgcn_s_sleep(2); if (++sp_ > (1u << 22)) break; }
            for (int f = 0; f < nkvflags; ++f) { sp_ = 0; while (__hip_atomic_load(pub + 64 + f, __ATOMIC_RELAXED, __HIP_MEMORY_SCOPE_AGENT) == 0u) { __builtin_amdgcn_s_sleep(2); if (++sp_ > (1u << 22)) break; } }
            __builtin_amdgcn_fence(__ATOMIC_ACQUIRE, "agent"); asm volatile("s_waitcnt vmcnt(0)" ::: "memory"); }
        __syncthreads();
        u32x4 pre[8]; bf16x8 qn[4]; TileQ tq; int decq0 = 0, dd = 1;
        { const bf16_t* src_ = memkv + (cwhich ? 256 : 0) + 64 * h_ + 8 * cdch;
#pragma unroll
          for (int jb = 0; jb < 8; ++jb) pre[jb] = *(const u32x4*)(src_ + (size_t)(b_ * MEMLEN + 32 * jb + ckey) * 512); }
        coop_tile(it, wave, qkv, tq, decq0, dd);
        { const bf16_t* qp_ = tq.qbase + (size_t)(tq.tb + tq.sa * (r32 >> 4) + tq.sb * (r32 & 15)) * 64 + 8 * hi;
#pragma unroll
          for (int s_ = 0; s_ < 4; ++s_) qn[s_] = *(const bf16x8*)(qp_ + 16 * s_); }
#pragma unroll
        for (int jb = 0; jb < 8; ++jb) *(LAS u32x4*)(lds + jb * 8192 + cdst) = pre[jb];
        AttnSt st;
#pragma unroll
        for (int r = 0; r < 16; ++r) { st.o0[r] = 0.f; st.o1[r] = 0.f; }
        st.m = -1e30f; st.l = 0.f;
#pragma unroll
        for (int s = 0; s < 4; ++s) st.q[s] = qn[s];
        __syncthreads();
        attn_blocks<2, true>(st, lds, nullptr, nullptr, 0, 0, 0, 0, 0, 0, 8, lane, 0, 0, 0, nullptr);
        attn_epilogue(st, tq, stg, O, nullptr, nullptr, lane);
    }
    __syncthreads();
}
__device__ __forceinline__ void attn_mfma_phase(LAS unsigned char* lds, const bf16_t* qkv, const bf16_t* memkv, const float* rpb, bf16_t* O, bf16_t* PO, float* Pml, unsigned* qctr, int wave, int vcu, int G, bool skip_mem) {
    int tid = wave * 64 + lane_id_now(); asm volatile("" : "+v"(tid));
    const int lane = tid & 63, r32 = lane & 31, hi = lane >> 5;
    { LAS float* tab = (LAS float*)(lds + ATT_TAB_OFF);
      for (int i = tid; i < 6 * 15 * 64; i += 512) { const int c = i & 63, rr = (i >> 6) % 15, h = i / (15 * 64); tab[i] = (c >= 16 && c <= 46) ? rpb[h * 465 + rr * 31 + (c - 16)] * LOG2E : 0.f; } }
    __syncthreads();
    LAS unsigned char* stg = lds + ATT_STG_OFF + wave * 4096;
    {
        const int ckey = (tid >> 3) & 31, cwhich = tid >> 8, cdch = tid & 7;
        const int cdst = cwhich ? 4096 + ckey * 128 + (((cdch >> 2) ^ ((ckey >> 1) & 1)) << 6) + (cdch & 3) * 16 : ckey * 128 + ((cdch ^ ((ckey >> 1) & 7)) << 4);
        constexpr int NIT = COOP_MEM + COOP_DIL + COOP_NA;
        u32x4 pre[12]; bf16x8 qn[4]; TileQ tq; int decq0 = 0, dd = 1;
#define COOP_LOAD(it) do { \
            if ((it) < COOP_MEM) { const int b_ = (it) >> 7, h_ = ((it) >> 5) & 3; const bf16_t* src_ = memkv + (cwhich ? 256 : 0) + 64 * h_ + 8 * cdch; \
                _Pragma("unroll") for (int jb = 0; jb < 8; ++jb) pre[jb] = *(const u32x4*)(src_ + (size_t)(b_ * MEMLEN + 32 * jb + ckey) * 512); } \
            else if ((it) < COOP_MEM + COOP_DIL) { const int x_ = (it) - COOP_MEM, hb_ = x_ / 96, r_ = x_ % 96, pat_ = r_ >> 5, grp_ = r_ & 31, b_ = hb_ / 6, h_ = hb_ % 6; \
                const int d_ = pat_ == 0 ? 1 : (pat_ == 1 ? 4 : 16), cls_ = pat_ == 0 ? 0 : (pat_ == 1 ? (grp_ >> 3) : (grp_ >> 1)), g0_ = pat_ == 0 ? 256 * grp_ : (pat_ == 1 ? 256 * (grp_ & 7) : 256 * (grp_ & 1)); \
                const bf16_t* src_ = qkv + (size_t)((cwhich ? QKV_VB : QKV_KB) / 64 + h_) * NTOK * 64 + 8 * cdch; \
                _Pragma("unroll") for (int jb = 0; jb < 12; ++jb) { const int t_ = min(max(cls_ + d_ * (g0_ - 64 + 32 * jb + ckey), 0), SEQ - 1); pre[jb] = *(const u32x4*)(src_ + (size_t)(b_ * SEQ + t_) * 64); } } \
            coop_tile((it), wave, qkv, tq, decq0, dd); \
            { const bf16_t* qp_ = tq.qbase + (size_t)(tq.tb + tq.sa * (r32 >> 4) + tq.sb * (r32 & 15)) * 64 + 8 * hi; _Pragma("unroll") for (int s_ = 0; s_ < 4; ++s_) qn[s_] = *(const bf16x8*)(qp_ + 16 * s_); } } while (0)
        int it = vcu;
        if (skip_mem) { while (it < COOP_MEM) it += G; }
        if (it < NIT) COOP_LOAD(it);
        for (; it < NIT; it += G) {
            __syncthreads();
            const int nb = it < COOP_MEM ? 8 : (it < COOP_MEM + COOP_DIL ? 12 : 0);
#pragma unroll
            for (int jb = 0; jb < 12; ++jb) if (jb < nb) *(LAS u32x4*)(lds + jb * 8192 + cdst) = pre[jb];
            AttnSt st;
#pragma unroll
            for (int r = 0; r < 16; ++r) { st.o0[r] = 0.f; st.o1[r] = 0.f; }
            st.m = -1e30f; st.l = 0.f;
#pragma unroll
            for (int s = 0; s < 4; ++s) st.q[s] = qn[s];
            const TileQ tc = tq; const int cdecq0 = decq0, cd = dd;
            const bool cur_na = it >= COOP_MEM + COOP_DIL;
            if (cur_na) {
#pragma unroll
                for (int jb = 0; jb < 12; ++jb) asm volatile("" : "=v"(pre[jb]));
#pragma unroll
                for (int s_ = 0; s_ < 4; ++s_) asm volatile("" : "=v"(qn[s_]));
            }
            if (!cur_na && it + G < NIT) COOP_LOAD(it + G);
            __syncthreads();
            if (it < COOP_MEM) attn_blocks<2, true>(st, lds, nullptr, nullptr, 0, 0, 0, 0, 0, 0, 8, lane, 0, 0, 0, nullptr);
            else if (it < COOP_MEM + COOP_DIL) attn_blocks<1, true>(st, lds + wave * 8192, nullptr, nullptr, 0, 0, 0, 0, 0, 0, 5, lane, cdecq0 - 64, SEQ / cd, cdecq0 + r32, nullptr);
            else { const int x = cdecq0, b = x / 1536, rem = x % 1536, h = rem >> 8, rp = (rem >> 2) & 63, cgp = rem & 3;
                const int r0 = 2 * rp, c0 = 16 * cgp, qrow = r0 + (r32 >> 4), qcol = c0 + (r32 & 15);
                const int kr0 = min(max(r0 - 4, 0), 120), kr1 = min(max(r0 - 3, 0), 120), nrows = kr1 + 8 - kr0;
                const int rsq = min(max(qrow - 4, 0), 120), csq = min(max(qcol - 8, 0), 48), cw0 = min(max(c0 - 8, 0), 32);
                attn_blocks<0, false, true>(st, lds + wave * 8192, qkv + (size_t)(QKV_KA / 64 + h) * NTOK * 64, qkv + (size_t)(QKV_VA / 64 + h) * NTOK * 64, 64, b * SEQ, kr0 * 64 + cw0, 64, 1, SEQ - 1, nrows, lane,
                               kr0 - rsq, cw0 - csq, (kr0 - qrow + 7) * 64 + (cw0 - qcol + 31), (const LAS float*)(lds + ATT_TAB_OFF) + h * 15 * 64); }
            attn_epilogue(st, tc, stg, O, PO, Pml, lane);
            if (cur_na && it + G < NIT) COOP_LOAD(it + G);
        }
#undef COOP_LOAD
        __syncthreads();
    }
    (void)qctr;
    __syncthreads();
}

constexpr int DEF_S1 = 1920, DEF_S2 = 5120, DEF_S3 = 2048, DM_ITEMS = NEXP * 56 * 32, DEF_S4 = DM_ITEMS - DEF_S1 - DEF_S2 - DEF_S3, DEF_TOTAL = DEF_S1 + DEF_S2 + DEF_S3 + DEF_S4;
__device__ __forceinline__ void conv_down_m(const float* w_down_m, unsigned char* wd_m, LAS unsigned char* lds, int wave, int q0, int q1, int worker, int nworkers) {
    const int lane = lane_id_now(); LAS float* scr = (LAS float*)(lds + wave * 16384);
    const int r8 = lane >> 3, c4 = (lane & 7) * 4, cc = lane & 7;
    f32x4 cv[8];
#define CDM_LOAD(q) do { const int e_ = (q) / 1792, r_ = (q) % 1792, kb_ = r_ >> 5, nb_ = r_ & 31; const float* W_ = w_down_m + (size_t)e_ * DFFE * D + (size_t)(64 * kb_) * D + 32 * nb_ + c4; \
        _Pragma("unroll") for (int i = 0; i < 8; ++i) cv[i] = __builtin_nontemporal_load((const f32x4*)(W_ + (size_t)(8 * i + r8) * D)); } while (0)
    int q = q0 + worker;
    if (q < q1) CDM_LOAD(q);
    for (; q < q1; q += nworkers) {
#pragma unroll
        for (int i = 0; i < 8; ++i) { LAS float* sp = scr + (8 * i + r8) * 33 + c4; sp[0] = cv[i][0] * W8_DN; sp[1] = cv[i][1] * W8_DN; sp[2] = cv[i][2] * W8_DN; sp[3] = cv[i][3] * W8_DN; }
        if (q + nworkers < q1) CDM_LOAD(q + nworkers);
        asm volatile("s_waitcnt lgkmcnt(0)" ::: "memory");
        const int e = q / 1792, r = q % 1792, kb = r >> 5, nb = r & 31; unsigned char* dst = wd_m + (size_t)e * D * DFFE;
#pragma unroll
        for (int j = 0; j < 4; ++j) { const int n = (lane >> 3) + 8 * j; const LAS float* sp = scr + (8 * cc) * 33 + n;
            u32x2 o; o.x = pk4_fp8(sp[0 * 33], sp[1 * 33], sp[2 * 33], sp[3 * 33]); o.y = pk4_fp8(sp[4 * 33], sp[5 * 33], sp[6 * 33], sp[7 * 33]);
            __builtin_nontemporal_store(o, (u32x2*)(dst + (size_t)(32 * nb + n) * DFFE + 64 * kb + 8 * cc)); }
        asm volatile("s_waitcnt lgkmcnt(0)" ::: "memory");
    }
#undef CDM_LOAD
}

constexpr int GU_ITEMS = NEXP * 2 * 16 * 112;
__device__ __forceinline__ void conv_gu_m(const float* w_gate_m, const float* w_up_m, const float* gain, unsigned char* wgu_m, LAS unsigned char* lds, int wave, int worker, int nworkers) {
    const int lane = lane_id_now(); LAS float* scr = (LAS float*)(lds + wave * 16384);
    const int r8 = lane >> 3, c4 = (lane & 7) * 4, cc = lane & 7;
    f32x4 cv[8]; float cg[8];
#define CGU_LOAD(q) do { const int e_ = (q) / 3584, q2_ = (q) % 3584, up_ = q2_ / 1792, r_ = q2_ % 1792, kb_ = r_ / 112, nb_ = r_ % 112; \
        const float* W_ = (up_ ? w_up_m : w_gate_m) + (size_t)e_ * D * DFFE + (size_t)(64 * kb_) * DFFE + 32 * nb_ + c4; \
        _Pragma("unroll") for (int i = 0; i < 8; ++i) { cv[i] = __builtin_nontemporal_load((const f32x4*)(W_ + (size_t)(8 * i + r8) * DFFE)); cg[i] = gain[64 * kb_ + 8 * i + r8] * W8_UP; } } while (0)
    int q = worker;
    if (q < GU_ITEMS) CGU_LOAD(q);
    for (; q < GU_ITEMS; q += nworkers) {
#pragma unroll
        for (int i = 0; i < 8; ++i) { LAS float* sp = scr + (8 * i + r8) * 33 + c4; sp[0] = cv[i][0] * cg[i]; sp[1] = cv[i][1] * cg[i]; sp[2] = cv[i][2] * cg[i]; sp[3] = cv[i][3] * cg[i]; }
        if (q + nworkers < GU_ITEMS) CGU_LOAD(q + nworkers);
        asm volatile("s_waitcnt lgkmcnt(0)" ::: "memory");
        const int e = q / 3584, q2 = q % 3584, up = q2 / 1792, r = q2 % 1792, kb = r / 112, nb = r % 112; unsigned char* dst = wgu_m + (size_t)e * 2 * DFFE * D; const int drow = up ? map_up(32 * nb) : map_gate(32 * nb);
#pragma unroll
        for (int j = 0; j < 4; ++j) { const int n = (lane >> 3) + 8 * j; const LAS float* sp = scr + (8 * cc) * 33 + n;
            u32x2 o; o.x = pk4_fp8(sp[0 * 33], sp[1 * 33], sp[2 * 33], sp[3 * 33]); o.y = pk4_fp8(sp[4 * 33], sp[5 * 33], sp[6 * 33], sp[7 * 33]);
            __builtin_nontemporal_store(o, (u32x2*)(dst + (size_t)(drow + n) * D + 64 * kb + 8 * cc)); }
        asm volatile("s_waitcnt lgkmcnt(0)" ::: "memory");
    }
#undef CGU_LOAD
    __syncthreads();
}

constexpr int NPHASE = 16;
__global__ void __launch_bounds__(512, 2) mk_fwd(Args a) {
    extern __shared__ __attribute__((aligned(16))) unsigned char lds_raw[];
    LAS unsigned char* lds = (LAS unsigned char*)lds_raw;
    const int tid0 = threadIdx.x, wave = __builtin_amdgcn_readfirstlane(tid0 >> 6);
    const int G = gridDim.x, bx = blockIdx.x;
#define PHASE_LOCALS int tid = wave * 64 + lane_id_now(); asm volatile("" : "+v"(tid)); const int lane = tid & 63; (void)lane;
    const int vcu = (G % 8 == 0) ? (bx % 8) * (G / 8) + bx / 8 : bx;
    const int gw = vcu * 8 + wave, NGW = G * 8;
    unsigned char* const ws0 = a.ws;
#define WS_LOCAL int wsz_ = 0; asm volatile("" : "+s"(wsz_)); unsigned char* ws = ws0 + wsz_;
#define SSQV(i) ((float*)(ws + WS_SSQ + (size_t)(i) * SSQ_BYTES))
#define P_SSQMEM ((float*)(ws + WS_SSQMEM))
#define P_ROPE ((float*)(ws + WS_ROPE))
#define P_MEMBF ((bf16_t*)(ws + WS_MEMBF))
#define P_MEMKV ((bf16_t*)(ws + WS_MEMKV))
#define P_EIDX ((int*)(ws + WS_EIDX))
#define P_GATE ((float*)(ws + WS_GATE))
#define P_POS ((int*)(ws + WS_POS))
#define P_ROWTOK ((int*)(ws + WS_ROWTOK))
#define P_ROWGATE ((float*)(ws + WS_ROWGATE))
#define P_CNT ((int*)(ws + WS_CNT))
#define P_RSTD3 ((float*)(ws + WS_RSTD3))
#define P_ROWRSTD ((float*)(ws + WS_ROWRSTD))
#define Wgu_m (ws + WS_WGU_M)
#define Wd_m (ws + WS_WD_M)
#define Hb ((bf16_t*)(ws + WS_HB))
#define Hb8 (ws + WS_HB8)
#define Win ((bf16_t*)(ws + WS_WIN))
#define Wmem ((bf16_t*)(ws + WS_WMEM))
#define Wout ((bf16_t*)(ws + WS_WOUT))
#define Wgu_d ((bf16_t*)(ws + WS_WGU_D))
#define Wd_d ((bf16_t*)(ws + WS_WD_D))
#define QKV ((bf16_t*)(ws + WS_QKV))
#define Ob ((bf16_t*)(ws + WS_O))
#define Hd ((bf16_t*)(ws + WS_HD))
#define Hm (ws + WS_HM)
#define Yb ((bf16_t*)(ws + WS_Y))

#if MK_N_LAUNCHES == 1
    volatile LAS unsigned* MISC = (volatile LAS unsigned*)(lds + MISC_OFF);
    if (tid0 < 32) MISC[tid0] = 0u;
    __syncthreads();
    const XcdBarrier bar = xcd_barrier_post((unsigned*)(ws0 + WS_CTL) + CW_BAR, MISC + 8, wave);
#define GRID_BAR() xcd_barrier(bar)
#else
#define GRID_BAR() do { } while (0)
#endif
    const int lo = a.ph_lo, hi = a.ph_hi;
#ifndef PHMASK
#define PHMASK 0xffffffu
#endif
#ifndef PROBE_DUP
#define PROBE_DUP 0
#endif
#define DUPN(k) (1 + ((PROBE_DUP >> (k)) & 1))
#define IN(k) (((PHMASK >> ((k) > 6 && (k) < 11 ? (k) - 6 : (k))) & 1u) && lo <= (k) && (k) < hi)
#define SEAM(k) do { if (IN(k) && IN((k) + 1)) GRID_BAR(); } while (0)

    if (IN(0)) for (int rep = 0; rep < DUPN(0); ++rep) {
        WS_LOCAL
        PHASE_LOCALS
        LAS float* scr = (LAS float*)(lds + wave * 16384);
        constexpr int I_IN = 16 * 80, I_MEM = 16 * 16, I_OUT = 16 * 32, I_GD = 16 * 88, I_DD = 44 * 32, I_GM = 16 * 112, I_DM = 56 * 32;
        constexpr int T0 = 2 * I_IN, T1 = T0 + 2 * I_MEM, T2 = T1 + 2 * I_OUT, T3 = T2 + 2 * I_GD, T4 = T3 + I_DD, T5 = T4 + 2 * NEXP * I_GM, T6 = T5 + NEXP * I_DM;
        struct ConvP { const float* W; const float* gain; unsigned char* dst; int K, N, k0, n0, drow; float scale; bool f8; };
#define CONV_DECODE(it, P) do { \
            if ((it) < T0) { const int l = (it) / I_IN, r = (it) % I_IN, kb = r / 80, nb = r % 80; \
                P.W = a.w_in + (size_t)l * D * IN_W; P.K = D; P.N = IN_W; P.gain = a.g_attn + l * D; P.scale = 1.f; P.dst = (unsigned char*)(Win + (size_t)l * IN_W * D); P.k0 = 64 * kb; P.n0 = 32 * nb; P.drow = map_head(32 * nb); P.f8 = false; } \
            else if ((it) < T1) { const int q = (it) - T0, l = q / I_MEM, r = q % I_MEM, kb = r / 16, nb = r % 16; \
                P.W = a.w_mem_kv + (size_t)l * D * 512; P.K = D; P.N = 512; P.gain = a.g_mem + l * D; P.scale = 1.f; P.dst = (unsigned char*)(Wmem + (size_t)l * 512 * D); P.k0 = 64 * kb; P.n0 = 32 * nb; P.drow = map_head(32 * nb); P.f8 = false; } \
            else if ((it) < T2) { const int q = (it) - T1, l = q / I_OUT, r = q % I_OUT, kb = r / 32, nb = r % 32; \
                P.W = a.w_out + (size_t)l * D * D; P.K = D; P.N = D; P.gain = a.g_out + l * D; P.scale = 1.f; P.dst = (unsigned char*)(Wout + (size_t)l * D * D); P.k0 = 64 * kb; P.n0 = 32 * nb; P.drow = 32 * nb; P.f8 = false; } \
            else if ((it) < T3) { const int q = (it) - T2, up = q / I_GD, r = q % I_GD, kb = r / 88, nb = r % 88; \
                P.W = up ? a.w_up_d : a.w_gate_d; P.K = D; P.N = DFF; P.gain = a.g_ffn; P.scale = DENSE_FP8_UP ? W8_UP : 1.f; P.dst = (unsigned char*)Wgu_d; P.k0 = 64 * kb; P.n0 = 32 * nb; P.drow = up ? map_up(32 * nb) : map_gate(32 * nb); P.f8 = DENSE_FP8_UP != 0; } \
            else if ((it) < T4) { const int r = (it) - T3, kb = r / 32, nb = r % 32; \
                P.W = a.w_down_d; P.K = DFF; P.N = D; P.gain = nullptr; P.scale = DENSE_FP8_DN ? W8_DN : 1.f; P.dst = (unsigned char*)Wd_d; P.k0 = 64 * kb; P.n0 = 32 * nb; P.drow = 32 * nb; P.f8 = DENSE_FP8_DN != 0; } \
            else if ((it) < T5) { const int q = (it) - T4, e = q / (2 * I_GM), q2 = q % (2 * I_GM), up = q2 / I_GM, r = q2 % I_GM, kb = r / 112, nb = r % 112; \
                P.W = (up ? a.w_up_m : a.w_gate_m) + (size_t)e * D * DFFE; P.K = D; P.N = DFFE; P.gain = a.g_ffn + D; P.scale = W8_UP; P.dst = Wgu_m + (size_t)e * 2 * DFFE * D; P.k0 = 64 * kb; P.n0 = 32 * nb; P.drow = up ? map_up(32 * nb) : map_gate(32 * nb); P.f8 = true; } \
            else { const int q = (it) - T5, e = q / I_DM, r = q % I_DM, kb = r / 32, nb = r % 32; \
                P.W = a.w_down_m + (size_t)e * DFFE * D; P.K = DFFE; P.N = D; P.gain = nullptr; P.scale = W8_DN; P.dst = Wd_m + (size_t)e * D * DFFE; P.k0 = 64 * kb; P.n0 = 32 * nb; P.drow = 32 * nb; P.f8 = true; } } while (0)
        const int r8 = lane >> 3, c4 = (lane & 7) * 4, cc = lane & 7;
        f32x4 cv[8]; float cg[8];
#define CONV_LOAD(P) do { _Pragma("unroll") for (int i = 0; i < 8; ++i) { const int kk = 8 * i + r8; cv[i] = __builtin_nontemporal_load((const f32x4*)(P.W + (size_t)(P.k0 + kk) * P.N + P.n0 + c4)); cg[i] = (P.gain ? P.gain[P.k0 + kk] : 1.f) * P.scale; } } while (0)
        const int TE = G == 256 ? (SKEW_CONV ? T4 : T6 - DEF_TOTAL) : T6;
        ConvP pc, pn; int it = gw;
        if (it < TE) { CONV_DECODE(it, pc); CONV_LOAD(pc); }
        for (; it < TE; it += NGW) {
#pragma unroll
            for (int i = 0; i < 8; ++i) { LAS float* sp = scr + (8 * i + r8) * 33 + c4; sp[0] = cv[i][0] * cg[i]; sp[1] = cv[i][1] * cg[i]; sp[2] = cv[i][2] * cg[i]; sp[3] = cv[i][3] * cg[i]; }
            const bool more = it + NGW < TE;
            if (more) { CONV_DECODE(it + NGW, pn); CONV_LOAD(pn); }
            asm volatile("s_waitcnt lgkmcnt(0)" ::: "memory");
#pragma unroll
            for (int j = 0; j < 4; ++j) { const int n = (lane >> 3) + 8 * j; const LAS float* sp = scr + (8 * cc) * 33 + n;
                const float v0 = sp[0 * 33], v1 = sp[1 * 33], v2 = sp[2 * 33], v3 = sp[3 * 33], v4 = sp[4 * 33], v5 = sp[5 * 33], v6 = sp[6 * 33], v7 = sp[7 * 33];
                if (pc.f8) { u32x2 o; o.x = pk4_fp8(v0, v1, v2, v3); o.y = pk4_fp8(v4, v5, v6, v7); __builtin_nontemporal_store(o, (u32x2*)(pc.dst + (size_t)(pc.drow + n) * pc.K + pc.k0 + 8 * cc)); }
                else { u32x4 o; o.x = pk_bf16(v0, v1); o.y = pk_bf16(v2, v3); o.z = pk_bf16(v4, v5); o.w = pk_bf16(v6, v7); *(u32x4*)((bf16_t*)pc.dst + (size_t)(pc.drow + n) * pc.K + pc.k0 + 8 * cc) = o; } }
            asm volatile("s_waitcnt lgkmcnt(0)" ::: "memory");
            if (more) pc = pn;
        }
#undef CONV_DECODE
#undef CONV_LOAD
        for (int m = gw; m < NTOK + NMEM; m += NGW) {
            const bool isx = m < NTOK; const float* src = isx ? a.x + (size_t)m * D : a.mem + (size_t)(m - NTOK) * D;
            bf16_t* dst = isx ? Hb + (size_t)m * D : P_MEMBF + (size_t)(m - NTOK) * D; float* sq = isx ? SSQV(0) + (size_t)m * 4 : P_SSQMEM + (size_t)(m - NTOK) * 4;
            const f32x4* xr = (const f32x4*)src + lane; float s = 0.f; f32x4 v[4];
#pragma unroll
            for (int j = 0; j < 4; ++j) { v[j] = __builtin_nontemporal_load(xr + 64 * j); s += (v[j][0] * v[j][0] + v[j][1] * v[j][1]) + (v[j][2] * v[j][2] + v[j][3] * v[j][3]); }
            s = wave_sum(s);
#pragma unroll
            for (int j = 0; j < 4; ++j) { u32x2 w; w.x = pk_bf16(v[j][0], v[j][1]); w.y = pk_bf16(v[j][2], v[j][3]); ((u32x2*)dst)[lane + 64 * j] = w; }
            if (lane < 4) sq[lane] = lane == 0 ? s : 0.f;
        }
        if (gw == 0) { for (int j = lane; j < D / 2; j += 64) ((unsigned*)(Hb + (size_t)NTOK * D))[j] = 0u; for (int j = lane; j < D / 4; j += 64) ((unsigned*)(Hb8 + (size_t)NTOK * D))[j] = 0u;
            if (lane < 4) for (int v = 0; v < 4; ++v) SSQV(v)[(size_t)NTOK * 4 + lane] = lane == 0 ? (float)D : 0.f; }
        for (int i = bx * 512 + tid; i < SEQ * 32; i += G * 512) { const int t = i >> 5, f = i & 31;
            const float inv = powf(10000.0f, -(2.0f / 64.0f) * (float)f); const float ang = (float)t * inv;
            P_ROPE[(size_t)t * 64 + f] = (float)cos((double)ang); P_ROPE[(size_t)t * 64 + 32 + f] = (float)sin((double)ang); }
    }
    SEAM(0);

#pragma unroll
    for (int layer = 0; layer < 2; ++layer) {
        const int pb = 1 + 6 * layer;
#define ssq_in SSQV(layer == 0 ? 0 : 2)
#define ssq_mid SSQV(layer == 0 ? 1 : 3)
        if (IN(pb)) for (int rep = 0; rep < DUPN(1); ++rep) {
            WS_LOCAL
            SchedReg S; S.A = (const char*)Hb; S.B = (const char*)(Win + (size_t)layer * IN_W * D); S.nM = NTOK / 256; S.nN = IN_W / 256; S.K = D; S.G = G; S.c = bx;
            S.nExtra = layer == 0 ? 8 : 0; S.memA = (const char*)P_MEMBF; S.memB = (const char*)Wmem;
            const int units_ = (NTOK / 256) * (IN_W / 256) + S.nExtra, busy_last = units_ - ((units_ - 1) / G) * G, nidle = G - busy_last; const bool mem_early = nidle >= 32;
            S.memfirst = mem_early; S.pub = (unsigned*)(ws + WS_CTL) + 8192 + 128 * layer;
            const int wt_pn_ = mem_early ? IN_W / 256 - 1 : -1;
            EpiQKV E; E.qkv = QKV; E.ssq = ssq_in; E.g_na = a.g_qk_na + layer * 128; E.g_dil = a.g_qk_dil + layer * 128; E.g_mem = a.g_qk_mem + layer * 128;
            E.rope = P_ROPE; E.memkv = P_MEMKV; E.ssqmem = P_SSQMEM; E.g_mem_all = a.g_qk_mem; E.lds = lds; E.wt_pn = wt_pn_; E.mem_delta = (long)((const char*)P_SSQMEM - (const char*)ssq_in);
            const bool skew_ = SKEW_CONV && G == 256 && layer == 0;
            if (skew_ && (bx & 4)) conv_gu_m(a.w_gate_m, a.w_up_m, a.g_ffn + D, Wgu_m, lds, wave, bx * 8 + wave, G * 8);
            pg8::gemm_phase<EpiQKV, SchedReg, false, true, false, false, true>(lds, D, S, E, wave);
            if (skew_ && !(bx & 4)) conv_gu_m(a.w_gate_m, a.w_up_m, a.g_ffn + D, Wgu_m, lds, wave, bx * 8 + wave, G * 8);
            if (mem_early && bx >= busy_last) attn_mem_items(lds, QKV, P_MEMKV + (size_t)layer * NMEM * 512, Ob, S.pub, layer == 0 ? 4 : 0, wave, bx - busy_last, nidle);
            if (G == 256 && bx >= busy_last) { const int qa = DM_ITEMS - DEF_TOTAL + (layer == 0 ? 0 : DEF_S1 + DEF_S2);
                conv_down_m(a.w_down_m, Wd_m, lds, wave, qa, qa + (layer == 0 ? DEF_S1 : DEF_S3), (bx - busy_last) * 8 + wave, nidle * 8); }
        }
        SEAM(pb);
#ifdef ATTN_SCALAR
        if (IN(pb + 1)) attn_scalar_phase(QKV, P_MEMKV + (size_t)layer * NMEM * 512, a.rpb_na + layer * 6 * 465, Ob, ssqh, G);
#else
        if (IN(pb + 1)) for (int rep = 0; rep < DUPN(2); ++rep) { WS_LOCAL attn_mfma_phase(lds, QKV, P_MEMKV + (size_t)layer * NMEM * 512, a.rpb_na + layer * 6 * 465, Ob, (bf16_t*)(ws + WS_HD), (float*)(ws + WS_HD + (size_t)3 * NTOK * 384 * 2), (unsigned*)(ws + WS_CTL) + 128 * layer + 256 * rep, wave, vcu, G, (G - (((NTOK / 256) * (IN_W / 256) + (layer == 0 ? 8 : 0)) - ((((NTOK / 256) * (IN_W / 256) + (layer == 0 ? 8 : 0)) - 1) / G) * G)) >= 32); }
#endif
        SEAM(pb + 1);
        if (IN(pb + 2)) for (int rep = 0; rep < DUPN(3); ++rep) {
            WS_LOCAL
            PHASE_LOCALS
            const bf16_t* PO = (const bf16_t*)(ws + WS_HD); const float* Pml = (const float*)(ws + WS_HD + (size_t)3 * NTOK * 384 * 2);
            const bool isdil = lane >= 24 && lane < 48; const int dcol = 16 * (lane - 24), hh = (lane - 24) >> 2;
            u32x4 rA[3][2], rB[3][2]; f32x2 mA[3], mB[3];
#define MRG_LOAD(mm, R, ML) do { \
                if (isdil) { _Pragma("unroll") for (int g = 0; g < 3; ++g) { ML[g] = *(const f32x2*)(Pml + (((size_t)g * NTOK + (mm)) * 6 + hh) * 2); const u32x4* pp = (const u32x4*)(PO + ((size_t)g * NTOK + (mm)) * 384 + dcol); R[g][0] = pp[0]; R[g][1] = pp[1]; } } \
                else { const u32x4* pp = (const u32x4*)(Ob + (size_t)(mm) * D + 16 * lane); R[0][0] = pp[0]; R[0][1] = pp[1]; } } while (0)
#pragma unroll
            for (int g = 0; g < 3; ++g) { mA[g] = (f32x2){0.f, 0.f}; mB[g] = (f32x2){0.f, 0.f};
#pragma unroll
                for (int j = 0; j < 2; ++j) { rA[g][j] = (u32x4){0u, 0u, 0u, 0u}; rB[g][j] = (u32x4){0u, 0u, 0u, 0u}; } }
            int m = gw;
            if (m < NTOK) MRG_LOAD(m, rA, mA);
            for (; m < NTOK; m += NGW) {
                const int mnx = m + NGW;
                if (mnx < NTOK) MRG_LOAD(mnx, rB, mB);
                float v[16];
                if (isdil) {
                    const float M = fmaxf(fmaxf(mA[0][0], mA[1][0]), mA[2][0]);
                    const float w0 = __builtin_amdgcn_exp2f(mA[0][0] - M), w1 = __builtin_amdgcn_exp2f(mA[1][0] - M), w2 = __builtin_amdgcn_exp2f(mA[2][0] - M);
                    const float il = 1.f / (w0 * mA[0][1] + w1 * mA[1][1] + w2 * mA[2][1]);
                    const float c0 = w0 * il, c1 = w1 * il, c2 = w2 * il;
#pragma unroll
                    for (int j = 0; j < 2; ++j) {
                        const unsigned a0[4] = {rA[0][j].x, rA[0][j].y, rA[0][j].z, rA[0][j].w}, a1[4] = {rA[1][j].x, rA[1][j].y, rA[1][j].z, rA[1][j].w}, a2[4] = {rA[2][j].x, rA[2][j].y, rA[2][j].z, rA[2][j].w};
#pragma unroll
                        for (int e = 0; e < 4; ++e) { v[8 * j + 2 * e] = c0 * bf_lo(a0[e]) + c1 * bf_lo(a1[e]) + c2 * bf_lo(a2[e]); v[8 * j + 2 * e + 1] = c0 * bf_hi(a0[e]) + c1 * bf_hi(a1[e]) + c2 * bf_hi(a2[e]); }
                    }
                } else {
#pragma unroll
                    for (int j = 0; j < 2; ++j) { const u32x4 w = rA[0][j]; v[8 * j + 0] = bf_lo(w.x); v[8 * j + 1] = bf_hi(w.x); v[8 * j + 2] = bf_lo(w.y); v[8 * j + 3] = bf_hi(w.y); v[8 * j + 4] = bf_lo(w.z); v[8 * j + 5] = bf_hi(w.z); v[8 * j + 6] = bf_lo(w.w); v[8 * j + 7] = bf_hi(w.w); }
                }
                float ss = 0.f;
#pragma unroll
                for (int e = 0; e < 16; ++e) ss += v[e] * v[e];
                float s0 = lane < 24 ? ss : 0.f, s1 = isdil ? ss : 0.f, s2 = lane >= 48 ? ss : 0.f;
                s0 = wave_sum(s0); s1 = wave_sum(s1); s2 = wave_sum(s2);
                const float r0 = rsqrtf(s0 * (1.f / 384.f) + RMS_EPS), r1 = rsqrtf(s1 * (1.f / 384.f) + RMS_EPS), r2 = rsqrtf(s2 * (1.f / 256.f) + RMS_EPS);
                const float r = lane < 24 ? r0 : (lane < 48 ? r1 : r2);
                u32x4* po = (u32x4*)(Ob + (size_t)m * D + 16 * lane);
#pragma unroll
                for (int j = 0; j < 2; ++j) { u32x4 w; w.x = pk_bf16(v[8 * j] * r, v[8 * j + 1] * r); w.y = pk_bf16(v[8 * j + 2] * r, v[8 * j + 3] * r); w.z = pk_bf16(v[8 * j + 4] * r, v[8 * j + 5] * r); w.w = pk_bf16(v[8 * j + 6] * r, v[8 * j + 7] * r); po[j] = w; }
#pragma unroll
                for (int g = 0; g < 3; ++g) { mA[g] = mB[g]; rA[g][0] = rB[g][0]; rA[g][1] = rB[g][1]; }
            }
#undef MRG_LOAD
        }
        SEAM(pb + 2);
        if (IN(pb + 3)) for (int rep = 0; rep < (layer == 0 ? DUPN(4) : 1); ++rep) {
            WS_LOCAL
            SchedReg S; S.memfirst = false; S.pub = nullptr; S.A = (const char*)Ob; S.B = (const char*)(Wout + (size_t)layer * D * D); S.nM = NTOK / 256; S.nN = D / 256; S.K = D; S.G = G; S.c = bx; S.nExtra = 0; S.memA = nullptr; S.memB = nullptr;
            EpiResid E; E.hb = Hb; E.ssq_out = ssq_mid; E.lds = lds; E.hb8 = (layer == 1 || DENSE_FP8_UP) ? Hb8 : nullptr; E.asc = 1.f;
            pg8::gemm_phase<EpiResid, SchedReg, false, true>(lds, D, S, E, wave);
        }
        SEAM(pb + 3);
        if (layer == 0) {
            if (IN(5)) for (int rep = 0; rep < DUPN(5); ++rep) {
                WS_LOCAL
#if DENSE_FP8_UP
                SchedReg S; S.memfirst = false; S.pub = nullptr; S.A = (const char*)Hb8; S.B = (const char*)Wgu_d; S.nM = NTOK / 256; S.nN = 2 * DFF / 256; S.K = D / 2; S.G = G; S.c = bx; S.nExtra = 0; S.memA = nullptr; S.memB = nullptr;
                EpiSwiGLU<false> E; E.H = Hd; E.ldh = DFF; E.ssq = ssq_mid; E.rowrstd = nullptr; E.H8 = DENSE_FP8_DN ? (unsigned char*)Hd : nullptr; E.ascale = 1.f / W8_UP; E.oscale = H8_SC;
                pg8::gemm_phase<EpiSwiGLU<false>, SchedReg, false, true, true>(lds, D / 2, S, E, wave);
                if (G == 256 && bx >= 128) conv_down_m(a.w_down_m, Wd_m, lds, wave, DM_ITEMS - DEF_TOTAL + DEF_S1, DM_ITEMS - DEF_TOTAL + DEF_S1 + DEF_S2, (bx - 128) * 8 + wave, 128 * 8);
#else
                SchedReg S; S.memfirst = false; S.pub = nullptr; S.A = (const char*)Hb; S.B = (const char*)Wgu_d; S.nM = NTOK / 256; S.nN = 2 * DFF / 256; S.K = D; S.G = G; S.c = bx; S.nExtra = 0; S.memA = nullptr; S.memB = nullptr;
                EpiSwiGLU<false> E; E.H = Hd; E.ldh = DFF; E.ssq = ssq_mid; E.rowrstd = nullptr; E.H8 = DENSE_FP8_DN ? (unsigned char*)Hd : nullptr; E.ascale = 1.f; E.oscale = H8_SC;
                pg8::gemm_phase<EpiSwiGLU<false>, SchedReg, false, true>(lds, D, S, E, wave);
                if (G == 256 && bx >= 128) conv_down_m(a.w_down_m, Wd_m, lds, wave, DM_ITEMS - DEF_TOTAL + DEF_S1, DM_ITEMS - DEF_TOTAL + DEF_S1 + DEF_S2, (bx - 128) * 8 + wave, 128 * 8);
#endif
            }
            SEAM(5);
            if (IN(6)) {
                WS_LOCAL
                SchedReg S; S.memfirst = false; S.pub = nullptr; S.A = (const char*)Hd; S.B = (const char*)Wd_d; S.nM = NTOK / 256; S.nN = D / 256; S.K = DENSE_FP8_DN ? DFF / 2 : DFF; S.G = G; S.c = bx; S.nExtra = 0; S.memA = nullptr; S.memB = nullptr;
                EpiResid E; E.hb = Hb; E.ssq_out = SSQV(2); E.lds = lds; E.hb8 = nullptr; E.asc = DENSE_FP8_DN ? 1.f / (W8_DN * H8_SC) : 1.f;
                pg8::gemm_phase<EpiResid, SchedReg, false, true, DENSE_FP8_DN != 0>(lds, DENSE_FP8_DN ? DFF / 2 : DFF, S, E, wave);
            }
            SEAM(6);
        }
    }
    if (IN(11)) for (int rep = 0; rep < DUPN(11); ++rep) {
        WS_LOCAL
        PHASE_LOCALS
        constexpr int RSTR = 2048 + 16;
        LAS unsigned char* wt = lds;
        for (int k = tid; k < D; k += 512) { const float g = a.g_ffn[D + k]; const f32x4 w0 = *(const f32x4*)(a.w_router + (size_t)k * 8), w1 = *(const f32x4*)(a.w_router + (size_t)k * 8 + 4);
            const float wv[8] = {w0[0] * g, w0[1] * g, w0[2] * g, w0[3] * g, w1[0] * g, w1[1] * g, w1[2] * g, w1[3] * g};
#pragma unroll
            for (int e = 0; e < 8; ++e) { const unsigned hb_ = pk_bf16(wv[e], 0.f) & 0xffffu; const float hf = __uint_as_float(hb_ << 16); const unsigned lb_ = pk_bf16(wv[e] - hf, 0.f) & 0xffffu;
                *(LAS unsigned short*)(wt + e * RSTR + k * 2) = (unsigned short)hb_; *(LAS unsigned short*)(wt + (8 + e) * RSTR + k * 2) = (unsigned short)lb_; } }
        __syncthreads();
        const int r32 = lane & 31, hi = lane >> 5, kq = wave & 3, tl = wave >> 2;
        LAS float* red = (LAS float*)(lds + 40960);
        const float* ssq3 = SSQV(3);
        for (int T = bx * 2 + tl; T < NTOK / 32; T += 2 * G) {
            const int tok0 = 32 * T;
            bf16x8 hbv[16]; { const bf16_t* hp = Hb + (size_t)(tok0 + r32) * D + 256 * kq + 8 * hi;
#pragma unroll
              for (int sI = 0; sI < 16; ++sI) hbv[sI] = *(const bf16x8*)(hp + 16 * sI); }
            f32x16 acc;
#pragma unroll
            for (int r = 0; r < 16; ++r) acc[r] = 0.f;
            const LAS unsigned char* wrow = wt + (r32 & 7) * RSTR + (256 * kq + 8 * hi) * 2;
#pragma unroll
            for (int sI = 0; sI < 16; ++sI) { bf16x8 ah = *(const LAS bf16x8*)(wrow + 32 * sI), al = *(const LAS bf16x8*)(wrow + 8 * RSTR + 32 * sI);
                if (r32 >= 8) { ah = (bf16x8){0, 0, 0, 0, 0, 0, 0, 0}; al = ah; }
                acc = MFMA32(ah, hbv[sI], acc); acc = MFMA32(al, hbv[sI], acc); }
            { f32x4 pv; pv[0] = acc[0]; pv[1] = acc[1]; pv[2] = acc[2]; pv[3] = acc[3]; *(LAS f32x4*)(red + ((tl * 4 + kq) * 32 + r32) * 8 + 4 * hi) = pv; }
            __syncthreads();
            if (kq == 0 && hi == 0) { const int mtok = tok0 + r32; float lg[8];
#pragma unroll
                for (int e = 0; e < 8; ++e) lg[e] = 0.f;
#pragma unroll
                for (int q = 0; q < 4; ++q) { const f32x4 p0 = *(const LAS f32x4*)(red + ((tl * 4 + q) * 32 + r32) * 8), p1 = *(const LAS f32x4*)(red + ((tl * 4 + q) * 32 + r32) * 8 + 4);
                    lg[0] += p0[0]; lg[1] += p0[1]; lg[2] += p0[2]; lg[3] += p0[3]; lg[4] += p1[0]; lg[5] += p1[1]; lg[6] += p1[2]; lg[7] += p1[3]; }
                const f32x4 sq = *(const f32x4*)(ssq3 + (size_t)mtok * 4); const float rs = rsqrtf(((sq[0] + sq[1]) + (sq[2] + sq[3])) * (1.f / D) + RMS_EPS);
#pragma unroll
                for (int e = 0; e < 8; ++e) lg[e] *= rs;
                int e1 = 0; float l1 = lg[0];
#pragma unroll
                for (int e = 1; e < 8; ++e) if (lg[e] > l1) { l1 = lg[e]; e1 = e; }
                int e2 = -1; float l2 = -3.0e38f;
#pragma unroll
                for (int e = 0; e < 8; ++e) if (e != e1 && lg[e] > l2) { l2 = lg[e]; e2 = e; }
                const float p2 = expf(l2 - l1), g1 = 1.f / (1.f + p2), g2 = p2 * g1;
                P_EIDX[mtok] = e1 | (e2 << 8); f32x2 gg; gg[0] = g1; gg[1] = g2; *(f32x2*)(P_GATE + 2 * mtok) = gg; P_RSTD3[mtok] = rs; }
            __syncthreads();
        }
    }
    SEAM(11);
    if (IN(12)) for (int rep = 0; rep < DUPN(12); ++rep) {
        WS_LOCAL
        PHASE_LOCALS
        LAS int* sh = (LAS int*)lds;
        int c8[8];
#pragma unroll
        for (int e = 0; e < 8; ++e) c8[e] = 0;
        const int t0 = tid * 32;
        { pg8::v4i_t ev4[8];
#pragma unroll
          for (int q = 0; q < 8; ++q) ev4[q] = *(const pg8::v4i_t*)(P_EIDX + t0 + 4 * q);
#pragma unroll
          for (int q = 0; q < 8; ++q)
#pragma unroll
            for (int z = 0; z < 4; ++z) { const int ev = ev4[q][z]; const int e1 = ev & 255, e2 = ev >> 8;
#pragma unroll
                for (int e = 0; e < 8; ++e) c8[e] += (e1 == e) + (e2 == e); } }
        LAS int* cnts = (LAS int*)lds;
        LAS int* wtot = cnts + 8 * 512;
#pragma unroll
        for (int e = 0; e < 8; ++e) cnts[e * 512 + tid] = c8[e];
        __syncthreads();
        {
            LAS int* row = cnts + wave * 512; LAS int* part = wtot + wave * 64;
            int v8[8]; int sl = 0;
#pragma unroll
            for (int k = 0; k < 8; ++k) { v8[k] = row[8 * lane + k]; sl += v8[k]; }
            part[lane] = sl;
            asm volatile("s_waitcnt lgkmcnt(0)" ::: "memory");
            int before = 0, all = 0;
            for (int k = 0; k < 64; ++k) { const int v = part[k]; all += v; before += (k < lane) ? v : 0; }
#pragma unroll
            for (int k = 0; k < 8; ++k) { row[8 * lane + k] = before; before += v8[k]; }
            if (lane == 0) wtot[512 + wave] = all;
        }
        __syncthreads();
        int pre[8], tot[8], pstart[8];
#pragma unroll
        for (int e = 0; e < 8; ++e) { pre[e] = cnts[e * 512 + tid]; tot[e] = wtot[512 + e]; }
        { int s = 0;
#pragma unroll
          for (int e = 0; e < 8; ++e) { pstart[e] = s; s += ((tot[e] + 255) >> 8) << 8; } }
        for (int rbase = bx + wave * 2 * G; rbase < 512; rbase += 16 * G) {
            const int rt = rbase + (lane >> 5) * G; const bool on = rt < 512; const int t = (on ? rt : 0) * 32 + (lane & 31);
            const int ev = on ? P_EIDX[t] : 0xffff; const int e1 = ev & 255, e2 = ev >> 8;
            const float rt3 = P_RSTD3[t], ga = P_GATE[2 * t], gb = P_GATE[2 * t + 1];
            const unsigned long long below = (lane & 31) == 0 ? 0ull : ((1ull << (lane & 31)) - 1ull) << (lane & 32);
            int d1 = 0, d2 = 0;
#pragma unroll
            for (int e = 0; e < 8; ++e) { const unsigned long long mk = __ballot(e1 == e || e2 == e); const int rank = __popcll(mk & below);
                const int base_e = pstart[e] + cnts[e * 512 + (on ? rt : 0)] + rank; if (e1 == e) d1 = base_e; if (e2 == e) d2 = base_e; }
            if (on) { P_ROWTOK[d1] = t; P_ROWGATE[d1] = ga; P_ROWRSTD[d1] = rt3; P_ROWTOK[d2] = t; P_ROWGATE[d2] = gb; P_ROWRSTD[d2] = rt3;
                u32x2 pp; pp.x = (unsigned)d1; pp.y = (unsigned)d2; *(u32x2*)(P_POS + 2 * t) = pp; }
        }
        if (bx < 8) { const int e = bx; int te = 0, ps = 0;
#pragma unroll
            for (int k = 0; k < 8; ++k) if (k == e) { te = tot[k]; ps = pstart[k]; }
            const int padded = ((te + 255) >> 8) << 8;
            for (int r = te + tid; r < padded; r += 512) { P_ROWTOK[ps + r] = NTOK; P_ROWGATE[ps + r] = 0.f; P_ROWRSTD[ps + r] = 0.f; } }
        if (bx == 0 && tid == 0) {
#pragma unroll
            for (int e = 0; e < 8; ++e) P_CNT[e] = tot[e]; }
        __syncthreads();
    }
    SEAM(12);
    if (IN(13)) for (int rep = 0; rep < DUPN(13); ++rep) {
        WS_LOCAL
        SchedMoE S; S.A = (const char*)Hb8; S.B = (const char*)Wgu_m; S.rowtok = P_ROWTOK; S.K = D / 2; S.G = G; S.c = bx; S.nN = 2 * DFFE / 256; S.bstride = (size_t)2 * DFFE * D; S.gather = true; S.streamk = false; S.cx = 0; S.init(P_CNT);
        EpiSwiGLU<true> E; E.H = nullptr; E.ldh = DFFE; E.ssq = nullptr; E.rowrstd = P_ROWRSTD; E.H8 = Hm; E.ascale = 1.f / W8_UP; E.oscale = H8_SC;
        pg8::gemm_phase<EpiSwiGLU<true>, SchedMoE, true, true, true>(lds, D / 2, S, E, wave);
        if (G == 256) {
            const int tot_ = S.bstart[NEXP] * S.nN, busy_ = tot_ - ((tot_ - 1) / G) * G, nidle_ = G - busy_; const int qa = DM_ITEMS - DEF_S4;
            if (nidle_ >= TEST_S4_MIN_IDLE) { if (vcu >= busy_) conv_down_m(a.w_down_m, Wd_m, lds, wave, qa, DM_ITEMS, (vcu - busy_) * 8 + wave, nidle_ * 8); }
            else conv_down_m(a.w_down_m, Wd_m, lds, wave, qa, DM_ITEMS, bx * 8 + wave, G * 8); }
    }
    SEAM(13);
    if (IN(14)) for (int rep = 0; rep < DUPN(14); ++rep) {
        WS_LOCAL
        SchedMoE S; S.A = (const char*)Hm; S.B = (const char*)Wd_m; S.rowtok = P_ROWTOK; S.K = DFFE / 2; S.G = G; S.c = bx; S.cx = bx; S.nN = D / 256; S.bstride = (size_t)D * DFFE; S.gather = false; S.streamk = true; S.init(P_CNT);
        EpiMoEDown E; E.Y = Yb; E.rowgate = P_ROWGATE; E.sc = 1.f / (W8_DN * H8_SC); E.pdelta = (long)((const char*)(ws + WS_R + YPART_OFF) - (const char*)Yb) - (long)2 * NTOK * D * 2;
        pg8::gemm_phase<EpiMoEDown, SchedMoE, false, true, true, true>(lds, DFFE / 2, S, E, wave);
    }
    SEAM(14);
    if (IN(15)) for (int rep = 0; rep < DUPN(15); ++rep) {
        WS_LOCAL
        PHASE_LOCALS
        f32x4 hA[4], hB[4]; u32x2 yA0[4], yA1[4], yB0[4], yB1[4];
        int nrb_ = 0;
#pragma unroll
        for (int e = 0; e < NEXP; ++e) nrb_ += (__builtin_amdgcn_readfirstlane(P_CNT[e]) + 255) >> 8;
        const int tot_ = nrb_ * (D / 256), nfr_ = tot_ / G, Sp = splitk_factor(tot_ - nfr_ * G, G);
        const int split_lo = Sp > 1 ? nfr_ * (G / (D / 256)) * 256 : 0x7fffffff;
        const unsigned char* ypart = ws + WS_R + YPART_OFF;
#define CMB_PART(Yv, p_) do { float s_[4][4]; _Pragma("unroll") for (int j = 0; j < 4; ++j) _Pragma("unroll") for (int q = 0; q < 4; ++q) s_[j][q] = 0.f; \
            for (int k0 = 0; k0 < Sp; k0 += 7) { u32x2 t_[7][4]; \
                _Pragma("unroll") for (int kk = 0; kk < 7; ++kk) { const int k_ = min(k0 + kk, Sp - 1); const u32x2* q_ = (const u32x2*)(ypart + (size_t)k_ * YPART_STRIDE + (size_t)((p_) - split_lo) * (D * 2)); \
                    _Pragma("unroll") for (int j = 0; j < 4; ++j) t_[kk][j] = q_[lane + 64 * j]; } \
                _Pragma("unroll") for (int kk = 0; kk < 7; ++kk) { const bool on_ = k0 + kk < Sp; \
                    _Pragma("unroll") for (int j = 0; j < 4; ++j) { s_[j][0] += on_ ? bf_lo(t_[kk][j].x) : 0.f; s_[j][1] += on_ ? bf_hi(t_[kk][j].x) : 0.f; s_[j][2] += on_ ? bf_lo(t_[kk][j].y) : 0.f; s_[j][3] += on_ ? bf_hi(t_[kk][j].y) : 0.f; } } } \
            _Pragma("unroll") for (int j = 0; j < 4; ++j) { Yv[j].x = pk_bf16(s_[j][0], s_[j][1]); Yv[j].y = pk_bf16(s_[j][2], s_[j][3]); } } while (0)
#define CMB_LOAD(mm, H, Y0, Y1) do { const int p0_ = __builtin_amdgcn_readfirstlane(P_POS[2 * (mm)]), p1_ = __builtin_amdgcn_readfirstlane(P_POS[2 * (mm) + 1]); \
            const u32x2* o_ = (const u32x2*)(Hb + (size_t)(mm) * D); const u32x2* y0_ = (const u32x2*)(Yb + (size_t)p0_ * D); const u32x2* y1_ = (const u32x2*)(Yb + (size_t)p1_ * D); \
            _Pragma("unroll") for (int j = 0; j < 4; ++j) { const int ch = lane + 64 * j; { const u32x2 r_ = o_[ch]; H[j] = (f32x4){bf_lo(r_.x), bf_hi(r_.x), bf_lo(r_.y), bf_hi(r_.y)}; } if (p0_ < split_lo) Y0[j] = y0_[ch]; if (p1_ < split_lo) Y1[j] = y1_[ch]; } \
            if (p0_ >= split_lo) CMB_PART(Y0, p0_); if (p1_ >= split_lo) CMB_PART(Y1, p1_); } while (0)
        int m = gw;
        if (m < NTOK) CMB_LOAD(m, hA, yA0, yA1);
        for (; m < NTOK; m += NGW) {
            const int mn = m + NGW;
            if (mn < NTOK) CMB_LOAD(mn, hB, yB0, yB1);
            f32x4* o = (f32x4*)(a.out + (size_t)m * D);
#pragma unroll
            for (int j = 0; j < 4; ++j) { f32x4 h = hA[j]; const u32x2 a0 = yA0[j], a1 = yA1[j];
                h[0] += bf_lo(a0.x) + bf_lo(a1.x); h[1] += bf_hi(a0.x) + bf_hi(a1.x); h[2] += bf_lo(a0.y) + bf_lo(a1.y); h[3] += bf_hi(a0.y) + bf_hi(a1.y); o[lane + 64 * j] = h; }
#pragma unroll
            for (int j = 0; j < 4; ++j) { hA[j] = hB[j]; yA0[j] = yB0[j]; yA1[j] = yB1[j]; }
        }
#undef CMB_LOAD
#undef CMB_PART
    }
#undef IN
#undef SEAM
#undef GRID_BAR
}

extern "C" void kernel_launch(void* const* d_in, const int* in_sizes, int n_in, void* d_out, int out_size, void* d_ws, size_t ws_size, hipStream_t stream) {
    static int grid = 0;
    if (grid == 0) {
        if (n_in != 20 || out_size != NTOK * D || ws_size < WS_END) { fprintf(stderr, "kernel_launch: unexpected shapes (n_in %d out %d ws %zu need %zu)\n", n_in, out_size, ws_size, (size_t)WS_END); grid = -1; return; }
        int dev = 0, cus = 0, per_cu = 0;
        (void)hipGetDevice(&dev); (void)hipDeviceGetAttribute(&cus, hipDeviceAttributeMultiprocessorCount, dev);
        if (hipFuncSetAttribute((const void*)mk_fwd, hipFuncAttributeMaxDynamicSharedMemorySize, LDS_BYTES) != hipSuccess) { fprintf(stderr, "kernel_launch: hipFuncSetAttribute failed\n"); grid = -1; return; }
        (void)hipOccupancyMaxActiveBlocksPerMultiprocessor(&per_cu, (const void*)mk_fwd, 512, LDS_BYTES);
        (void)hipGetLastError();
        if (per_cu < 1) { fprintf(stderr, "kernel_launch: occupancy query says %d blocks per CU\n", per_cu); per_cu = 1; }
        grid = cus;
    }
    if (grid < 0) return;
    (void)hipMemsetAsync((char*)d_ws + WS_CTL, 0, CTL_BYTES, stream);
    Args a{};
    a.x = (const float*)d_in[0]; a.mem = (const float*)d_in[1]; a.g_attn = (const float*)d_in[2]; a.w_in = (const float*)d_in[3]; a.g_qk_na = (const float*)d_in[4]; a.rpb_na = (const float*)d_in[5];
    a.g_qk_dil = (const float*)d_in[6]; a.g_mem = (const float*)d_in[7]; a.w_mem_kv = (const float*)d_in[8]; a.g_qk_mem = (const float*)d_in[9]; a.g_out = (const float*)d_in[10]; a.w_out = (const float*)d_in[11];
    a.g_ffn = (const float*)d_in[12]; a.w_gate_d = (const float*)d_in[13]; a.w_up_d = (const float*)d_in[14]; a.w_down_d = (const float*)d_in[15]; a.w_router = (const float*)d_in[16];
    a.w_gate_m = (const float*)d_in[17]; a.w_up_m = (const float*)d_in[18]; a.w_down_m = (const float*)d_in[19];
    a.out = (float*)d_out; a.ws = (unsigned char*)d_ws;
#if MK_N_LAUNCHES == 1
    a.ph_lo = 0; a.ph_hi = NPHASE;
    void* args[] = {&a};
    hipError_t e = hipLaunchCooperativeKernel((const void*)mk_fwd, dim3(grid), dim3(512), args, LDS_BYTES, stream);
    if (e != hipSuccess) fprintf(stderr, "cooperative launch failed: %s (grid %d)\n", hipGetErrorString(e), grid);
#else
    for (int p = 0; p < NPHASE; ++p) { a.ph_lo = p; a.ph_hi = p + 1; hipLaunchKernelGGL(mk_fwd, dim3(grid), dim3(512), LDS_BYTES, stream, a); }
#endif
}
```

```cpp
#include <hip/hip_runtime.h>
#include <hip/hip_cooperative_groups.h>
#include <cstdio>
#include <cstdint>
namespace cg = cooperative_groups;

#ifndef MK_N_LAUNCHES
#define MK_N_LAUNCHES 1
#endif
#ifndef DENSE_FP8_UP
#define DENSE_FP8_UP 1
#endif
#ifndef DENSE_FP8_DN
#define DENSE_FP8_DN 1
#endif

constexpr int D = 1024, SEQ = 8192, NTOK = 16384, MEMLEN = 256, NMEM = 512;
constexpr int HD = 64;
constexpr int IN_W = 2560;
constexpr int DFF = 2816, NEXP = 8, DFFE = 3584;
constexpr int PMAX = 34816;
constexpr int YPART_ROWS = PMAX - 2 * NTOK;
constexpr size_t YPART_STRIDE = (size_t)YPART_ROWS * 1024 * 2, YPART_OFF = (size_t)128 << 20;
constexpr int QKV_QA = 0, QKV_KA = 384, QKV_VA = 768, QKV_QB = 1152, QKV_KB = 1536, QKV_VB = 1920, QKV_QM = 2304;
constexpr float RMS_EPS = 1e-6f;
constexpr float LOG2E = 1.4426950408889634f;
constexpr float QSCALE = 0.125f * LOG2E;
constexpr float W8_UP = 64.f, W8_DN = 128.f, H8_SC = 8.f;

#define LAS __attribute__((address_space(3)))
#define GAS __attribute__((address_space(1)))
typedef unsigned short bf16_t;
typedef short bf16x8 __attribute__((ext_vector_type(8)));
typedef float f32x4 __attribute__((ext_vector_type(4)));
typedef float f32x2 __attribute__((ext_vector_type(2)));
typedef unsigned u32x4 __attribute__((ext_vector_type(4)));
typedef unsigned u32x2 __attribute__((ext_vector_type(2)));
typedef __bf16 bf16x2_t __attribute__((ext_vector_type(2)));

__device__ __forceinline__ unsigned pk_bf16(float lo, float hi) { f32x2 v = {lo, hi}; bf16x2_t b = __builtin_convertvector(v, bf16x2_t); return __builtin_bit_cast(unsigned, b); }
__device__ __forceinline__ unsigned pk4_fp8(float a, float b, float c, float d) { int w = 0; w = __builtin_amdgcn_cvt_pk_fp8_f32(a, b, w, false); w = __builtin_amdgcn_cvt_pk_fp8_f32(c, d, w, true); return (unsigned)w; }
__device__ __forceinline__ void st16_wt(void* p, u32x4 v) { asm volatile("global_store_dwordx4 %0, %1, off sc1\n\ts_nop 1" :: "v"(p), "v"(v) : "memory"); }
__device__ __forceinline__ float bf_lo(unsigned u) { return __uint_as_float(u << 16); }
__device__ __forceinline__ float bf_hi(unsigned u) { return __uint_as_float(u & 0xffff0000u); }
__device__ __forceinline__ float sum_x32(float v) { auto r = __builtin_amdgcn_permlane32_swap(__float_as_uint(v), __float_as_uint(v), false, false); return __uint_as_float(r[0]) + __uint_as_float(r[1]); }
__device__ __forceinline__ float sum_x16(float v) { auto r = __builtin_amdgcn_permlane16_swap(__float_as_uint(v), __float_as_uint(v), false, false); return __uint_as_float(r[0]) + __uint_as_float(r[1]); }
template <int K> __device__ __forceinline__ float swz_xor(float v) { return __uint_as_float((unsigned)__builtin_amdgcn_ds_swizzle((int)__float_as_uint(v), (K << 10) | 0x1f)); }
__device__ __forceinline__ float wave_sum(float v) { v += swz_xor<1>(v); v += swz_xor<2>(v); v += swz_xor<4>(v); v += swz_xor<8>(v); v = sum_x16(v); return sum_x32(v); }
__device__ __forceinline__ float ssq16(const float* p) {
    const f32x4* q = (const f32x4*)p; const f32x4 a = q[0], b = q[1], c = q[2], d = q[3];
    const f32x4 s = (a + b) + (c + d); return (s[0] + s[1]) + (s[2] + s[3]);
}

__device__ __forceinline__ int lane_id_now() { int l; asm volatile("v_mbcnt_lo_u32_b32 %0, -1, 0\n\tv_mbcnt_hi_u32_b32 %0, -1, %0" : "=v"(l)); return l; }
constexpr size_t al256(size_t x) { return (x + 255) & ~(size_t)255; }
constexpr size_t WS_CTL = 0, CTL_BYTES = 1u << 16;
constexpr size_t SSQ_BYTES = al256((size_t)(NTOK + 1) * 4 * 4);
constexpr size_t WS_SSQ = WS_CTL + CTL_BYTES;
constexpr size_t WS_SSQMEM = WS_SSQ + 4 * SSQ_BYTES;
constexpr size_t WS_SSQH = WS_SSQMEM + al256((size_t)NMEM * 4 * 4);
constexpr size_t WS_ROPE = WS_SSQH + al256((size_t)NTOK * 16 * 4);
constexpr size_t WS_MEMBF = WS_ROPE + al256((size_t)SEQ * 64 * 4);
constexpr size_t WS_MEMKV = WS_MEMBF + al256((size_t)NMEM * D * 2);
constexpr size_t WS_EIDX = WS_MEMKV + al256((size_t)2 * NMEM * 512 * 2);
constexpr size_t WS_GATE = WS_EIDX + al256((size_t)NTOK * 4);
constexpr size_t WS_POS = WS_GATE + al256((size_t)NTOK * 8);
constexpr size_t WS_ROWTOK = WS_POS + al256((size_t)NTOK * 8);
constexpr size_t WS_ROWGATE = WS_ROWTOK + al256((size_t)PMAX * 4);
constexpr size_t WS_CNT = WS_ROWGATE + al256((size_t)PMAX * 4);
constexpr size_t WS_RSTD3 = al256(WS_CNT + 256);
constexpr size_t WS_ROWRSTD = WS_RSTD3 + al256((size_t)NTOK * 4);
constexpr size_t WS_WGU_M = WS_ROWRSTD + al256((size_t)PMAX * 4);
constexpr size_t WS_WD_M = WS_WGU_M + (size_t)NEXP * 2 * DFFE * D;
constexpr size_t WS_HB = WS_WD_M + (size_t)NEXP * D * DFFE;
constexpr size_t WS_HB8 = WS_HB + al256((size_t)(NTOK + 1) * D * 2);
constexpr size_t WS_Y = WS_HB8 + al256((size_t)(NTOK + 1) * D);
constexpr size_t WS_R = WS_Y + (size_t)PMAX * D * 2;
constexpr size_t WS_WIN = WS_R;
constexpr size_t WS_WMEM = WS_WIN + (size_t)2 * IN_W * D * 2;
constexpr size_t WS_WOUT = WS_WMEM + (size_t)2 * 512 * D * 2;
constexpr size_t WS_WGU_D = WS_WOUT + (size_t)2 * D * D * 2;
constexpr size_t WS_WD_D = WS_WGU_D + (size_t)2 * DFF * D * 2;
constexpr size_t WS_QKV = WS_WD_D + (size_t)D * DFF * 2;
constexpr size_t WS_O = WS_QKV + (size_t)NTOK * IN_W * 2;
constexpr size_t WS_HD = WS_O + (size_t)NTOK * D * 2;
constexpr size_t WS_R_END1 = WS_HD + (size_t)NTOK * DFF * 2;
constexpr size_t WS_HM = WS_R;
constexpr size_t WS_R_END2 = WS_HM + (size_t)PMAX * DFFE;
constexpr size_t WS_END = WS_R_END1 > WS_R_END2 ? WS_R_END1 : WS_R_END2;
static_assert(WS_END <= (size_t)469762048, "workspace map exceeds 4 x the largest input tensor");

constexpr int RING_BYTES = 131072;
constexpr int LDS_BYTES = 163840;

namespace pg8 {
constexpr int BM = 256, BK = 64, HALF = 128, HTB = HALF * BK * 2, NXCD = 8, WGM = 8;
__host__ __device__ __forceinline__ int lds_byte(int r, int c) { const int st = (r >> 4) * 2 + (c >> 5), rr = r & 15, cc = c & 31, ob = rr * 64 + cc * 2; return st * 1024 + (ob ^ (((ob >> 9) & 1) << 5)); }
__host__ __device__ __forceinline__ void stage_rc(int b, int& R, int& C) { const int st = b / 1024, sb = b % 1024, swz = sb ^ (((sb >> 9) & 1) << 5); R = (st >> 1) * 16 + swz / 64; C = (st & 1) * 32 + (swz % 64) / 2; }
__host__ __device__ __forceinline__ int perm32(int rho) { const int n = rho >> 4, i = rho & 15; return 8 * (i >> 2) + 4 * n + (i & 3); }

struct Unit { int pm, pn, kind, aux; const char* A; const char* B; const int* rows; int nt2, part; };

__device__ __forceinline__ void tile_order(int L, int nM, int nN, int& pm, int& pn) {
    const int nwg = nM * nN; int wgid = L;
    { const int q = nwg / NXCD, r = nwg % NXCD, xcd = wgid % NXCD, off = wgid / NXCD; wgid = (xcd < r ? xcd * (q + 1) : r * (q + 1) + (xcd - r) * q) + off; }
    const int nig = WGM * nN, gid = wgid / nig, fm = gid * WGM, gsz = (nM - fm) < WGM ? (nM - fm) : WGM;
    pm = fm + ((wgid % nig) % gsz); pn = (wgid % nig) / gsz;
}

__host__ __device__ __forceinline__ int g8(int r) { return ((r >> 1) & 7) ^ ((((r >> 2) ^ (r >> 3)) & 1) << 1); }
__host__ __device__ __forceinline__ void stage_rc8(int b, int& R, int& C) { const int p = b >> 4, row = p >> 3, phys = p & 7; R = row; C = (phys ^ g8(row & 15)) * 8; }
typedef int v8i_t __attribute__((ext_vector_type(8)));
typedef int v4i_t __attribute__((ext_vector_type(4)));
template <class Epi, class Sched, bool GATHER, bool ALIGN_EPI, bool FP8 = false, bool SK = false, bool PUB = false>
__device__ __forceinline__ void gemm_phase(LAS unsigned char* lds, const int K, const Sched& S, const Epi& E, const int wave_in) {
    int tid = wave_in * 64 + lane_id_now(); asm volatile("" : "+v"(tid));
    const int wid = __builtin_amdgcn_readfirstlane(tid >> 6), lane = tid & 63, wr = wid >> 2, wc = wid & 3, fr = lane & 15, fq = lane >> 4;
    const int nt = K / BK;
    int RA[2], CA[2]; unsigned voffB[2];
#pragma unroll
    for (int i = 0; i < 2; ++i) { int R, C; if constexpr (FP8) stage_rc8(tid * 16 + i * 8192, R, C); else stage_rc(tid * 16 + i * 8192, R, C); const int Rb = Epi::PERM ? ((R & ~31) + perm32(R & 31)) : R;
        RA[i] = R; CA[i] = C; voffB[i] = (unsigned)(Rb * K + C) * 2u; }
    const size_t kstep = (size_t)(BK * 2);
    const size_t hstep = (size_t)HALF * K * 2;
    const unsigned ldsw = (unsigned)wid * 1024u;
    int aoffk[2], boffk[2];
    if constexpr (FP8) { const int gx = g8(fr);
        aoffk[0] = (wr * 64 + fr) * 128 + (((2 * fq) ^ gx) << 4); aoffk[1] = (wr * 64 + fr) * 128 + (((2 * fq + 1) ^ gx) << 4);
        boffk[0] = (wc * 32 + fr) * 128 + (((2 * fq) ^ gx) << 4); boffk[1] = (wc * 32 + fr) * 128 + (((2 * fq + 1) ^ gx) << 4); }
    else { aoffk[0] = lds_byte(wr * 64 + fr, fq * 8); aoffk[1] = aoffk[0] + 1024; boffk[0] = lds_byte(wc * 32 + fr, fq * 8); boffk[1] = boffk[0] + 1024; }
#define PG8_SA(b, h) (((b) * 2 + (h)) * HTB)
#define PG8_SB(b, h) ((4 + (b) * 2 + (h)) * HTB)
#define PG8_STAGE(bufoff, gbase, voff) do { _Pragma("unroll") for (int _i = 0; _i < 2; ++_i) \
        __builtin_amdgcn_global_load_lds((const unsigned*)((const char*)(gbase) + (voff)[_i]), (LAS unsigned*)(lds + (bufoff) + ldsw + _i * 8192), 16, 0, 0); } while (0)
#define PG8_LDA(dst, dst8, b, h) do { _Pragma("unroll") for (int m = 0; m < 4; ++m) { \
        if constexpr (FP8) { const v4i_t lo_ = *(const LAS v4i_t*)(lds + PG8_SA(b, h) + aoffk[0] + m * 2048), hi_ = *(const LAS v4i_t*)(lds + PG8_SA(b, h) + aoffk[1] + m * 2048); dst8[m] = __builtin_shufflevector(lo_, hi_, 0, 1, 2, 3, 4, 5, 6, 7); } \
        else { _Pragma("unroll") for (int k = 0; k < 2; ++k) dst[m][k] = *(const LAS bf16x8*)(lds + PG8_SA(b, h) + aoffk[k] + m * 2048); } } } while (0)
#define PG8_LDB(dst, dst8, b, h) do { _Pragma("unroll") for (int n = 0; n < 2; ++n) { \
        if constexpr (FP8) { const v4i_t lo_ = *(const LAS v4i_t*)(lds + PG8_SB(b, h) + boffk[0] + n * 2048), hi_ = *(const LAS v4i_t*)(lds + PG8_SB(b, h) + boffk[1] + n * 2048); dst8[n] = __builtin_shufflevector(lo_, hi_, 0, 1, 2, 3, 4, 5, 6, 7); } \
        else { _Pragma("unroll") for (int k = 0; k < 2; ++k) dst[n][k] = *(const LAS bf16x8*)(lds + PG8_SB(b, h) + boffk[k] + n * 2048); } } } while (0)
#define PG8_MMA(ai, bj, At, Bt, At8, Bt8) do { __builtin_amdgcn_s_setprio(1); _Pragma("unroll") for (int m = 0; m < 4; ++m) _Pragma("unroll") for (int n = 0; n < 2; ++n) { \
        if constexpr (FP8) asm volatile("v_mfma_scale_f32_16x16x128_f8f6f4 %0, %1, %2, %0, %3, %3 op_sel_hi:[0,0,0]" : "+v"(acc[ai][bj][m][n]) : "v"(Bt8[n]), "v"(At8[m]), "v"(sc8));   \
        else { _Pragma("unroll") for (int k = 0; k < 2; ++k) acc[ai][bj][m][n] = __builtin_amdgcn_mfma_f32_16x16x32_bf16(Bt[n][k], At[m][k], acc[ai][bj][m][n], 0, 0, 0); } } \
        __builtin_amdgcn_s_setprio(0); } while (0)
#define PG8_WAIT_V(n) asm volatile("s_waitcnt vmcnt(" #n ")" ::: "memory")
#define PG8_WAIT_L(n) asm volatile("s_waitcnt lgkmcnt(" #n ")" ::: "memory")
#define PG8_BAR __builtin_amdgcn_s_barrier()
#define PG8_SCHED __builtin_amdgcn_sched_barrier(0)
#define PG8_OFFS(u, off) do { _Pragma("unroll") for (int _h = 0; _h < 2; ++_h) _Pragma("unroll") for (int _i = 0; _i < 2; ++_i) { \
        if constexpr (GATHER) off[_h][_i] = (unsigned)(u).rows[_h * HALF + RA[_i]] * (unsigned)(K * 2) + (unsigned)(CA[_i] * 2); \
        else off[_h][_i] = (unsigned)((_h * HALF + RA[_i]) * K + CA[_i]) * 2u; } } while (0)
    constexpr int AB = Epi::AUX_BYTES; constexpr int ROWS_OFF = 131072 + 6144, AUX_OFF = 131072 + 9216;
#define PG8_AUX(u, slot) do { if constexpr (AB != 0) { if (wid < 4) { const int t_ = wave_in * 64 + lane_id_now();   const char* src_ = E.aux_src(u) + (size_t)t_ * AB; LAS unsigned* dst_ = (LAS unsigned*)(lds + AUX_OFF + (slot) * 4096 + wid * (64 * AB)); \
        if constexpr (AB == 16) __builtin_amdgcn_global_load_lds((const unsigned*)src_, dst_, 16, 0, 0); else __builtin_amdgcn_global_load_lds((const unsigned*)src_, dst_, 4, 0, 0); } } } while (0)
#define PG8_ROWS(u, slot) do { if constexpr (GATHER) { if (wid < 4) { const int t_ = wave_in * 64 + lane_id_now(); __builtin_amdgcn_global_load_lds((const unsigned*)((u).rows + t_), (LAS unsigned*)(lds + ROWS_OFF + (slot) * 1024 + wid * 256), 4, 0, 0); } } } while (0)
    int cs = 0, ns = 1;
    Unit cur, nxt; int ui = 0;
    if (!S.next(0, cur)) return;
    f32x4 acc[2][2][4][2];
#pragma unroll
    for (int a = 0; a < 2; ++a)
#pragma unroll
        for (int b = 0; b < 2; ++b)
#pragma unroll
            for (int m = 0; m < 4; ++m)
#pragma unroll
                for (int n = 0; n < 2; ++n) acc[a][b][m][n] = (f32x4){0.f, 0.f, 0.f, 0.f};
    bf16x8 At[4][2], B0[2][2], B1[2][2];
    v8i_t At8[4], B08[2], B18[2];
    int sc8 = 0x7f7f7f7f; asm volatile("" : "+v"(sc8));
    unsigned coff[2][2], noff[2][2];
    PG8_OFFS(cur, coff);
    const char* cA = cur.A; const char* cB = cur.B;
    PG8_AUX(cur, 0);
    PG8_STAGE(PG8_SB(0, 0), cB, voffB); PG8_STAGE(PG8_SB(0, 1), cB + hstep, voffB); PG8_STAGE(PG8_SA(0, 0), cA, coff[0]); PG8_STAGE(PG8_SA(0, 1), cA, coff[1]);
    if (wr == 1) PG8_BAR;
    PG8_WAIT_V(2); PG8_BAR;
    PG8_STAGE(PG8_SB(1, 0), cB + kstep, voffB); PG8_STAGE(PG8_SA(1, 0), cA + kstep, coff[0]); PG8_STAGE(PG8_SB(1, 1), cB + hstep + kstep, voffB);
    PG8_WAIT_V(6); PG8_BAR;
    for (;;) {
        const bool has_next = S.next(ui + 1, nxt);
        ns = cs == 2 ? 0 : cs + 1;
#pragma unroll
        for (int h = 0; h < 2; ++h)
#pragma unroll
            for (int i = 0; i < 2; ++i) noff[h][i] = coff[h][i];
        if (has_next) { PG8_AUX(nxt, ns); if constexpr (GATHER) { PG8_ROWS(nxt, ns); } else { PG8_OFFS(nxt, noff); } }
        const char* nA = has_next ? nxt.A : cA; const char* nB = has_next ? nxt.B : cB;
        const int ntc = (SK && cur.nt2) ? 2 * cur.nt2 : nt;
        for (int t = 0; t < ntc; t += 2) {
            const bool last = (t == ntc - 2);
            const char* a1 = cA + (size_t)(t + 1) * kstep;
            const char* a2 = last ? nA : cA + (size_t)(t + 2) * kstep; const char* b2 = last ? nB : cB + (size_t)(t + 2) * kstep;
            const char* a3 = a2 + kstep; const char* b3 = b2 + kstep;
            if constexpr (GATHER) { if (last && has_next) { const LAS int* rt_ = (const LAS int*)(lds + ROWS_OFF + ns * 1024);
#pragma unroll
                for (int h = 0; h < 2; ++h)
#pragma unroll
                    for (int i = 0; i < 2; ++i) noff[h][i] = (unsigned)rt_[h * HALF + RA[i]] * (unsigned)(K * 2) + (unsigned)(CA[i] * 2); } }
            unsigned o2[2][2];
#pragma unroll
            for (int h = 0; h < 2; ++h)
#pragma unroll
                for (int i = 0; i < 2; ++i) o2[h][i] = last ? noff[h][i] : coff[h][i];
            PG8_LDB(B0, B08, 0, 0); PG8_LDB(B1, B18, 0, 1); PG8_SCHED; PG8_LDA(At, At8, 0, 0); PG8_STAGE(PG8_SA(1, 1), a1, coff[1]);
            PG8_WAIT_V(8); PG8_WAIT_L(0); PG8_BAR; PG8_MMA(0, 0, At, B0, At8, B08); PG8_MMA(0, 1, At, B1, At8, B18); PG8_BAR; PG8_SCHED;
            PG8_LDA(At, At8, 0, 1); PG8_STAGE(PG8_SB(0, 0), b2, voffB); PG8_STAGE(PG8_SB(0, 1), b2 + hstep, voffB); PG8_STAGE(PG8_SA(0, 0), a2, o2[0]);
            PG8_WAIT_V(8); PG8_WAIT_L(0); PG8_BAR; PG8_MMA(1, 0, At, B0, At8, B08); PG8_MMA(1, 1, At, B1, At8, B18); PG8_BAR; PG8_SCHED;
            PG8_LDB(B0, B08, 1, 0); PG8_LDB(B1, B18, 1, 1); PG8_SCHED; PG8_LDA(At, At8, 1, 0); PG8_STAGE(PG8_SA(0, 1), a2, o2[1]);
            PG8_WAIT_V(8); PG8_WAIT_L(0); PG8_BAR; PG8_MMA(0, 0, At, B0, At8, B08); PG8_MMA(0, 1, At, B1, At8, B18); PG8_BAR; PG8_SCHED;
            PG8_LDA(At, At8, 1, 1); PG8_STAGE(PG8_SB(1, 0), b3, voffB); PG8_STAGE(PG8_SB(1, 1), b3 + hstep, voffB); PG8_STAGE(PG8_SA(1, 0), a3, o2[0]);
            PG8_WAIT_V(8); PG8_WAIT_L(0); PG8_BAR; PG8_MMA(1, 0, At, B0, At8, B08); PG8_MMA(1, 1, At, B1, At8, B18); PG8_BAR; PG8_SCHED;
        }
        if constexpr (FP8) asm volatile("s_nop 15\n\ts_nop 15" ::: "memory");
        if constexpr (ALIGN_EPI) { if (wr == 0) PG8_BAR; }
        E(acc, cur, wr, wc, fr, fq, (const LAS unsigned char*)(lds + AUX_OFF + cs * 4096));
        if constexpr (PUB) { const int pi_ = S.pub_index(cur); if (pi_ >= 0) {
            asm volatile("s_waitcnt vmcnt(0)" ::: "memory"); __syncthreads();
            if (wid == 0 && lane_id_now() == 0) __hip_atomic_store(S.pub + pi_, 1u, __ATOMIC_RELAXED, __HIP_MEMORY_SCOPE_AGENT); } }
        cs = ns;
        if (!has_next) break;
#pragma unroll
        for (int a = 0; a < 2; ++a)
#pragma unroll
            for (int b = 0; b < 2; ++b)
#pragma unroll
                for (int m = 0; m < 4; ++m)
#pragma unroll
                    for (int n = 0; n < 2; ++n) acc[a][b][m][n] = (f32x4){0.f, 0.f, 0.f, 0.f};
        cur = nxt; cA = nA; cB = nB; ++ui;
#pragma unroll
        for (int h = 0; h < 2; ++h)
#pragma unroll
            for (int i = 0; i < 2; ++i) coff[h][i] = noff[h][i];
        if constexpr (ALIGN_EPI) { if (wr == 1) PG8_BAR; }
    }
    PG8_WAIT_V(0);
    if constexpr (!ALIGN_EPI) { if (wr == 0) PG8_BAR; }
    PG8_BAR;
#undef PG8_SA
#undef PG8_SB
#undef PG8_STAGE
#undef PG8_LDA
#undef PG8_LDB
#undef PG8_MMA
#undef PG8_WAIT_V
#undef PG8_WAIT_L
#undef PG8_BAR
#undef PG8_SCHED
#undef PG8_OFFS
#undef PG8_AUX
#undef PG8_ROWS
}
}
using pg8::Unit;

struct SchedReg {
    const char* A; const char* B; int nM, nN, K, G, c; int nExtra; const char* memA; const char* memB;
    bool memfirst; unsigned* pub;
    __device__ __forceinline__ bool next(int i, Unit& u) const {
        const int L0 = i * G + c, nwg = nM * nN;
        if (memfirst ? (L0 >= nExtra && L0 < nExtra + nwg) : (L0 < nwg)) { const int L = memfirst ? L0 - nExtra : L0; int pm, pn; pg8::tile_order(L, nM, nN, pm, pn);
            if (memfirst) pn = pn == 0 ? nN - 1 : pn - 1;
            u.pm = pm; u.pn = pn; u.kind = 0; u.aux = 0;
            u.A = A + (size_t)pm * 256 * K * 2; u.B = B + (size_t)pn * 256 * K * 2; u.rows = nullptr; u.nt2 = 0; u.part = 0; return true; }
        const int x = memfirst ? L0 : L0 - nwg; if (x < 0 || x >= nExtra) return false;
        const int layer = x >> 2, pm = (x >> 1) & 1, pn = x & 1;
        u.pm = pm; u.pn = pn; u.kind = 1; u.aux = layer; u.A = memA + (size_t)pm * 256 * K * 2; u.B = memB + ((size_t)layer * 512 + (size_t)pn * 256) * K * 2; u.rows = nullptr; u.nt2 = 0; u.part = 0; return true;
    }
    __device__ __forceinline__ int pub_index(const Unit& u) const { return u.kind == 1 ? 64 + u.aux * 4 + u.pm * 2 + u.pn : (u.pn == nN - 1 ? u.pm : -1); }
};
#ifndef SKEW_CONV
#define SKEW_CONV 1
#endif
#ifndef TEST_S4_MIN_IDLE
#define TEST_S4_MIN_IDLE 32
#endif
#ifndef TEST_FORCE_SP
#define TEST_FORCE_SP 0
#endif
__device__ __forceinline__ int splitk_factor(int Rn, int G) { if (TEST_FORCE_SP) return G != 256 ? 1 : TEST_FORCE_SP; return G != 256 ? 1 : (Rn * 14 <= G ? 14 : (Rn * 7 <= G ? 7 : (Rn * 2 <= G ? 2 : 1))); }
struct SchedMoE {
    const char* A; const char* B; const int* rowtok; int K, G, c, nN; size_t bstride;
    int bstart[NEXP + 1];
    bool gather; bool streamk; int cx;
    __device__ __forceinline__ void init(const int* cnt) { int s = 0;
#pragma unroll
        for (int e = 0; e < NEXP; ++e) { bstart[e] = s; s += (__builtin_amdgcn_readfirstlane(cnt[e]) + 255) >> 8; } bstart[NEXP] = s; }
    __device__ __forceinline__ bool next(int i, Unit& u) const {
        const int total = bstart[NEXP] * nN; int L, t0 = 0, len = 0, part = 0, kd = 0;
        if (streamk) {
            const int nfr = total / G, Rn = total - nfr * G;
            if (i < nfr) L = i * G + ((G & 7) == 0 ? (c & 7) * (G >> 3) + (c >> 3) : c);
            else { const int NT2 = K / 128, Sp = splitk_factor(Rn, G);
                const int q_ = (i - nfr) * G + cx; if (q_ >= Rn * Sp) return false;
                const int ku = q_ / Rn; L = nfr * G + (q_ - ku * Rn); len = NT2 / Sp; t0 = ku * len; part = Sp > 1 ? 1 : 0; kd = ku; }
        } else { L = i * G + ((G & 7) == 0 ? (c & 7) * (G >> 3) + (c >> 3) : c); if (L >= total) return false; }
        int e = 0, bs = bstart[0], be = bstart[1];
#pragma unroll
        for (int k = 1; k < NEXP; ++k) if (L >= bstart[k] * nN) { e = k; bs = bstart[k]; be = bstart[k + 1]; }
        const int r = L - bs * nN, nb = be - bs;
        const int pg = r / (nb * 4), rem = r - pg * (nb * 4);
        const int pn = 4 * pg + (rem & 3), rb = bs + (rem >> 2);
        u.pm = rb; u.pn = pn; u.kind = kd; u.aux = e;
        u.A = (gather ? A : A + (size_t)rb * 256 * K * 2) + (size_t)t0 * 256; u.B = B + (size_t)e * bstride + (size_t)pn * 256 * K * 2 + (size_t)t0 * 256; u.rows = rowtok + rb * 256; u.nt2 = len; u.part = part; return true;
    }
};

#define SCHED_FENCE() __builtin_amdgcn_sched_barrier(0)
constexpr int EPI_LDS_OFF = RING_BYTES + 1024;
__device__ __forceinline__ void rows_rstd(float (&rs)[8], const LAS unsigned char* aux, const int (&rl)[8]) {
    f32x4 t[8];
#pragma unroll
    for (int g = 0; g < 8; ++g) t[g] = *(const LAS f32x4*)(aux + rl[g] * 16);
#pragma unroll
    for (int g = 0; g < 8; ++g) rs[g] = rsqrtf(((t[g][0] + t[g][1]) + (t[g][2] + t[g][3])) * (1.f / D) + RMS_EPS);
}
struct EpiQKV {
    static constexpr bool PERM = true; static constexpr int AUX_BYTES = 16;
    int wt_pn;
    long mem_delta;
    __device__ __forceinline__ const char* aux_src(const Unit& u) const { return (const char*)ssq + (u.kind == 0 ? 0L : mem_delta) + (size_t)u.pm * 256 * 16; }
    bf16_t* qkv; const float* ssq; const float* g_na; const float* g_dil; const float* g_mem;
    const float* rope; bf16_t* memkv; const float* ssqmem; const float* g_mem_all;
    LAS unsigned char* lds;
    __device__ __forceinline__ void operator()(f32x4 (&acc)[2][2][4][2], const Unit& u, int wr, int wc, int fr, int fq, const LAS unsigned char* aux) const {
        const float* gain = nullptr; bool do_rope = false; float sc = 1.f; bf16_t* out; int ldc, col0; const float* sq;
        if (u.kind == 0) {
            const int head = 4 * u.pn + wc; out = qkv + (size_t)head * NTOK * 64; ldc = 64; col0 = 0; sq = ssq;
            if (head < 6) { gain = g_na; sc = QSCALE; }
            else if (head < 12) { gain = g_na + 64; }
            else if (head < 18) { }
            else if (head < 24) { gain = g_dil; do_rope = true; sc = QSCALE; }
            else if (head < 30) { gain = g_dil + 64; do_rope = true; }
            else if (head < 36) { }
            else { gain = g_mem; sc = QSCALE; }
        } else {
            out = memkv + (size_t)u.aux * NMEM * 512; ldc = 512; col0 = 256 * u.pn + 64 * wc; sq = ssqmem;
            if (u.pn == 0) gain = g_mem_all + u.aux * 128 + 64;
        }
        int tok[8], rl[8]; (void)sq;
#pragma unroll
        for (int g = 0; g < 8; ++g) { rl[g] = (g >> 2) * 128 + wr * 64 + (g & 3) * 16 + fr; tok[g] = u.pm * 256 + rl[g]; }
        float rs[8]; rows_rstd(rs, aux, rl);
        f32x4 gv[2][2];
#pragma unroll
        for (int bj = 0; bj < 2; ++bj)
#pragma unroll
            for (int n = 0; n < 2; ++n) gv[bj][n] = gain ? *(const f32x4*)(gain + 32 * bj + 8 * fq + 4 * n) * sc : (f32x4){sc, sc, sc, sc};
#pragma unroll
        for (int g = 0; g < 8; ++g) {
            const int ai = g >> 2, m = g & 3; float r2 = rs[g];
            if (gain) {
                float ms = 0.f;
#pragma unroll
                for (int bj = 0; bj < 2; ++bj)
#pragma unroll
                    for (int n = 0; n < 2; ++n) { const f32x4 x = acc[ai][bj][m][n]; ms += (x[0] * x[0] + x[1] * x[1]) + (x[2] * x[2] + x[3] * x[3]); }
                ms = sum_x16(ms); ms = sum_x32(ms);
                r2 = rs[g] * rsqrtf(ms * rs[g] * rs[g] * (1.f / HD) + RMS_EPS);
            }
#pragma unroll
            for (int bj = 0; bj < 2; ++bj)
#pragma unroll
                for (int n = 0; n < 2; ++n) acc[ai][bj][m][n] = acc[ai][bj][m][n] * r2 * gv[bj][n];
        }
        u32x4 P[8][2];
        if (do_rope) {
            f32x4 rc[2][4];
#define ROPE_LD(g, slot) do { const float* rp_ = rope + (size_t)(tok[g] & (SEQ - 1)) * 64 + 8 * fq; rc[slot][0] = *(const f32x4*)(rp_); rc[slot][1] = *(const f32x4*)(rp_ + 4); rc[slot][2] = *(const f32x4*)(rp_ + 32); rc[slot][3] = *(const f32x4*)(rp_ + 36); } while (0)
            ROPE_LD(0, 0); ROPE_LD(1, 1);
#pragma unroll
            for (int g = 0; g < 8; ++g) { const int ai = g >> 2, m = g & 3;
#pragma unroll
                for (int n = 0; n < 2; ++n) { const f32x4 cs = rc[g & 1][n], sn = rc[g & 1][2 + n]; const f32x4 x1 = acc[ai][0][m][n], x2 = acc[ai][1][m][n];
                    acc[ai][0][m][n] = x1 * cs - x2 * sn; acc[ai][1][m][n] = x1 * sn + x2 * cs; }
                SCHED_FENCE();
                if (g + 2 < 8) { ROPE_LD(g + 2, g & 1); }
                SCHED_FENCE();
            }
#undef ROPE_LD
        }
#pragma unroll
        for (int g = 0; g < 8; ++g) { const int ai = g >> 2, m = g & 3;
#pragma unroll
            for (int bj = 0; bj < 2; ++bj) { const f32x4 a = acc[ai][bj][m][0], b = acc[ai][bj][m][1];
                P[g][bj].x = pk_bf16(a[0], a[1]); P[g][bj].y = pk_bf16(a[2], a[3]); P[g][bj].z = pk_bf16(b[0], b[1]); P[g][bj].w = pk_bf16(b[2], b[3]); } }
        if (u.kind == 1 || u.pn == wt_pn) {
#pragma unroll
            for (int g = 0; g < 8; ++g) { bf16_t* rowp = out + (size_t)tok[g] * ldc + col0 + 8 * fq; st16_wt(rowp, P[g][0]); st16_wt(rowp + 32, P[g][1]); }
        } else {
#pragma unroll
            for (int g = 0; g < 8; ++g) { bf16_t* rowp = out + (size_t)tok[g] * ldc + col0 + 8 * fq; *(u32x4*)(rowp) = P[g][0]; *(u32x4*)(rowp + 32) = P[g][1]; }
        }
    }
};
struct EpiResid {
    static constexpr bool PERM = true; static constexpr int AUX_BYTES = 0;
    __device__ __forceinline__ const char* aux_src(const Unit&) const { return nullptr; }
    bf16_t* hb; float* ssq_out; LAS unsigned char* lds; unsigned char* hb8; float asc;
    __device__ __forceinline__ void operator()(f32x4 (&acc)[2][2][4][2], const Unit& u, int wr, int wc, int fr, int fq, const LAS unsigned char*) const {
        const int col0 = u.pn * 256 + wc * 32 + 8 * fq;
        u32x4 rb[4][2];
#define RES_LD(g, slot) do { const bf16_t* p_ = hb + (size_t)(u.pm * 256 + ((g) >> 2) * 128 + wr * 64 + ((g) & 3) * 16 + fr) * D + col0; rb[slot][0] = *(const u32x4*)p_; rb[slot][1] = *(const u32x4*)(p_ + 128); } while (0)
        RES_LD(0, 0); RES_LD(1, 1); RES_LD(2, 2); RES_LD(3, 3);
        LAS float* red = (LAS float*)(lds + EPI_LDS_OFF);
#pragma unroll
        for (int g = 0; g < 8; ++g) { const int ai = g >> 2, m = g & 3; float s = 0.f;
#pragma unroll
            for (int bj = 0; bj < 2; ++bj) { const u32x4 r = rb[g & 3][bj];
                f32x4 h0 = acc[ai][bj][m][0] * asc, h1 = acc[ai][bj][m][1] * asc;
                h0[0] += bf_lo(r.x); h0[1] += bf_hi(r.x); h0[2] += bf_lo(r.y); h0[3] += bf_hi(r.y); h1[0] += bf_lo(r.z); h1[1] += bf_hi(r.z); h1[2] += bf_lo(r.w); h1[3] += bf_hi(r.w);
                acc[ai][bj][m][0] = h0; acc[ai][bj][m][1] = h1;
                s += ((h0[0] * h0[0] + h0[1] * h0[1]) + (h0[2] * h0[2] + h0[3] * h0[3])) + ((h1[0] * h1[0] + h1[1] * h1[1]) + (h1[2] * h1[2] + h1[3] * h1[3])); }
            SCHED_FENCE();
            if (g + 4 < 8) { RES_LD(g + 4, g & 3); }
            SCHED_FENCE();
            s = sum_x16(s); s = sum_x32(s);
            if (fq == 0) red[(ai * 128 + wr * 64 + m * 16 + fr) * 4 + wc] = s; }
#undef RES_LD
        asm volatile("s_waitcnt lgkmcnt(0)" ::: "memory"); __builtin_amdgcn_s_barrier(); asm volatile("" ::: "memory");
        { const int t = (wr * 4 + wc) * 64 + fq * 16 + fr; if (t < 256) { const f32x4 p = *(const LAS f32x4*)(red + t * 4); ssq_out[(size_t)(u.pm * 256 + t) * 4 + u.pn] = (p[0] + p[1]) + (p[2] + p[3]); } }
#pragma unroll
        for (int g = 0; g < 8; ++g) { const int ai = g >> 2, m = g & 3; const size_t off = (size_t)(u.pm * 256 + ai * 128 + wr * 64 + m * 16 + fr) * D + col0;
#pragma unroll
            for (int bj = 0; bj < 2; ++bj) { const f32x4 h0 = acc[ai][bj][m][0], h1 = acc[ai][bj][m][1];
                u32x4 w; w.x = pk_bf16(h0[0], h0[1]); w.y = pk_bf16(h0[2], h0[3]); w.z = pk_bf16(h1[0], h1[1]); w.w = pk_bf16(h1[2], h1[3]); *(u32x4*)(hb + off + bj * 128) = w;
                if (hb8) { u32x2 w8; w8.x = pk4_fp8(h0[0], h0[1], h0[2], h0[3]); w8.y = pk4_fp8(h1[0], h1[1], h1[2], h1[3]); *(u32x2*)(hb8 + off + bj * 128) = w8; } } }
        asm volatile("s_waitcnt lgkmcnt(0)" ::: "memory"); __builtin_amdgcn_s_barrier(); asm volatile("" ::: "memory");
    }
};
template <bool MOE> struct EpiSwiGLU {
    static constexpr bool PERM = true; static constexpr int AUX_BYTES = MOE ? 4 : 16;
    bf16_t* H; int ldh; const float* ssq; const float* rowrstd; unsigned char* H8; float ascale, oscale;
    __device__ __forceinline__ const char* aux_src(const Unit& u) const { return MOE ? (const char*)(rowrstd + (size_t)u.pm * 256) : (const char*)(ssq + (size_t)u.pm * 256 * 4); }
    __device__ __forceinline__ void operator()(f32x4 (&acc)[2][2][4][2], const Unit& u, int wr, int wc, int fr, int fq, const LAS unsigned char* aux) const {
        const int col0 = u.pn * 128 + wc * 32 + 8 * fq;
        int rl[8];
#pragma unroll
        for (int g = 0; g < 8; ++g) rl[g] = (g >> 2) * 128 + wr * 64 + (g & 3) * 16 + fr;
        float rs[8];
        if constexpr (MOE) {
#pragma unroll
            for (int g = 0; g < 8; ++g) rs[g] = *(const LAS float*)(aux + rl[g] * 4);
        } else rows_rstd(rs, aux, rl);
#pragma unroll
        for (int g = 0; g < 8; ++g) { const int ai = g >> 2, m = g & 3; unsigned wv[4];
            const float a_ = rs[g] * ascale, ic_ = __builtin_amdgcn_rcpf(a_ * a_ * (H8 ? oscale : 1.f)); const f32x2 aL2 = {-a_ * LOG2E, -a_ * LOG2E}, ic2 = {ic_, ic_};
#pragma unroll
            for (int n = 0; n < 2; ++n) { const f32x4 G4 = acc[ai][0][m][n], U4 = acc[ai][1][m][n]; float o[4];
#pragma unroll
                for (int h = 0; h < 2; ++h) { const f32x2 Gh = {G4[2 * h], G4[2 * h + 1]}, Uh = {U4[2 * h], U4[2 * h + 1]}; const f32x2 p = Gh * Uh, x = Gh * aL2;
                    f32x2 e; e.x = __builtin_amdgcn_exp2f(x.x); e.y = __builtin_amdgcn_exp2f(x.y); const f32x2 d = e * ic2 + ic2;
                    f32x2 r; r.x = __builtin_amdgcn_rcpf(d.x); r.y = __builtin_amdgcn_rcpf(d.y); const f32x2 q = p * r; o[2 * h] = q.x; o[2 * h + 1] = q.y; }
                if (H8) { wv[n] = pk4_fp8(__builtin_amdgcn_fmed3f(o[0], -448.f, 448.f), __builtin_amdgcn_fmed3f(o[1], -448.f, 448.f), __builtin_amdgcn_fmed3f(o[2], -448.f, 448.f), __builtin_amdgcn_fmed3f(o[3], -448.f, 448.f)); }
                else { wv[2 * n] = pk_bf16(o[0], o[1]); wv[2 * n + 1] = pk_bf16(o[2], o[3]); } }
            if (H8) { u32x2 w2; w2.x = wv[0]; w2.y = wv[1]; *(u32x2*)(H8 + (size_t)(u.pm * 256 + rl[g]) * ldh + col0) = w2; }
            else { u32x4 w4; w4.x = wv[0]; w4.y = wv[1]; w4.z = wv[2]; w4.w = wv[3]; *(u32x4*)(H + (size_t)(u.pm * 256 + rl[g]) * ldh + col0) = w4; }
            SCHED_FENCE(); }
    }
};
struct EpiMoEDown {
    static constexpr bool PERM = true; static constexpr int AUX_BYTES = 4, STORES = 16;
    __device__ __forceinline__ const char* aux_src(const Unit& u) const { return (const char*)(rowgate + (size_t)u.pm * 256); }
    bf16_t* Y; const float* rowgate; float sc; long pdelta;
    __device__ __forceinline__ void operator()(f32x4 (&acc)[2][2][4][2], const Unit& u, int wr, int wc, int fr, int fq, const LAS unsigned char* aux) const {
        const int col0 = u.pn * 256 + wc * 32 + 8 * fq;
        float gt[8];
#pragma unroll
        for (int g = 0; g < 8; ++g) gt[g] = *(const LAS float*)(aux + ((g >> 2) * 128 + wr * 64 + (g & 3) * 16 + fr) * 4) * sc;
        u32x4 W[8][2];
#pragma unroll
        for (int g = 0; g < 8; ++g) { const int ai = g >> 2, m = g & 3;
#pragma unroll
            for (int bj = 0; bj < 2; ++bj) { const f32x4 a = acc[ai][bj][m][0] * gt[g], b = acc[ai][bj][m][1] * gt[g];
                W[g][bj].x = pk_bf16(a[0], a[1]); W[g][bj].y = pk_bf16(a[2], a[3]); W[g][bj].z = pk_bf16(b[0], b[1]); W[g][bj].w = pk_bf16(b[2], b[3]); } }
        char* yo = (char*)Y + (u.part == 1 ? pdelta + (long)u.kind * (long)YPART_STRIDE : 0L);
#pragma unroll
        for (int g = 0; g < 8; ++g) { const int row = u.pm * 256 + (g >> 2) * 128 + wr * 64 + (g & 3) * 16 + fr; bf16_t* yp = (bf16_t*)yo + (size_t)row * D + col0; *(u32x4*)yp = W[g][0]; *(u32x4*)(yp + 128) = W[g][1]; }
    }
};

#define XB_TMO      128
#define XB_XCNT(j)  (256  + 64 * (j))
#define XB_XSUB(j)  (1280 + 64 * (j))
#define XB_XGEN(j)  (2304 + 64 * (j))
#define XB_TOP      3328
#define XB_TOPGEN   3392
#define XCD_BAR_WORDS 3456
#define XB_SPIN_CAP (1u << 20)
__device__ __forceinline__ unsigned xb_ld(unsigned* p)              { return __hip_atomic_load(p, __ATOMIC_RELAXED, __HIP_MEMORY_SCOPE_AGENT); }
__device__ __forceinline__ unsigned xb_add(unsigned* p, unsigned v) { return __hip_atomic_fetch_add(p, v, __ATOMIC_RELAXED, __HIP_MEMORY_SCOPE_AGENT); }
__device__ __forceinline__ unsigned xb_xcc_id() { return (unsigned)__builtin_amdgcn_s_getreg((3 << 11) | 20) & 0xFu; }
#define XB_SPIN(cond, bar) do { unsigned _sp = 0; while (cond) { __builtin_amdgcn_s_sleep(1); \
    if ((++_sp & 255u) == 0u) { if (xb_ld(&(bar)[XB_TMO])) break; if (_sp > XB_SPIN_CAP) { atomicAdd(&(bar)[XB_TMO], 1u); break; } } } } while (0)
struct XcdBarrier { unsigned* bar; unsigned x; volatile LAS unsigned* st; int w; };
__device__ __forceinline__ XcdBarrier xcd_barrier_post(unsigned* bar, volatile LAS unsigned* st, int wave) {
    XcdBarrier b; b.bar = bar; b.x = xb_xcc_id(); b.st = st; b.w = wave;
    if (wave == 0 && lane_id_now() == 0) (void)xb_add(&bar[XB_XCNT(b.x)], 1u);
    return b;
}
__device__ __forceinline__ void xcd_barrier_complete(unsigned* bar, unsigned x, unsigned& nloc, unsigned& nx) {
    const unsigned G = gridDim.x * gridDim.y * gridDim.z;
    unsigned sum, cnt, mine, sp = 0u;
    for (;;) {
        sum = 0u; cnt = 0u; mine = 0u;
#pragma unroll
        for (unsigned j = 0; j < 16; ++j) { const unsigned c = xb_ld(&bar[XB_XCNT(j)]); sum += c; cnt += (c > 0u) ? 1u : 0u; mine = (j == x) ? c : mine; }
        if (sum == G) break;
        __builtin_amdgcn_s_sleep(1);
        if ((++sp & 255u) == 0u) { if (xb_ld(&bar[XB_TMO])) break; if (sp > XB_SPIN_CAP) { atomicAdd(&bar[XB_TMO], 1u); break; } }
    }
    nloc = mine > 0u ? mine : 1u; nx = cnt > 0u ? cnt : 1u;
}
__device__ __forceinline__ void xcd_barrier(const XcdBarrier& b) {
    asm volatile("s_waitcnt vmcnt(0)" ::: "memory");
    __syncthreads();
    if (b.w == 0 && lane_id_now() == 0) {
        unsigned* bar = b.bar;
        __builtin_amdgcn_s_waitcnt(0);
        unsigned nloc = b.st[0], nx = b.st[1];
        if (nloc == 0u) { xcd_barrier_complete(bar, b.x, nloc, nx); b.st[0] = nloc; b.st[1] = nx; }
        const unsigned old = xb_add(&bar[XB_XSUB(b.x)], 1u);
        const unsigned gen = old / nloc;
        if (old + 1u == (gen + 1u) * nloc) {
            __builtin_amdgcn_fence(__ATOMIC_RELEASE, "agent");
            asm volatile("s_waitcnt vmcnt(0)" ::: "memory");
            __builtin_amdgcn_fence(__ATOMIC_ACQUIRE, "agent");
            const unsigned og = xb_add(&bar[XB_TOP], 1u);
            const unsigned tg = og / nx;
            if (og + 1u == (tg + 1u) * nx) xb_add(&bar[XB_TOPGEN], 1u);
            else XB_SPIN(xb_ld(&bar[XB_TOPGEN]) == tg, bar);
            xb_add(&bar[XB_XGEN(b.x)], 1u);
            asm volatile("s_waitcnt vmcnt(0)" ::: "memory");
        } else {
            __builtin_amdgcn_fence(__ATOMIC_ACQUIRE, "agent");
            XB_SPIN(xb_ld(&bar[XB_XGEN(b.x)]) == gen, bar);
            asm volatile("s_waitcnt vmcnt(0)" ::: "memory");
        }
    }
    __syncthreads();
}
constexpr int CW_BAR = 1024;
constexpr int MISC_OFF = RING_BYTES + 320;
static_assert((CW_BAR + XCD_BAR_WORDS) * 4 <= (int)CTL_BYTES, "barrier words inside the memset region");

struct Args {
    const float* x; const float* mem; const float* g_attn; const float* w_in; const float* g_qk_na; const float* rpb_na; const float* g_qk_dil; const float* g_mem;
    const float* w_mem_kv; const float* g_qk_mem; const float* g_out; const float* w_out; const float* g_ffn; const float* w_gate_d; const float* w_up_d; const float* w_down_d;
    const float* w_router; const float* w_gate_m; const float* w_up_m; const float* w_down_m;
    float* out; unsigned char* ws; int ph_lo, ph_hi;
};

__device__ __forceinline__ void conv_item(const float* W, int K, int N, const float* gain, bf16_t* WT, int k0, int n0, int dst_row0, LAS float* scr, int lane) {
    const int r8 = lane >> 3, c4 = (lane & 7) * 4;
#pragma unroll
    for (int i = 0; i < 8; ++i) { const int kk = 8 * i + r8; const f32x4 v = *(const f32x4*)(W + (size_t)(k0 + kk) * N + n0 + c4);
        const float g = gain ? gain[k0 + kk] : 1.f; LAS float* s = scr + kk * 33 + c4; s[0] = v[0] * g; s[1] = v[1] * g; s[2] = v[2] * g; s[3] = v[3] * g; }
    asm volatile("s_waitcnt lgkmcnt(0)" ::: "memory");
    const int c = lane & 7;
#pragma unroll
    for (int j = 0; j < 4; ++j) { const int n = (lane >> 3) + 8 * j; const LAS float* s = scr + (8 * c) * 33 + n;
        u32x4 o; o.x = pk_bf16(s[0 * 33], s[1 * 33]); o.y = pk_bf16(s[2 * 33], s[3 * 33]); o.z = pk_bf16(s[4 * 33], s[5 * 33]); o.w = pk_bf16(s[6 * 33], s[7 * 33]);
        *(u32x4*)(WT + (size_t)(dst_row0 + n) * K + k0 + 8 * c) = o; }
    asm volatile("s_waitcnt lgkmcnt(0)" ::: "memory");
}
__device__ __forceinline__ void conv_item8(const float* W, int K, int N, const float* gain, float scale, unsigned char* WT, int k0, int n0, int dst_row0, LAS float* scr, int lane) {
    const int r8 = lane >> 3, c4 = (lane & 7) * 4;
#pragma unroll
    for (int i = 0; i < 8; ++i) { const int kk = 8 * i + r8; const f32x4 v = *(const f32x4*)(W + (size_t)(k0 + kk) * N + n0 + c4);
        const float g = (gain ? gain[k0 + kk] : 1.f) * scale; LAS float* s = scr + kk * 33 + c4; s[0] = v[0] * g; s[1] = v[1] * g; s[2] = v[2] * g; s[3] = v[3] * g; }
    asm volatile("s_waitcnt lgkmcnt(0)" ::: "memory");
    const int c = lane & 7;
#pragma unroll
    for (int j = 0; j < 4; ++j) { const int n = (lane >> 3) + 8 * j; const LAS float* s = scr + (8 * c) * 33 + n;
        u32x2 o; o.x = pk4_fp8(s[0 * 33], s[1 * 33], s[2 * 33], s[3 * 33]); o.y = pk4_fp8(s[4 * 33], s[5 * 33], s[6 * 33], s[7 * 33]);
        *(u32x2*)(WT + (size_t)(dst_row0 + n) * K + k0 + 8 * c) = o; }
    asm volatile("s_waitcnt lgkmcnt(0)" ::: "memory");
}
__device__ __forceinline__ int map_head(int n) { const int head = n >> 6, d = n & 63; return 256 * (head >> 2) + 128 * (d >> 5) + 32 * (head & 3) + (d & 31); }
__device__ __forceinline__ int map_gate(int n) { return 256 * (n >> 7) + (n & 127); }
__device__ __forceinline__ int map_up(int n) { return 256 * (n >> 7) + 128 + (n & 127); }

__device__ __forceinline__ void attn_key(const bf16_t* kp, const bf16_t* vp, const float (&q)[64], float bias, float& m, float& l, float (&o)[64]) {
    float s = bias;
#pragma unroll
    for (int c = 0; c < 8; ++c) { const u32x4 kk = *(const u32x4*)(kp + 8 * c);
        s += q[8 * c + 0] * bf_lo(kk.x) + q[8 * c + 1] * bf_hi(kk.x) + q[8 * c + 2] * bf_lo(kk.y) + q[8 * c + 3] * bf_hi(kk.y)
           + q[8 * c + 4] * bf_lo(kk.z) + q[8 * c + 5] * bf_hi(kk.z) + q[8 * c + 6] * bf_lo(kk.w) + q[8 * c + 7] * bf_hi(kk.w); }
    const float mn = fmaxf(m, s), a = exp2f(m - mn), p = exp2f(s - mn);
    l = l * a + p; m = mn;
#pragma unroll
    for (int c = 0; c < 8; ++c) { const u32x4 vv = *(const u32x4*)(vp + 8 * c);
        o[8 * c + 0] = o[8 * c + 0] * a + p * bf_lo(vv.x); o[8 * c + 1] = o[8 * c + 1] * a + p * bf_hi(vv.x);
        o[8 * c + 2] = o[8 * c + 2] * a + p * bf_lo(vv.y); o[8 * c + 3] = o[8 * c + 3] * a + p * bf_hi(vv.y);
        o[8 * c + 4] = o[8 * c + 4] * a + p * bf_lo(vv.z); o[8 * c + 5] = o[8 * c + 5] * a + p * bf_hi(vv.z);
        o[8 * c + 6] = o[8 * c + 6] * a + p * bf_lo(vv.w); o[8 * c + 7] = o[8 * c + 7] * a + p * bf_hi(vv.w); }
}
__device__ __forceinline__ void attn_scalar_phase(const bf16_t* qkv, const bf16_t* memkv, const float* rpb, bf16_t* O, float* ssqh, int G) {
    int tidp = threadIdx.x; asm volatile("" : "+v"(tidp));
    for (int idx = blockIdx.x * 512 + tidp; idx < NTOK * 16; idx += G * 512) {
        const int head = idx / NTOK, tok = idx % NTOK, b = tok / SEQ, t = tok % SEQ;
        int qcol; if (head < 6) qcol = QKV_QA + 64 * head; else if (head < 12) qcol = QKV_QB + 64 * (head - 6); else qcol = QKV_QM + 64 * (head - 12);
        float q[64], o[64];
        { const bf16_t* qp = qkv + (size_t)tok * IN_W + qcol;
#pragma unroll
          for (int c = 0; c < 8; ++c) { const u32x4 kk = *(const u32x4*)(qp + 8 * c); q[8 * c + 0] = bf_lo(kk.x); q[8 * c + 1] = bf_hi(kk.x); q[8 * c + 2] = bf_lo(kk.y); q[8 * c + 3] = bf_hi(kk.y);
              q[8 * c + 4] = bf_lo(kk.z); q[8 * c + 5] = bf_hi(kk.z); q[8 * c + 6] = bf_lo(kk.w); q[8 * c + 7] = bf_hi(kk.w); } }
#pragma unroll
        for (int d = 0; d < 64; ++d) o[d] = 0.f;
        float m = -1e30f, l = 0.f;
        if (head < 6) {
            const int r = t >> 6, c = t & 63; int rs = r - 4; rs = rs < 0 ? 0 : (rs > 120 ? 120 : rs); int cs = c - 8; cs = cs < 0 ? 0 : (cs > 48 ? 48 : cs);
            const float* bp = rpb + head * 465;
            for (int i = 0; i < 8; ++i) for (int j = 0; j < 16; ++j) {
                const int kt = b * SEQ + (rs + i) * 64 + cs + j; const float bias = bp[(rs + i - r + 7) * 31 + (cs + j - c + 15)] * LOG2E;
                attn_key(qkv + (size_t)kt * IN_W + QKV_KA + 64 * head, qkv + (size_t)kt * IN_W + QKV_VA + 64 * head, q, bias, m, l, o); }
        } else if (head < 12) {
            const int hh = head - 6;
            for (int g = 0; g < 3; ++g) { const int dd = g == 0 ? 1 : (g == 1 ? 4 : 16);
                for (int j = -64; j <= 64; ++j) { const int pos = t + dd * j; if (pos < 0 || pos >= SEQ) continue; const int kt = b * SEQ + pos;
                    attn_key(qkv + (size_t)kt * IN_W + QKV_KB + 64 * hh, qkv + (size_t)kt * IN_W + QKV_VB + 64 * hh, q, 0.f, m, l, o); } }
        } else {
            const int hh = head - 12;
            for (int j = 0; j < MEMLEN; ++j) { const bf16_t* kp = memkv + (size_t)(b * MEMLEN + j) * 512 + 64 * hh; attn_key(kp, kp + 256, q, 0.f, m, l, o); }
        }
        const float il = 1.f / l; float ss = 0.f; bf16_t* op = O + (size_t)tok * D + 64 * head;
#pragma unroll
        for (int c = 0; c < 8; ++c) { float v[8];
#pragma unroll
            for (int e = 0; e < 8; ++e) { v[e] = o[8 * c + e] * il; ss += v[e] * v[e]; }
            u32x4 w; w.x = pk_bf16(v[0], v[1]); w.y = pk_bf16(v[2], v[3]); w.z = pk_bf16(v[4], v[5]); w.w = pk_bf16(v[6], v[7]); *(u32x4*)(op + 8 * c) = w; }
        ssqh[(size_t)tok * 16 + head] = ss;
    }
}

typedef float f32x16 __attribute__((ext_vector_type(16)));
typedef short s16x4 __attribute__((ext_vector_type(4)));
typedef short v4i16_t __attribute__((ext_vector_type(4)));
#define MFMA32(a, b, c) __builtin_amdgcn_mfma_f32_32x32x16_bf16((a), (b), (c), 0, 0, 0)
__device__ __forceinline__ s16x4 tr_read(const LAS unsigned char* p) { return __builtin_bit_cast(s16x4, __builtin_amdgcn_ds_read_tr16_b64_v4i16((LAS v4i16_t*)p)); }
constexpr int ATT_TAB_OFF = 139264;
struct AttnSt { f32x16 o0, o1; float m, l; bf16x8 q[4]; };

template <int MODE, bool LDSRES = false, bool ONESET = false>
__device__ __forceinline__ void attn_blocks(AttnSt& st, LAS unsigned char* vbuf, const bf16_t* kb, const bf16_t* vb, const int pitch, const int tokbase,
                                            const int t0, const int blockstep, const int dstep, const int tmax, const int nblk, const int lane_in,
                                            const int p0, const int p1, const int p2, const LAS float* tab) {
    int lane_o = lane_in; asm volatile("" : "+v"(lane_o)); const int lane = lane_o;
    const int r32 = lane & 31, hi = lane >> 5;
    const int vkey = lane >> 3, vch = lane & 7;
    const int w0 = vkey * 128 + (((vch >> 2) ^ ((lane >> 4) & 1)) << 6) + (vch & 3) * 16;
    const int q4 = (lane & 15) >> 2;
    const int rb0 = (4 * hi + q4) * 128 + (((q4 >> 1) & 1) << 6) + 32 * ((lane >> 4) & 1) + 8 * (lane & 3);
    u32x4 kA[4], kB[4], vA[4], vB[4];
    const int wk0 = vkey * 128 + ((vch ^ (vkey >> 1)) << 4), wk1 = vkey * 128 + ((vch ^ (vkey >> 1) ^ 4) << 4);
    const int kx = (r32 >> 1) & 7;
    const int rk0 = r32 * 128 + (((0 + hi) ^ kx) << 4), rk1 = r32 * 128 + (((2 + hi) ^ kx) << 4), rk2 = r32 * 128 + (((4 + hi) ^ kx) << 4), rk3 = r32 * 128 + (((6 + hi) ^ kx) << 4);
#define ATT_TOK(j, i) (tokbase + min(max(t0 + (j) * blockstep + (i) * dstep, 0), tmax))
#define ATT_LOAD(j, KR, VR) do { \
        _Pragma("unroll") for (int i_ = 0; i_ < 4; ++i_) { const size_t ro_ = (size_t)ATT_TOK(j, vkey + 8 * i_) * pitch + 8 * vch; KR[i_] = *(const u32x4*)(kb + ro_); VR[i_] = *(const u32x4*)(vb + ro_); } } while (0)
#define ATT_QK(S, ks_) do { \
        const bf16x8 kf0 = *(const LAS bf16x8*)((ks_) + rk0), kf1 = *(const LAS bf16x8*)((ks_) + rk1), kf2 = *(const LAS bf16x8*)((ks_) + rk2), kf3 = *(const LAS bf16x8*)((ks_) + rk3); \
        _Pragma("unroll") for (int r = 0; r < 16; ++r) S[r] = 0.f; \
        S = MFMA32(kf0, st.q[0], S); S = MFMA32(kf1, st.q[1], S); S = MFMA32(kf2, st.q[2], S); S = MFMA32(kf3, st.q[3], S); } while (0)
#define ATT_MASK(S, j) do { \
        int mlo = 0, mcnt = 32; \
        if (MODE == 0) { mlo = -p1; mcnt = ((unsigned)(p0 + (j)) < 8u) ? 16 : 0; } \
        else if (MODE == 1) { const int b0_ = p0 + 32 * (j); mlo = max(p2 - 64, 0) - b0_; mcnt = max(min(p2 + 64, p1 - 1) - b0_ - mlo + 1, 0); } \
        const bool allv = (MODE == 2) || __all(mlo <= 0 && mlo + mcnt >= 32); \
        if (MODE == 0) { _Pragma("unroll") for (int r = 0; r < 16; ++r) S[r] += tab[p2 + 64 * (j) + (r & 3) + 8 * (r >> 2) + 4 * hi]; } \
        if (!allv) { const int e0_ = 4 * hi - mlo; \
            _Pragma("unroll") for (int r = 0; r < 16; ++r) S[r] = ((unsigned)(e0_ + (r & 3) + 8 * (r >> 2)) < (unsigned)mcnt) ? S[r] : -INFINITY; } } while (0)
#define ATT_MAX16(S) fmaxf(fmaxf(fmaxf(fmaxf(S[0], S[1]), fmaxf(S[2], S[3])), fmaxf(fmaxf(S[4], S[5]), fmaxf(S[6], S[7]))), fmaxf(fmaxf(fmaxf(S[8], S[9]), fmaxf(S[10], S[11])), fmaxf(fmaxf(S[12], S[13]), fmaxf(S[14], S[15]))))
#define ATT_SUM16(S) ((((S[0] + S[1]) + (S[2] + S[3])) + ((S[4] + S[5]) + (S[6] + S[7]))) + (((S[8] + S[9]) + (S[10] + S[11])) + ((S[12] + S[13]) + (S[14] + S[15]))))
#define ATT_PV(S, vs_) do { \
        bf16x8 pb[2]; \
        _Pragma("unroll") for (int s = 0; s < 2; ++s) { u32x4 w; w.x = pk_bf16(S[8 * s + 0], S[8 * s + 1]); w.y = pk_bf16(S[8 * s + 2], S[8 * s + 3]); w.z = pk_bf16(S[8 * s + 4], S[8 * s + 5]); w.w = pk_bf16(S[8 * s + 6], S[8 * s + 7]); \
            pb[s] = __builtin_bit_cast(bf16x8, w); } \
        _Pragma("unroll") for (int s = 0; s < 2; ++s) { \
            const s16x4 a0 = tr_read((vs_) + rb0 + s * 2048), a1 = tr_read((vs_) + rb0 + s * 2048 + 1024); \
            const s16x4 b0 = tr_read((vs_) + (rb0 ^ 64) + s * 2048), b1 = tr_read((vs_) + (rb0 ^ 64) + s * 2048 + 1024); \
            const bf16x8 va = (bf16x8){a0[0], a0[1], a0[2], a0[3], a1[0], a1[1], a1[2], a1[3]}; \
            const bf16x8 vb8 = (bf16x8){b0[0], b0[1], b0[2], b0[3], b1[0], b1[1], b1[2], b1[3]}; \
            st.o0 = MFMA32(va, pb[s], st.o0); st.o1 = MFMA32(vb8, pb[s], st.o1); } } while (0)
#define ATT_BODY(j, KR, VR) do { \
        LAS unsigned char* ks = LDSRES ? vbuf + (j) * 8192 : vbuf; LAS unsigned char* vs = ks + 4096; \
        if constexpr (!LDSRES) { \
        *(LAS u32x4*)(ks + wk0) = KR[0]; *(LAS u32x4*)(ks + wk1 + 1024) = KR[1]; *(LAS u32x4*)(ks + wk0 + 2048) = KR[2]; *(LAS u32x4*)(ks + wk1 + 3072) = KR[3]; \
        _Pragma("unroll") for (int i = 0; i < 4; ++i) *(LAS u32x4*)(vs + w0 + i * 1024) = VR[i]; \
        if ((j) + (ONESET ? 1 : 2) < nblk) { ATT_LOAD((j) + (ONESET ? 1 : 2), KR, VR); } } \
        f32x16 S; ATT_QK(S, ks); ATT_MASK(S, (j)); \
        float bm = ATT_MAX16(S); \
        { auto rr_ = __builtin_amdgcn_permlane32_swap(__float_as_uint(bm), __float_as_uint(bm), false, false); bm = fmaxf(__uint_as_float(rr_[0]), __uint_as_float(rr_[1])); } \
        const float mn = fmaxf(st.m, bm), alpha = __builtin_amdgcn_exp2f(st.m - mn); st.m = mn; \
        _Pragma("unroll") for (int r = 0; r < 16; ++r) S[r] = __builtin_amdgcn_exp2f(S[r] - mn); \
        st.l = st.l * alpha + ATT_SUM16(S); \
        if (__any(alpha != 1.f)) { _Pragma("unroll") for (int r = 0; r < 16; ++r) { st.o0[r] *= alpha; st.o1[r] *= alpha; } } \
        ATT_PV(S, vs); \
    } while (0)
#define ATT_BODY2(j) do { \
        LAS unsigned char* ks0 = vbuf + (j) * 8192; LAS unsigned char* ks1 = ks0 + 8192; \
        f32x16 S0, S1; ATT_QK(S0, ks0); ATT_QK(S1, ks1); ATT_MASK(S0, (j)); ATT_MASK(S1, (j) + 1); \
        float bm = fmaxf(ATT_MAX16(S0), ATT_MAX16(S1)); \
        { auto rr_ = __builtin_amdgcn_permlane32_swap(__float_as_uint(bm), __float_as_uint(bm), false, false); bm = fmaxf(__uint_as_float(rr_[0]), __uint_as_float(rr_[1])); } \
        const float mn = fmaxf(st.m, bm), alpha = __builtin_amdgcn_exp2f(st.m - mn); st.m = mn; \
        _Pragma("unroll") for (int r = 0; r < 16; ++r) { S0[r] = __builtin_amdgcn_exp2f(S0[r] - mn); S1[r] = __builtin_amdgcn_exp2f(S1[r] - mn); } \
        st.l = st.l * alpha + (ATT_SUM16(S0) + ATT_SUM16(S1)); \
        if (__any(alpha != 1.f)) { _Pragma("unroll") for (int r = 0; r < 16; ++r) { st.o0[r] *= alpha; st.o1[r] *= alpha; } } \
        ATT_PV(S0, ks0 + 4096); ATT_PV(S1, ks1 + 4096); \
    } while (0)
    if constexpr (LDSRES) {
        for (int j = 0; j < nblk; ++j) ATT_BODY(j, kA, vA);
    } else if constexpr (ONESET) {
        ATT_LOAD(0, kA, vA);
        for (int j = 0; j < nblk; ++j) ATT_BODY(j, kA, vA);
    } else {
        ATT_LOAD(0, kA, vA); if (nblk > 1) { ATT_LOAD(1, kB, vB); }
        for (int j = 0; j < nblk; j += 2) {
            ATT_BODY(j, kA, vA);
            if (j + 1 < nblk) ATT_BODY(j + 1, kB, vB);
        }
    }
#undef ATT_BODY
#undef ATT_BODY2
#undef ATT_QK
#undef ATT_MASK
#undef ATT_MAX16
#undef ATT_SUM16
#undef ATT_PV
#undef ATT_TOK
#undef ATT_LOAD
}

constexpr int COOP_MEM = 256, COOP_DIL = 1152, COOP_NA = 384;
constexpr int ATT_Q_NA = 384;
constexpr int ATT_STG_OFF = 98304;
struct TileQ { int tb, sa, sb, headg, pat; const bf16_t* qbase; };
__device__ __forceinline__ void coop_tile(int it, int wave, const bf16_t* qkv, TileQ& t, int& decq0, int& dd) {
    if (it < COOP_MEM) { const int b = it >> 7, h = (it >> 5) & 3, grp = it & 31; t.tb = b * SEQ + 256 * grp + 32 * wave; t.sa = 16; t.sb = 1; t.headg = 12 + h; t.pat = -1; t.qbase = qkv + (size_t)(QKV_QM / 64 + h) * NTOK * 64; decq0 = 0; dd = 1; }
    else if (it >= COOP_MEM + COOP_DIL) { const int x = 8 * (it - COOP_MEM - COOP_DIL) + wave, b = x / 1536, rem = x % 1536, h = rem >> 8, rp = (rem >> 2) & 63, cgp = rem & 3;
        t.tb = b * SEQ + 2 * rp * 64 + 16 * cgp; t.sa = 64; t.sb = 1; t.headg = h; t.pat = -1; t.qbase = qkv + (size_t)(QKV_QA / 64 + h) * NTOK * 64; decq0 = x; dd = 1; }
    else { const int x = it - COOP_MEM, hb = x / 96, r = x % 96, grp = r & 31, b = hb / 6, h = hb % 6, pat = r >> 5;
        const int d = pat == 0 ? 1 : (pat == 1 ? 4 : 16), cls = pat == 0 ? 0 : (pat == 1 ? (grp >> 3) : (grp >> 1)), g0 = pat == 0 ? 256 * grp : (pat == 1 ? 256 * (grp & 7) : 256 * (grp & 1));
        decq0 = g0 + 32 * wave; dd = d; t.tb = b * SEQ + cls + d * decq0; t.sa = 16 * d; t.sb = d; t.headg = 6 + h; t.pat = pat; t.qbase = qkv + (size_t)(QKV_QB / 64 + h) * NTOK * 64; }
}
__device__ __forceinline__ void attn_epilogue(const AttnSt& st, const TileQ& t, LAS unsigned char* stg, bf16_t* O, bf16_t* PO, float* Pml, int lane_in) {
    int lane = lane_in; asm volatile("" : "+v"(lane));
    const int r32 = lane & 31, hi = lane >> 5;
    const float lt = sum_x32(st.l), inv = t.pat < 0 ? 1.f / lt : 1.f;
    LAS unsigned char* wrow = stg + r32 * 128; const int sx = r32 & 15;
#pragma unroll
    for (int g = 0; g < 4; ++g) {
        u32x2 w0v; w0v.x = pk_bf16(st.o0[4 * g] * inv, st.o0[4 * g + 1] * inv); w0v.y = pk_bf16(st.o0[4 * g + 2] * inv, st.o0[4 * g + 3] * inv); *(LAS u32x2*)(wrow + (((2 * g + hi) ^ sx) << 3)) = w0v;
        u32x2 w1v; w1v.x = pk_bf16(st.o1[4 * g] * inv, st.o1[4 * g + 1] * inv); w1v.y = pk_bf16(st.o1[4 * g + 2] * inv, st.o1[4 * g + 3] * inv); *(LAS u32x2*)(wrow + (((8 + 2 * g + hi) ^ sx) << 3)) = w1v;
    }
    if (t.pat >= 0 && hi == 0) { const int tok = t.tb + t.sa * (r32 >> 4) + t.sb * (r32 & 15); f32x2 ml; ml[0] = st.m; ml[1] = lt; *(f32x2*)(Pml + (((size_t)t.pat * NTOK + tok) * 6 + (t.headg - 6)) * 2) = ml; }
    const int c = lane & 7;
#pragma unroll
    for (int i = 0; i < 4; ++i) {
        const int row = 8 * i + (lane >> 3), sr = row & 15, p0 = (2 * c) ^ sr;
        u32x4 v = *(const LAS u32x4*)(stg + row * 128 + ((p0 & ~1) << 3));
        if (sr & 1) { const unsigned tx = v.x, ty = v.y; v.x = v.z; v.y = v.w; v.z = tx; v.w = ty; }
        const int tok = t.tb + t.sa * (row >> 4) + t.sb * (row & 15);
        bf16_t* dst = t.pat < 0 ? O + (size_t)tok * D + 64 * t.headg + 8 * c : PO + ((size_t)t.pat * NTOK + tok) * 384 + 64 * (t.headg - 6) + 8 * c;
        *(u32x4*)dst = v;
    }
}
__device__ __forceinline__ void attn_mem_items(LAS unsigned char* lds, const bf16_t* qkv, const bf16_t* memkv, bf16_t* O, unsigned* pub, const int nkvflags, int wave, int first, int stride) {
    int tid = wave * 64 + lane_id_now(); asm volatile("" : "+v"(tid));
    const int lane = tid & 63, r32 = lane & 31, hi = lane >> 5;
    LAS unsigned char* stg = lds + ATT_STG_OFF + wave * 4096;
    const int ckey = (tid >> 3) & 31, cwhich = tid >> 8, cdch = tid & 7;
    const int cdst = cwhich ? 4096 + ckey * 128 + (((cdch >> 2) ^ ((ckey >> 1) & 1)) << 6) + (cdch & 3) * 16 : ckey * 128 + ((cdch ^ ((ckey >> 1) & 7)) << 4);
    for (int it = first; it < COOP_MEM; it += stride) {
        const int b_ = it >> 7, h_ = (it >> 5) & 3, panel = b_ * (SEQ / 256) + (it & 31);
        if (wave == 0 && lane_id_now() == 0) { unsigned sp_ = 0;
            while (__hip_atomic_load(pub + panel, __ATOMIC_RELAXED, __HIP_MEMORY_SCOPE_AGENT) == 0u) { __builtin_amdgcn_s_sleep(2); if (++sp_ > (1u << 22)) break; }
            for (int f = 0; f < nkvflags; ++f) { sp_ = 0; while (__hip_atomic_load(pub + 64 + f, __ATOMIC_RELAXED, __HIP_MEMORY_SCOPE_AGENT) == 0u) { __builtin_amdgcn_s_sleep(2); if (++sp_ > (1u << 22)) break; } }
            __builtin_amdgcn_fence(__ATOMIC_ACQUIRE, "agent"); asm volatile("s_waitcnt vmcnt(0)" ::: "memory"); }
        __syncthreads();
        u32x4 pre[8]; bf16x8 qn[4]; TileQ tq; int decq0 = 0, dd = 1;
        { const bf16_t* src_ = memkv + (cwhich ? 256 : 0) + 64 * h_ + 8 * cdch;
#pragma unroll
          for (int jb = 0; jb < 8; ++jb) pre[jb] = *(const u32x4*)(src_ + (size_t)(b_ * MEMLEN + 32 * jb + ckey) * 512); }
        coop_tile(it, wave, qkv, tq, decq0, dd);
        { const bf16_t* qp_ = tq.qbase + (size_t)(tq.tb + tq.sa * (r32 >> 4) + tq.sb * (r32 & 15)) * 64 + 8 * hi;
#pragma unroll
          for (int s_ = 0; s_ < 4; ++s_) qn[s_] = *(const bf16x8*)(qp_ + 16 * s_); }
#pragma unroll
        for (int jb = 0; jb < 8; ++jb) *(LAS u32x4*)(lds + jb * 8192 + cdst) = pre[jb];
        AttnSt st;
#pragma unroll
        for (int r = 0; r < 16; ++r) { st.o0[r] = 0.f; st.o1[r] = 0.f; }
        st.m = -1e30f; st.l = 0.f;
#pragma unroll
        for (int s = 0; s < 4; ++s) st.q[s] = qn[s];
        __syncthreads();
        attn_blocks<2, true>(st, lds, nullptr, nullptr, 0, 0, 0, 0, 0, 0, 8, lane, 0, 0, 0, nullptr);
        attn_epilogue(st, tq, stg, O, nullptr, nullptr, lane);
    }
    __syncthreads();
}
__device__ __forceinline__ void attn_mfma_phase(LAS unsigned char* lds, const bf16_t* qkv, const bf16_t* memkv, const float* rpb, bf16_t* O, bf16_t* PO, float* Pml, unsigned* qctr, int wave, int vcu, int G, bool skip_mem) {
    int tid = wave * 64 + lane_id_now(); asm volatile("" : "+v"(tid));
    const int lane = tid & 63, r32 = lane & 31, hi = lane >> 5;
    { LAS float* tab = (LAS float*)(lds + ATT_TAB_OFF);
      for (int i = tid; i < 6 * 15 * 64; i += 512) { const int c = i & 63, rr = (i >> 6) % 15, h = i / (15 * 64); tab[i] = (c >= 16 && c <= 46) ? rpb[h * 465 + rr * 31 + (c - 16)] * LOG2E : 0.f; } }
    __syncthreads();
    LAS unsigned char* stg = lds + ATT_STG_OFF + wave * 4096;
    {
        const int ckey = (tid >> 3) & 31, cwhich = tid >> 8, cdch = tid & 7;
        const int cdst = cwhich ? 4096 + ckey * 128 + (((cdch >> 2) ^ ((ckey >> 1) & 1)) << 6) + (cdch & 3) * 16 : ckey * 128 + ((cdch ^ ((ckey >> 1) & 7)) << 4);
        constexpr int NIT = COOP_MEM + COOP_DIL + COOP_NA;
        u32x4 pre[12]; bf16x8 qn[4]; TileQ tq; int decq0 = 0, dd = 1;
#define COOP_LOAD(it) do { \
            if ((it) < COOP_MEM) { const int b_ = (it) >> 7, h_ = ((it) >> 5) & 3; const bf16_t* src_ = memkv + (cwhich ? 256 : 0) + 64 * h_ + 8 * cdch; \
                _Pragma("unroll") for (int jb = 0; jb < 8; ++jb) pre[jb] = *(const u32x4*)(src_ + (size_t)(b_ * MEMLEN + 32 * jb + ckey) * 512); } \
            else if ((it) < COOP_MEM + COOP_DIL) { const int x_ = (it) - COOP_MEM, hb_ = x_ / 96, r_ = x_ % 96, pat_ = r_ >> 5, grp_ = r_ & 31, b_ = hb_ / 6, h_ = hb_ % 6; \
                const int d_ = pat_ == 0 ? 1 : (pat_ == 1 ? 4 : 16), cls_ = pat_ == 0 ? 0 : (pat_ == 1 ? (grp_ >> 3) : (grp_ >> 1)), g0_ = pat_ == 0 ? 256 * grp_ : (pat_ == 1 ? 256 * (grp_ & 7) : 256 * (grp_ & 1)); \
                const bf16_t* src_ = qkv + (size_t)((cwhich ? QKV_VB : QKV_KB) / 64 + h_) * NTOK * 64 + 8 * cdch; \
                _Pragma("unroll") for (int jb = 0; jb < 12; ++jb) { const int t_ = min(max(cls_ + d_ * (g0_ - 64 + 32 * jb + ckey), 0), SEQ - 1); pre[jb] = *(const u32x4*)(src_ + (size_t)(b_ * SEQ + t_) * 64); } } \
            coop_tile((it), wave, qkv, tq, decq0, dd); \
            { const bf16_t* qp_ = tq.qbase + (size_t)(tq.tb + tq.sa * (r32 >> 4) + tq.sb * (r32 & 15)) * 64 + 8 * hi; _Pragma("unroll") for (int s_ = 0; s_ < 4; ++s_) qn[s_] = *(const bf16x8*)(qp_ + 16 * s_); } } while (0)
        int it = vcu;
        if (skip_mem) { while (it < COOP_MEM) it += G; }
        if (it < NIT) COOP_LOAD(it);
        for (; it < NIT; it += G) {
            __syncthreads();
            const int nb = it < COOP_MEM ? 8 : (it < COOP_MEM + COOP_DIL ? 12 : 0);
#pragma unroll
            for (int jb = 0; jb < 12; ++jb) if (jb < nb) *(LAS u32x4*)(lds + jb * 8192 + cdst) = pre[jb];
            AttnSt st;
#pragma unroll
            for (int r = 0; r < 16; ++r) { st.o0[r] = 0.f; st.o1[r] = 0.f; }
            st.m = -1e30f; st.l = 0.f;
#pragma unroll
            for (int s = 0; s < 4; ++s) st.q[s] = qn[s];
            const TileQ tc = tq; const int cdecq0 = decq0, cd = dd;
            const bool cur_na = it >= COOP_MEM + COOP_DIL;
            if (cur_na) {
#pragma unroll
                for (int jb = 0; jb < 12; ++jb) asm volatile("" : "=v"(pre[jb]));
#pragma unroll
                for (int s_ = 0; s_ < 4; ++s_) asm volatile("" : "=v"(qn[s_]));
            }
            if (!cur_na && it + G < NIT) COOP_LOAD(it + G);
            __syncthreads();
            if (it < COOP_MEM) attn_blocks<2, true>(st, lds, nullptr, nullptr, 0, 0, 0, 0, 0, 0, 8, lane, 0, 0, 0, nullptr);
            else if (it < COOP_MEM + COOP_DIL) attn_blocks<1, true>(st, lds + wave * 8192, nullptr, nullptr, 0, 0, 0, 0, 0, 0, 5, lane, cdecq0 - 64, SEQ / cd, cdecq0 + r32, nullptr);
            else { const int x = cdecq0, b = x / 1536, rem = x % 1536, h = rem >> 8, rp = (rem >> 2) & 63, cgp = rem & 3;
                const int r0 = 2 * rp, c0 = 16 * cgp, qrow = r0 + (r32 >> 4), qcol = c0 + (r32 & 15);
                const int kr0 = min(max(r0 - 4, 0), 120), kr1 = min(max(r0 - 3, 0), 120), nrows = kr1 + 8 - kr0;
                const int rsq = min(max(qrow - 4, 0), 120), csq = min(max(qcol - 8, 0), 48), cw0 = min(max(c0 - 8, 0), 32);
                attn_blocks<0, false, true>(st, lds + wave * 8192, qkv + (size_t)(QKV_KA / 64 + h) * NTOK * 64, qkv + (size_t)(QKV_VA / 64 + h) * NTOK * 64, 64, b * SEQ, kr0 * 64 + cw0, 64, 1, SEQ - 1, nrows, lane,
                               kr0 - rsq, cw0 - csq, (kr0 - qrow + 7) * 64 + (cw0 - qcol + 31), (const LAS float*)(lds + ATT_TAB_OFF) + h * 15 * 64); }
            attn_epilogue(st, tc, stg, O, PO, Pml, lane);
            if (cur_na && it + G < NIT) COOP_LOAD(it + G);
        }
#undef COOP_LOAD
        __syncthreads();
    }
    (void)qctr;
    __syncthreads();
}

constexpr int DEF_S1 = 1920, DEF_S2 = 5120, DEF_S3 = 2048, DM_ITEMS = NEXP * 56 * 32, DEF_S4 = DM_ITEMS - DEF_S1 - DEF_S2 - DEF_S3, DEF_TOTAL = DEF_S1 + DEF_S2 + DEF_S3 + DEF_S4;
__device__ __forceinline__ void conv_down_m(const float* w_down_m, unsigned char* wd_m, LAS unsigned char* lds, int wave, int q0, int q1, int worker, int nworkers) {
    const int lane = lane_id_now(); LAS float* scr = (LAS float*)(lds + wave * 16384);
    const int r8 = lane >> 3, c4 = (lane & 7) * 4, cc = lane & 7;
    f32x4 cv[8];
#define CDM_LOAD(q) do { const int e_ = (q) / 1792, r_ = (q) % 1792, kb_ = r_ >> 5, nb_ = r_ & 31; const float* W_ = w_down_m + (size_t)e_ * DFFE * D + (size_t)(64 * kb_) * D + 32 * nb_ + c4; \
        _Pragma("unroll") for (int i = 0; i < 8; ++i) cv[i] = __builtin_nontemporal_load((const f32x4*)(W_ + (size_t)(8 * i + r8) * D)); } while (0)
    int q = q0 + worker;
    if (q < q1) CDM_LOAD(q);
    for (; q < q1; q += nworkers) {
#pragma unroll
        for (int i = 0; i < 8; ++i) { LAS float* sp = scr + (8 * i + r8) * 33 + c4; sp[0] = cv[i][0] * W8_DN; sp[1] = cv[i][1] * W8_DN; sp[2] = cv[i][2] * W8_DN; sp[3] = cv[i][3] * W8_DN; }
        if (q + nworkers < q1) CDM_LOAD(q + nworkers);
        asm volatile("s_waitcnt lgkmcnt(0)" ::: "memory");
        const int e = q / 1792, r = q % 1792, kb = r >> 5, nb = r & 31; unsigned char* dst = wd_m + (size_t)e * D * DFFE;
#pragma unroll
        for (int j = 0; j < 4; ++j) { const int n = (lane >> 3) + 8 * j; const LAS float* sp = scr + (8 * cc) * 33 + n;
            u32x2 o; o.x = pk4_fp8(sp[0 * 33], sp[1 * 33], sp[2 * 33], sp[3 * 33]); o.y = pk4_fp8(sp[4 * 33], sp[5 * 33], sp[6 * 33], sp[7 * 33]);
            __builtin_nontemporal_store(o, (u32x2*)(dst + (size_t)(32 * nb + n) * DFFE + 64 * kb + 8 * cc)); }
        asm volatile("s_waitcnt lgkmcnt(0)" ::: "memory");
    }
#undef CDM_LOAD
}

constexpr int GU_ITEMS = NEXP * 2 * 16 * 112;
__device__ __forceinline__ void conv_gu_m(const float* w_gate_m, const float* w_up_m, const float* gain, unsigned char* wgu_m, LAS unsigned char* lds, int wave, int worker, int nworkers) {
    const int lane = lane_id_now(); LAS float* scr = (LAS float*)(lds + wave * 16384);
    const int r8 = lane >> 3, c4 = (lane & 7) * 4, cc = lane & 7;
    f32x4 cv[8]; float cg[8];
#define CGU_LOAD(q) do { const int e_ = (q) / 3584, q2_ = (q) % 3584, up_ = q2_ / 1792, r_ = q2_ % 1792, kb_ = r_ / 112, nb_ = r_ % 112; \
        const float* W_ = (up_ ? w_up_m : w_gate_m) + (size_t)e_ * D * DFFE + (size_t)(64 * kb_) * DFFE + 32 * nb_ + c4; \
        _Pragma("unroll") for (int i = 0; i < 8; ++i) { cv[i] = __builtin_nontemporal_load((const f32x4*)(W_ + (size_t)(8 * i + r8) * DFFE)); cg[i] = gain[64 * kb_ + 8 * i + r8] * W8_UP; } } while (0)
    int q = worker;
    if (q < GU_ITEMS) CGU_LOAD(q);
    for (; q < GU_ITEMS; q += nworkers) {
#pragma unroll
        for (int i = 0; i < 8; ++i) { LAS float* sp = scr + (8 * i + r8) * 33 + c4; sp[0] = cv[i][0] * cg[i]; sp[1] = cv[i][1] * cg[i]; sp[2] = cv[i][2] * cg[i]; sp[3] = cv[i][3] * cg[i]; }
        if (q + nworkers < GU_ITEMS) CGU_LOAD(q + nworkers);
        asm volatile("s_waitcnt lgkmcnt(0)" ::: "memory");
        const int e = q / 3584, q2 = q % 3584, up = q2 / 1792, r = q2 % 1792, kb = r / 112, nb = r % 112; unsigned char* dst = wgu_m + (size_t)e * 2 * DFFE * D; const int drow = up ? map_up(32 * nb) : map_gate(32 * nb);
#pragma unroll
        for (int j = 0; j < 4; ++j) { const int n = (lane >> 3) + 8 * j; const LAS float* sp = scr + (8 * cc) * 33 + n;
            u32x2 o; o.x = pk4_fp8(sp[0 * 33], sp[1 * 33], sp[2 * 33], sp[3 * 33]); o.y = pk4_fp8(sp[4 * 33], sp[5 * 33], sp[6 * 33], sp[7 * 33]);
            __builtin_nontemporal_store(o, (u32x2*)(dst + (size_t)(drow + n) * D + 64 * kb + 8 * cc)); }
        asm volatile("s_waitcnt lgkmcnt(0)" ::: "memory");
    }
#undef CGU_LOAD
    __syncthreads();
}

constexpr int NPHASE = 16;
__global__ void __launch_bounds__(512, 2) mk_fwd(Args a) {
    extern __shared__ __attribute__((aligned(16))) unsigned char lds_raw[];
    LAS unsigned char* lds = (LAS unsigned char*)lds_raw;
    const int tid0 = threadIdx.x, wave = __builtin_amdgcn_readfirstlane(tid0 >> 6);
    const int G = gridDim.x, bx = blockIdx.x;
#define PHASE_LOCALS int tid = wave * 64 + lane_id_now(); asm volatile("" : "+v"(tid)); const int lane = tid & 63; (void)lane;
    const int vcu = (G % 8 == 0) ? (bx % 8) * (G / 8) + bx / 8 : bx;
    const int gw = vcu * 8 + wave, NGW = G * 8;
    unsigned char* const ws0 = a.ws;
#define WS_LOCAL int wsz_ = 0; asm volatile("" : "+s"(wsz_)); unsigned char* ws = ws0 + wsz_;
#define SSQV(i) ((float*)(ws + WS_SSQ + (size_t)(i) * SSQ_BYTES))
#define P_SSQMEM ((float*)(ws + WS_SSQMEM))
#define P_ROPE ((float*)(ws + WS_ROPE))
#define P_MEMBF ((bf16_t*)(ws + WS_MEMBF))
#define P_MEMKV ((bf16_t*)(ws + WS_MEMKV))
#define P_EIDX ((int*)(ws + WS_EIDX))
#define P_GATE ((float*)(ws + WS_GATE))
#define P_POS ((int*)(ws + WS_POS))
#define P_ROWTOK ((int*)(ws + WS_ROWTOK))
#define P_ROWGATE ((float*)(ws + WS_ROWGATE))
#define P_CNT ((int*)(ws + WS_CNT))
#define P_RSTD3 ((float*)(ws + WS_RSTD3))
#define P_ROWRSTD ((float*)(ws + WS_ROWRSTD))
#define Wgu_m (ws + WS_WGU_M)
#define Wd_m (ws + WS_WD_M)
#define Hb ((bf16_t*)(ws + WS_HB))
#define Hb8 (ws + WS_HB8)
#define Win ((bf16_t*)(ws + WS_WIN))
#define Wmem ((bf16_t*)(ws + WS_WMEM))
#define Wout ((bf16_t*)(ws + WS_WOUT))
#define Wgu_d ((bf16_t*)(ws + WS_WGU_D))
#define Wd_d ((bf16_t*)(ws + WS_WD_D))
#define QKV ((bf16_t*)(ws + WS_QKV))
#define Ob ((bf16_t*)(ws + WS_O))
#define Hd ((bf16_t*)(ws + WS_HD))
#define Hm (ws + WS_HM)
#define Yb ((bf16_t*)(ws + WS_Y))

#if MK_N_LAUNCHES == 1
    volatile LAS unsigned* MISC = (volatile LAS unsigned*)(lds + MISC_OFF);
    if (tid0 < 32) MISC[tid0] = 0u;
    __syncthreads();
    const XcdBarrier bar = xcd_barrier_post((unsigned*)(ws0 + WS_CTL) + CW_BAR, MISC + 8, wave);
#define GRID_BAR() xcd_barrier(bar)
#else
#define GRID_BAR() do { } while (0)
#endif
    const int lo = a.ph_lo, hi = a.ph_hi;
#ifndef PHMASK
#define PHMASK 0xffffffu
#endif
#ifndef PROBE_DUP
#define PROBE_DUP 0
#endif
#define DUPN(k) (1 + ((PROBE_DUP >> (k)) & 1))
#define IN(k) (((PHMASK >> ((k) > 6 && (k) < 11 ? (k) - 6 : (k))) & 1u) && lo <= (k) && (k) < hi)
#define SEAM(k) do { if (IN(k) && IN((k) + 1)) GRID_BAR(); } while (0)

    if (IN(0)) for (int rep = 0; rep < DUPN(0); ++rep) {
        WS_LOCAL
        PHASE_LOCALS
        LAS float* scr = (LAS float*)(lds + wave * 16384);
        constexpr int I_IN = 16 * 80, I_MEM = 16 * 16, I_OUT = 16 * 32, I_GD = 16 * 88, I_DD = 44 * 32, I_GM = 16 * 112, I_DM = 56 * 32;
        constexpr int T0 = 2 * I_IN, T1 = T0 + 2 * I_MEM, T2 = T1 + 2 * I_OUT, T3 = T2 + 2 * I_GD, T4 = T3 + I_DD, T5 = T4 + 2 * NEXP * I_GM, T6 = T5 + NEXP * I_DM;
        struct ConvP { const float* W; const float* gain; unsigned char* dst; int K, N, k0, n0, drow; float scale; bool f8; };
#define CONV_DECODE(it, P) do { \
            if ((it) < T0) { const int l = (it) / I_IN, r = (it) % I_IN, kb = r / 80, nb = r % 80; \
                P.W = a.w_in + (size_t)l * D * IN_W; P.K = D; P.N = IN_W; P.gain = a.g_attn + l * D; P.scale = 1.f; P.dst = (unsigned char*)(Win + (size_t)l * IN_W * D); P.k0 = 64 * kb; P.n0 = 32 * nb; P.drow = map_head(32 * nb); P.f8 = false; } \
            else if ((it) < T1) { const int q = (it) - T0, l = q / I_MEM, r = q % I_MEM, kb = r / 16, nb = r % 16; \
                P.W = a.w_mem_kv + (size_t)l * D * 512; P.K = D; P.N = 512; P.gain = a.g_mem + l * D; P.scale = 1.f; P.dst = (unsigned char*)(Wmem + (size_t)l * 512 * D); P.k0 = 64 * kb; P.n0 = 32 * nb; P.drow = map_head(32 * nb); P.f8 = false; } \
            else if ((it) < T2) { const int q = (it) - T1, l = q / I_OUT, r = q % I_OUT, kb = r / 32, nb = r % 32; \
                P.W = a.w_out + (size_t)l * D * D; P.K = D; P.N = D; P.gain = a.g_out + l * D; P.scale = 1.f; P.dst = (unsigned char*)(Wout + (size_t)l * D * D); P.k0 = 64 * kb; P.n0 = 32 * nb; P.drow = 32 * nb; P.f8 = false; } \
            else if ((it) < T3) { const int q = (it) - T2, up = q / I_GD, r = q % I_GD, kb = r / 88, nb = r % 88; \
                P.W = up ? a.w_up_d : a.w_gate_d; P.K = D; P.N = DFF; P.gain = a.g_ffn; P.scale = DENSE_FP8_UP ? W8_UP : 1.f; P.dst = (unsigned char*)Wgu_d; P.k0 = 64 * kb; P.n0 = 32 * nb; P.drow = up ? map_up(32 * nb) : map_gate(32 * nb); P.f8 = DENSE_FP8_UP != 0; } \
            else if ((it) < T4) { const int r = (it) - T3, kb = r / 32, nb = r % 32; \
                P.W = a.w_down_d; P.K = DFF; P.N = D; P.gain = nullptr; P.scale = DENSE_FP8_DN ? W8_DN : 1.f; P.dst = (unsigned char*)Wd_d; P.k0 = 64 * kb; P.n0 = 32 * nb; P.drow = 32 * nb; P.f8 = DENSE_FP8_DN != 0; } \
            else if ((it) < T5) { const int q = (it) - T4, e = q / (2 * I_GM), q2 = q % (2 * I_GM), up = q2 / I_GM, r = q2 % I_GM, kb = r / 112, nb = r % 112; \
                P.W = (up ? a.w_up_m : a.w_gate_m) + (size_t)e * D * DFFE; P.K = D; P.N = DFFE; P.gain = a.g_ffn + D; P.scale = W8_UP; P.dst = Wgu_m + (size_t)e * 2 * DFFE * D; P.k0 = 64 * kb; P.n0 = 32 * nb; P.drow = up ? map_up(32 * nb) : map_gate(32 * nb); P.f8 = true; } \
            else { const int q = (it) - T5, e = q / I_DM, r = q % I_DM, kb = r / 32, nb = r % 32; \
                P.W = a.w_down_m + (size_t)e * DFFE * D; P.K = DFFE; P.N = D; P.gain = nullptr; P.scale = W8_DN; P.dst = Wd_m + (size_t)e * D * DFFE; P.k0 = 64 * kb; P.n0 = 32 * nb; P.drow = 32 * nb; P.f8 = true; } } while (0)
        const int r8 = lane >> 3, c4 = (lane & 7) * 4, cc = lane & 7;
        f32x4 cv[8]; float cg[8];
#define CONV_LOAD(P) do { _Pragma("unroll") for (int i = 0; i < 8; ++i) { const int kk = 8 * i + r8; cv[i] = __builtin_nontemporal_load((const f32x4*)(P.W + (size_t)(P.k0 + kk) * P.N + P.n0 + c4)); cg[i] = (P.gain ? P.gain[P.k0 + kk] : 1.f) * P.scale; } } while (0)
        const int TE = G == 256 ? (SKEW_CONV ? T4 : T6 - DEF_TOTAL) : T6;
        ConvP pc, pn; int it = gw;
        if (it < TE) { CONV_DECODE(it, pc); CONV_LOAD(pc); }
        for (; it < TE; it += NGW) {
#pragma unroll
            for (int i = 0; i < 8; ++i) { LAS float* sp = scr + (8 * i + r8) * 33 + c4; sp[0] = cv[i][0] * cg[i]; sp[1] = cv[i][1] * cg[i]; sp[2] = cv[i][2] * cg[i]; sp[3] = cv[i][3] * cg[i]; }
            const bool more = it + NGW < TE;
            if (more) { CONV_DECODE(it + NGW, pn); CONV_LOAD(pn); }
            asm volatile("s_waitcnt lgkmcnt(0)" ::: "memory");
#pragma unroll
            for (int j = 0; j < 4; ++j) { const int n = (lane >> 3) + 8 * j; const LAS float* sp = scr + (8 * cc) * 33 + n;
                const float v0 = sp[0 * 33], v1 = sp[1 * 33], v2 = sp[2 * 33], v3 = sp[3 * 33], v4 = sp[4 * 33], v5 = sp[5 * 33], v6 = sp[6 * 33], v7 = sp[7 * 33];
                if (pc.f8) { u32x2 o; o.x = pk4_fp8(v0, v1, v2, v3); o.y = pk4_fp8(v4, v5, v6, v7); __builtin_nontemporal_store(o, (u32x2*)(pc.dst + (size_t)(pc.drow + n) * pc.K + pc.k0 + 8 * cc)); }
                else { u32x4 o; o.x = pk_bf16(v0, v1); o.y = pk_bf16(v2, v3); o.z = pk_bf16(v4, v5); o.w = pk_bf16(v6, v7); *(u32x4*)((bf16_t*)pc.dst + (size_t)(pc.drow + n) * pc.K + pc.k0 + 8 * cc) = o; } }
            asm volatile("s_waitcnt lgkmcnt(0)" ::: "memory");
            if (more) pc = pn;
        }
#undef CONV_DECODE
#undef CONV_LOAD
        for (int m = gw; m < NTOK + NMEM; m += NGW) {
            const bool isx = m < NTOK; const float* src = isx ? a.x + (size_t)m * D : a.mem + (size_t)(m - NTOK) * D;
            bf16_t* dst = isx ? Hb + (size_t)m * D : P_MEMBF + (size_t)(m - NTOK) * D; float* sq = isx ? SSQV(0) + (size_t)m * 4 : P_SSQMEM + (size_t)(m - NTOK) * 4;
            const f32x4* xr = (const f32x4*)src + lane; float s = 0.f; f32x4 v[4];
#pragma unroll
            for (int j = 0; j < 4; ++j) { v[j] = __builtin_nontemporal_load(xr + 64 * j); s += (v[j][0] * v[j][0] + v[j][1] * v[j][1]) + (v[j][2] * v[j][2] + v[j][3] * v[j][3]); }
            s = wave_sum(s);
#pragma unroll
            for (int j = 0; j < 4; ++j) { u32x2 w; w.x = pk_bf16(v[j][0], v[j][1]); w.y = pk_bf16(v[j][2], v[j][3]); ((u32x2*)dst)[lane + 64 * j] = w; }
            if (lane < 4) sq[lane] = lane == 0 ? s : 0.f;
        }
        if (gw == 0) { for (int j = lane; j < D / 2; j += 64) ((unsigned*)(Hb + (size_t)NTOK * D))[j] = 0u; for (int j = lane; j < D / 4; j += 64) ((unsigned*)(Hb8 + (size_t)NTOK * D))[j] = 0u;
            if (lane < 4) for (int v = 0; v < 4; ++v) SSQV(v)[(size_t)NTOK * 4 + lane] = lane == 0 ? (float)D : 0.f; }
        for (int i = bx * 512 + tid; i < SEQ * 32; i += G * 512) { const int t = i >> 5, f = i & 31;
            const float inv = powf(10000.0f, -(2.0f / 64.0f) * (float)f); const float ang = (float)t * inv;
            P_ROPE[(size_t)t * 64 + f] = (float)cos((double)ang); P_ROPE[(size_t)t * 64 + 32 + f] = (float)sin((double)ang); }
    }
    SEAM(0);

#pragma unroll
    for (int layer = 0; layer < 2; ++layer) {
        const int pb = 1 + 6 * layer;
#define ssq_in SSQV(layer == 0 ? 0 : 2)
#define ssq_mid SSQV(layer == 0 ? 1 : 3)
        if (IN(pb)) for (int rep = 0; rep < DUPN(1); ++rep) {
            WS_LOCAL
            SchedReg S; S.A = (const char*)Hb; S.B = (const char*)(Win + (size_t)layer * IN_W * D); S.nM = NTOK / 256; S.nN = IN_W / 256; S.K = D; S.G = G; S.c = bx;
            S.nExtra = layer == 0 ? 8 : 0; S.memA = (const char*)P_MEMBF; S.memB = (const char*)Wmem;
            const int units_ = (NTOK / 256) * (IN_W / 256) + S.nExtra, busy_last = units_ - ((units_ - 1) / G) * G, nidle = G - busy_last; const bool mem_early = nidle >= 32;
            S.memfirst = mem_early; S.pub = (unsigned*)(ws + WS_CTL) + 8192 + 128 * layer;
            const int wt_pn_ = mem_early ? IN_W / 256 - 1 : -1;
            EpiQKV E; E.qkv = QKV; E.ssq = ssq_in; E.g_na = a.g_qk_na + layer * 128; E.g_dil = a.g_qk_dil + layer * 128; E.g_mem = a.g_qk_mem + layer * 128;
            E.rope = P_ROPE; E.memkv = P_MEMKV; E.ssqmem = P_SSQMEM; E.g_mem_all = a.g_qk_mem; E.lds = lds; E.wt_pn = wt_pn_; E.mem_delta = (long)((const char*)P_SSQMEM - (const char*)ssq_in);
            const bool skew_ = SKEW_CONV && G == 256 && layer == 0;
            if (skew_ && (bx & 4)) conv_gu_m(a.w_gate_m, a.w_up_m, a.g_ffn + D, Wgu_m, lds, wave, bx * 8 + wave, G * 8);
            pg8::gemm_phase<EpiQKV, SchedReg, false, true, false, false, true>(lds, D, S, E, wave);
            if (skew_ && !(bx & 4)) conv_gu_m(a.w_gate_m, a.w_up_m, a.g_ffn + D, Wgu_m, lds, wave, bx * 8 + wave, G * 8);
            if (mem_early && bx >= busy_last) attn_mem_items(lds, QKV, P_MEMKV + (size_t)layer * NMEM * 512, Ob, S.pub, layer == 0 ? 4 : 0, wave, bx - busy_last, nidle);
            if (G == 256 && bx >= busy_last) { const int qa = DM_ITEMS - DEF_TOTAL + (layer == 0 ? 0 : DEF_S1 + DEF_S2);
                conv_down_m(a.w_down_m, Wd_m, lds, wave, qa, qa + (layer == 0 ? DEF_S1 : DEF_S3), (bx - busy_last) * 8 + wave, nidle * 8); }
        }
        SEAM(pb);
#ifdef ATTN_SCALAR
        if (IN(pb + 1)) attn_scalar_phase(QKV, P_MEMKV + (size_t)layer * NMEM * 512, a.rpb_na + layer * 6 * 465, Ob, ssqh, G);
#else
        if (IN(pb + 1)) for (int rep = 0; rep < DUPN(2); ++rep) { WS_LOCAL attn_mfma_phase(lds, QKV, P_MEMKV + (size_t)layer * NMEM * 512, a.rpb_na + layer * 6 * 465, Ob, (bf16_t*)(ws + WS_HD), (float*)(ws + WS_HD + (size_t)3 * NTOK * 384 * 2), (unsigned*)(ws + WS_CTL) + 128 * layer + 256 * rep, wave, vcu, G, (G - (((NTOK / 256) * (IN_W / 256) + (layer == 0 ? 8 : 0)) - ((((NTOK / 256) * (IN_W / 256) + (layer == 0 ? 8 : 0)) - 1) / G) * G)) >= 32); }
#endif
        SEAM(pb + 1);
        if (IN(pb + 2)) for (int rep = 0; rep < DUPN(3); ++rep) {
            WS_LOCAL
            PHASE_LOCALS
            const bf16_t* PO = (const bf16_t*)(ws + WS_HD); const float* Pml = (const float*)(ws + WS_HD + (size_t)3 * NTOK * 384 * 2);
            const bool isdil = lane >= 24 && lane < 48; const int dcol = 16 * (lane - 24), hh = (lane - 24) >> 2;
            u32x4 rA[3][2], rB[3][2]; f32x2 mA[3], mB[3];
#define MRG_LOAD(mm, R, ML) do { \
                if (isdil) { _Pragma("unroll") for (int g = 0; g < 3; ++g) { ML[g] = *(const f32x2*)(Pml + (((size_t)g * NTOK + (mm)) * 6 + hh) * 2); const u32x4* pp = (const u32x4*)(PO + ((size_t)g * NTOK + (mm)) * 384 + dcol); R[g][0] = pp[0]; R[g][1] = pp[1]; } } \
                else { const u32x4* pp = (const u32x4*)(Ob + (size_t)(mm) * D + 16 * lane); R[0][0] = pp[0]; R[0][1] = pp[1]; } } while (0)
#pragma unroll
            for (int g = 0; g < 3; ++g) { mA[g] = (f32x2){0.f, 0.f}; mB[g] = (f32x2){0.f, 0.f};
#pragma unroll
                for (int j = 0; j < 2; ++j) { rA[g][j] = (u32x4){0u, 0u, 0u, 0u}; rB[g][j] = (u32x4){0u, 0u, 0u, 0u}; } }
            int m = gw;
            if (m < NTOK) MRG_LOAD(m, rA, mA);
            for (; m < NTOK; m += NGW) {
                const int mnx = m + NGW;
                if (mnx < NTOK) MRG_LOAD(mnx, rB, mB);
                float v[16];
                if (isdil) {
                    const float M = fmaxf(fmaxf(mA[0][0], mA[1][0]), mA[2][0]);
                    const float w0 = __builtin_amdgcn_exp2f(mA[0][0] - M), w1 = __builtin_amdgcn_exp2f(mA[1][0] - M), w2 = __builtin_amdgcn_exp2f(mA[2][0] - M);
                    const float il = 1.f / (w0 * mA[0][1] + w1 * mA[1][1] + w2 * mA[2][1]);
                    const float c0 = w0 * il, c1 = w1 * il, c2 = w2 * il;
#pragma unroll
                    for (int j = 0; j < 2; ++j) {
                        const unsigned a0[4] = {rA[0][j].x, rA[0][j].y, rA[0][j].z, rA[0][j].w}, a1[4] = {rA[1][j].x, rA[1][j].y, rA[1][j].z, rA[1][j].w}, a2[4] = {rA[2][j].x, rA[2][j].y, rA[2][j].z, rA[2][j].w};
#pragma unroll
                        for (int e = 0; e < 4; ++e) { v[8 * j + 2 * e] = c0 * bf_lo(a0[e]) + c1 * bf_lo(a1[e]) + c2 * bf_lo(a2[e]); v[8 * j + 2 * e + 1] = c0 * bf_hi(a0[e]) + c1 * bf_hi(a1[e]) + c2 * bf_hi(a2[e]); }
                    }
                } else {
#pragma unroll
                    for (int j = 0; j < 2; ++j) { const u32x4 w = rA[0][j]; v[8 * j + 0] = bf_lo(w.x); v[8 * j + 1] = bf_hi(w.x); v[8 * j + 2] = bf_lo(w.y); v[8 * j + 3] = bf_hi(w.y); v[8 * j + 4] = bf_lo(w.z); v[8 * j + 5] = bf_hi(w.z); v[8 * j + 6] = bf_lo(w.w); v[8 * j + 7] = bf_hi(w.w); }
                }
                float ss = 0.f;
#pragma unroll
                for (int e = 0; e < 16; ++e) ss += v[e] * v[e];
                float s0 = lane < 24 ? ss : 0.f, s1 = isdil ? ss : 0.f, s2 = lane >= 48 ? ss : 0.f;
                s0 = wave_sum(s0); s1 = wave_sum(s1); s2 = wave_sum(s2);
                const float r0 = rsqrtf(s0 * (1.f / 384.f) + RMS_EPS), r1 = rsqrtf(s1 * (1.f / 384.f) + RMS_EPS), r2 = rsqrtf(s2 * (1.f / 256.f) + RMS_EPS);
                const float r = lane < 24 ? r0 : (lane < 48 ? r1 : r2);
                u32x4* po = (u32x4*)(Ob + (size_t)m * D + 16 * lane);
#pragma unroll
                for (int j = 0; j < 2; ++j) { u32x4 w; w.x = pk_bf16(v[8 * j] * r, v[8 * j + 1] * r); w.y = pk_bf16(v[8 * j + 2] * r, v[8 * j + 3] * r); w.z = pk_bf16(v[8 * j + 4] * r, v[8 * j + 5] * r); w.w = pk_bf16(v[8 * j + 6] * r, v[8 * j + 7] * r); po[j] = w; }
#pragma unroll
                for (int g = 0; g < 3; ++g) { mA[g] = mB[g]; rA[g][0] = rB[g][0]; rA[g][1] = rB[g][1]; }
            }
#undef MRG_LOAD
        }
        SEAM(pb + 2);
        if (IN(pb + 3)) for (int rep = 0; rep < (layer == 0 ? DUPN(4) : 1); ++rep) {
            WS_LOCAL
            SchedReg S; S.memfirst = false; S.pub = nullptr; S.A = (const char*)Ob; S.B = (const char*)(Wout + (size_t)layer * D * D); S.nM = NTOK / 256; S.nN = D / 256; S.K = D; S.G = G; S.c = bx; S.nExtra = 0; S.memA = nullptr; S.memB = nullptr;
            EpiResid E; E.hb = Hb; E.ssq_out = ssq_mid; E.lds = lds; E.hb8 = (layer == 1 || DENSE_FP8_UP) ? Hb8 : nullptr; E.asc = 1.f;
            pg8::gemm_phase<EpiResid, SchedReg, false, true>(lds, D, S, E, wave);
        }
        SEAM(pb + 3);
        if (layer == 0) {
            if (IN(5)) for (int rep = 0; rep < DUPN(5); ++rep) {
                WS_LOCAL
#if DENSE_FP8_UP
                SchedReg S; S.memfirst = false; S.pub = nullptr; S.A = (const char*)Hb8; S.B = (const char*)Wgu_d; S.nM = NTOK / 256; S.nN = 2 * DFF / 256; S.K = D / 2; S.G = G; S.c = bx; S.nExtra = 0; S.memA = nullptr; S.memB = nullptr;
                EpiSwiGLU<false> E; E.H = Hd; E.ldh = DFF; E.ssq = ssq_mid; E.rowrstd = nullptr; E.H8 = DENSE_FP8_DN ? (unsigned char*)Hd : nullptr; E.ascale = 1.f / W8_UP; E.oscale = H8_SC;
                pg8::gemm_phase<EpiSwiGLU<false>, SchedReg, false, true, true>(lds, D / 2, S, E, wave);
                if (G == 256 && bx >= 128) conv_down_m(a.w_down_m, Wd_m, lds, wave, DM_ITEMS - DEF_TOTAL + DEF_S1, DM_ITEMS - DEF_TOTAL + DEF_S1 + DEF_S2, (bx - 128) * 8 + wave, 128 * 8);
#else
                SchedReg S; S.memfirst = false; S.pub = nullptr; S.A = (const char*)Hb; S.B = (const char*)Wgu_d; S.nM = NTOK / 256; S.nN = 2 * DFF / 256; S.K = D; S.G = G; S.c = bx; S.nExtra = 0; S.memA = nullptr; S.memB = nullptr;
                EpiSwiGLU<false> E; E.H = Hd; E.ldh = DFF; E.ssq = ssq_mid; E.rowrstd = nullptr; E.H8 = DENSE_FP8_DN ? (unsigned char*)Hd : nullptr; E.ascale = 1.f; E.oscale = H8_SC;
                pg8::gemm_phase<EpiSwiGLU<false>, SchedReg, false, true>(lds, D, S, E, wave);
                if (G == 256 && bx >= 128) conv_down_m(a.w_down_m, Wd_m, lds, wave, DM_ITEMS - DEF_TOTAL + DEF_S1, DM_ITEMS - DEF_TOTAL + DEF_S1 + DEF_S2, (bx - 128) * 8 + wave, 128 * 8);
#endif
            }
            SEAM(5);
            if (IN(6)) {
                WS_LOCAL
                SchedReg S; S.memfirst = false; S.pub = nullptr; S.A = (const char*)Hd; S.B = (const char*)Wd_d; S.nM = NTOK / 256; S.nN = D / 256; S.K = DENSE_FP8_DN ? DFF / 2 : DFF; S.G = G; S.c = bx; S.nExtra = 0; S.memA = nullptr; S.memB = nullptr;
                EpiResid E; E.hb = Hb; E.ssq_out = SSQV(2); E.lds = lds; E.hb8 = nullptr; E.asc = DENSE_FP8_DN ? 1.f / (W8_DN * H8_SC) : 1.f;
                pg8::gemm_phase<EpiResid, SchedReg, false, true, DENSE_FP8_DN != 0>(lds, DENSE_FP8_DN ? DFF / 2 : DFF, S, E, wave);
            }
            SEAM(6);
        }
    }
    if (IN(11)) for (int rep = 0; rep < DUPN(11); ++rep) {
        WS_LOCAL
        PHASE_LOCALS
        constexpr int RSTR = 2048 + 16;
        LAS unsigned char* wt = lds;
        for (int k = tid; k < D; k += 512) { const float g = a.g_ffn[D + k]; const f32x4 w0 = *(const f32x4*)(a.w_router + (size_t)k * 8), w1 = *(const f32x4*)(a.w_router + (size_t)k * 8 + 4);
            const float wv[8] = {w0[0] * g, w0[1] * g, w0[2] * g, w0[3] * g, w1[0] * g, w1[1] * g, w1[2] * g, w1[3] * g};
#pragma unroll
            for (int e = 0; e < 8; ++e) { const unsigned hb_ = pk_bf16(wv[e], 0.f) & 0xffffu; const float hf = __uint_as_float(hb_ << 16); const unsigned lb_ = pk_bf16(wv[e] - hf, 0.f) & 0xffffu;
                *(LAS unsigned short*)(wt + e * RSTR + k * 2) = (unsigned short)hb_; *(LAS unsigned short*)(wt + (8 + e) * RSTR + k * 2) = (unsigned short)lb_; } }
        __syncthreads();
        const int r32 = lane & 31, hi = lane >> 5, kq = wave & 3, tl = wave >> 2;
        LAS float* red = (LAS float*)(lds + 40960);
        const float* ssq3 = SSQV(3);
        for (int T = bx * 2 + tl; T < NTOK / 32; T += 2 * G) {
            const int tok0 = 32 * T;
            bf16x8 hbv[16]; { const bf16_t* hp = Hb + (size_t)(tok0 + r32) * D + 256 * kq + 8 * hi;
#pragma unroll
              for (int sI = 0; sI < 16; ++sI) hbv[sI] = *(const bf16x8*)(hp + 16 * sI); }
            f32x16 acc;
#pragma unroll
            for (int r = 0; r < 16; ++r) acc[r] = 0.f;
            const LAS unsigned char* wrow = wt + (r32 & 7) * RSTR + (256 * kq + 8 * hi) * 2;
#pragma unroll
            for (int sI = 0; sI < 16; ++sI) { bf16x8 ah = *(const LAS bf16x8*)(wrow + 32 * sI), al = *(const LAS bf16x8*)(wrow + 8 * RSTR + 32 * sI);
                if (r32 >= 8) { ah = (bf16x8){0, 0, 0, 0, 0, 0, 0, 0}; al = ah; }
                acc = MFMA32(ah, hbv[sI], acc); acc = MFMA32(al, hbv[sI], acc); }
            { f32x4 pv; pv[0] = acc[0]; pv[1] = acc[1]; pv[2] = acc[2]; pv[3] = acc[3]; *(LAS f32x4*)(red + ((tl * 4 + kq) * 32 + r32) * 8 + 4 * hi) = pv; }
            __syncthreads();
            if (kq == 0 && hi == 0) { const int mtok = tok0 + r32; float lg[8];
#pragma unroll
                for (int e = 0; e < 8; ++e) lg[e] = 0.f;
#pragma unroll
                for (int q = 0; q < 4; ++q) { const f32x4 p0 = *(const LAS f32x4*)(red + ((tl * 4 + q) * 32 + r32) * 8), p1 = *(const LAS f32x4*)(red + ((tl * 4 + q) * 32 + r32) * 8 + 4);
                    lg[0] += p0[0]; lg[1] += p0[1]; lg[2] += p0[2]; lg[3] += p0[3]; lg[4] += p1[0]; lg[5] += p1[1]; lg[6] += p1[2]; lg[7] += p1[3]; }
                const f32x4 sq = *(const f32x4*)(ssq3 + (size_t)mtok * 4); const float rs = rsqrtf(((sq[0] + sq[1]) + (sq[2] + sq[3])) * (1.f / D) + RMS_EPS);
#pragma unroll
                for (int e = 0; e < 8; ++e) lg[e] *= rs;
                int e1 = 0; float l1 = lg[0];
#pragma unroll
                for (int e = 1; e < 8; ++e) if (lg[e] > l1) { l1 = lg[e]; e1 = e; }
                int e2 = -1; float l2 = -3.0e38f;
#pragma unroll
                for (int e = 0; e < 8; ++e) if (e != e1 && lg[e] > l2) { l2 = lg[e]; e2 = e; }
                const float p2 = expf(l2 - l1), g1 = 1.f / (1.f + p2), g2 = p2 * g1;
                P_EIDX[mtok] = e1 | (e2 << 8); f32x2 gg; gg[0] = g1; gg[1] = g2; *(f32x2*)(P_GATE + 2 * mtok) = gg; P_RSTD3[mtok] = rs; }
            __syncthreads();
        }
    }
    SEAM(11);
    if (IN(12)) for (int rep = 0; rep < DUPN(12); ++rep) {
        WS_LOCAL
        PHASE_LOCALS
        LAS int* sh = (LAS int*)lds;
        int c8[8];
#pragma unroll
        for (int e = 0; e < 8; ++e) c8[e] = 0;
        const int t0 = tid * 32;
        { pg8::v4i_t ev4[8];
#pragma unroll
          for (int q = 0; q < 8; ++q) ev4[q] = *(const pg8::v4i_t*)(P_EIDX + t0 + 4 * q);
#pragma unroll
          for (int q = 0; q < 8; ++q)
#pragma unroll
            for (int z = 0; z < 4; ++z) { const int ev = ev4[q][z]; const int e1 = ev & 255, e2 = ev >> 8;
#pragma unroll
                for (int e = 0; e < 8; ++e) c8[e] += (e1 == e) + (e2 == e); } }
        LAS int* cnts = (LAS int*)lds;
        LAS int* wtot = cnts + 8 * 512;
#pragma unroll
        for (int e = 0; e < 8; ++e) cnts[e * 512 + tid] = c8[e];
        __syncthreads();
        {
            LAS int* row = cnts + wave * 512; LAS int* part = wtot + wave * 64;
            int v8[8]; int sl = 0;
#pragma unroll
            for (int k = 0; k < 8; ++k) { v8[k] = row[8 * lane + k]; sl += v8[k]; }
            part[lane] = sl;
            asm volatile("s_waitcnt lgkmcnt(0)" ::: "memory");
            int before = 0, all = 0;
            for (int k = 0; k < 64; ++k) { const int v = part[k]; all += v; before += (k < lane) ? v : 0; }
#pragma unroll
            for (int k = 0; k < 8; ++k) { row[8 * lane + k] = before; before += v8[k]; }
            if (lane == 0) wtot[512 + wave] = all;
        }
        __syncthreads();
        int pre[8], tot[8], pstart[8];
#pragma unroll
        for (int e = 0; e < 8; ++e) { pre[e] = cnts[e * 512 + tid]; tot[e] = wtot[512 + e]; }
        { int s = 0;
#pragma unroll
          for (int e = 0; e < 8; ++e) { pstart[e] = s; s += ((tot[e] + 255) >> 8) << 8; } }
        for (int rbase = bx + wave * 2 * G; rbase < 512; rbase += 16 * G) {
            const int rt = rbase + (lane >> 5) * G; const bool on = rt < 512; const int t = (on ? rt : 0) * 32 + (lane & 31);
            const int ev = on ? P_EIDX[t] : 0xffff; const int e1 = ev & 255, e2 = ev >> 8;
            const float rt3 = P_RSTD3[t], ga = P_GATE[2 * t], gb = P_GATE[2 * t + 1];
            const unsigned long long below = (lane & 31) == 0 ? 0ull : ((1ull << (lane & 31)) - 1ull) << (lane & 32);
            int d1 = 0, d2 = 0;
#pragma unroll
            for (int e = 0; e < 8; ++e) { const unsigned long long mk = __ballot(e1 == e || e2 == e); const int rank = __popcll(mk & below);
                const int base_e = pstart[e] + cnts[e * 512 + (on ? rt : 0)] + rank; if (e1 == e) d1 = base_e; if (e2 == e) d2 = base_e; }
            if (on) { P_ROWTOK[d1] = t; P_ROWGATE[d1] = ga; P_ROWRSTD[d1] = rt3; P_ROWTOK[d2] = t; P_ROWGATE[d2] = gb; P_ROWRSTD[d2] = rt3;
                u32x2 pp; pp.x = (unsigned)d1; pp.y = (unsigned)d2; *(u32x2*)(P_POS + 2 * t) = pp; }
        }
        if (bx < 8) { const int e = bx; int te = 0, ps = 0;
#pragma unroll
            for (int k = 0; k < 8; ++k) if (k == e) { te = tot[k]; ps = pstart[k]; }
            const int padded = ((te + 255) >> 8) << 8;
            for (int r = te + tid; r < padded; r += 512) { P_ROWTOK[ps + r] = NTOK; P_ROWGATE[ps + r] = 0.f; P_ROWRSTD[ps + r] = 0.f; } }
        if (bx == 0 && tid == 0) {
#pragma unroll
            for (int e = 0; e < 8; ++e) P_CNT[e] = tot[e]; }
        __syncthreads();
    }
    SEAM(12);
    if (IN(13)) for (int rep = 0; rep < DUPN(13); ++rep) {
        WS_LOCAL
        SchedMoE S; S.A = (const char*)Hb8; S.B = (const char*)Wgu_m; S.rowtok = P_ROWTOK; S.K = D / 2; S.G = G; S.c = bx; S.nN = 2 * DFFE / 256; S.bstride = (size_t)2 * DFFE * D; S.gather = true; S.streamk = false; S.cx = 0; S.init(P_CNT);
        EpiSwiGLU<true> E; E.H = nullptr; E.ldh = DFFE; E.ssq = nullptr; E.rowrstd = P_ROWRSTD; E.H8 = Hm; E.ascale = 1.f / W8_UP; E.oscale = H8_SC;
        pg8::gemm_phase<EpiSwiGLU<true>, SchedMoE, true, true, true>(lds, D / 2, S, E, wave);
        if (G == 256) {
            const int tot_ = S.bstart[NEXP] * S.nN, busy_ = tot_ - ((tot_ - 1) / G) * G, nidle_ = G - busy_; const int qa = DM_ITEMS - DEF_S4;
            if (nidle_ >= TEST_S4_MIN_IDLE) { if (vcu >= busy_) conv_down_m(a.w_down_m, Wd_m, lds, wave, qa, DM_ITEMS, (vcu - busy_) * 8 + wave, nidle_ * 8); }
            else conv_down_m(a.w_down_m, Wd_m, lds, wave, qa, DM_ITEMS, bx * 8 + wave, G * 8); }
    }
    SEAM(13);
    if (IN(14)) for (int rep = 0; rep < DUPN(14); ++rep) {
        WS_LOCAL
        SchedMoE S; S.A = (const char*)Hm; S.B = (const char*)Wd_m; S.rowtok = P_ROWTOK; S.K = DFFE / 2; S.G = G; S.c = bx; S.cx = bx; S.nN = D / 256; S.bstride = (size_t)D * DFFE; S.gather = false; S.streamk = true; S.init(P_CNT);
        EpiMoEDown E; E.Y = Yb; E.rowgate = P_ROWGATE; E.sc = 1.f / (W8_DN * H8_SC); E.pdelta = (long)((const char*)(ws + WS_R + YPART_OFF) - (const char*)Yb) - (long)2 * NTOK * D * 2;
        pg8::gemm_phase<EpiMoEDown, SchedMoE, false, true, true, true>(lds, DFFE / 2, S, E, wave);
    }
    SEAM(14);
    if (IN(15)) for (int rep = 0; rep < DUPN(15); ++rep) {
        WS_LOCAL
        PHASE_LOCALS
        f32x4 hA[4], hB[4]; u32x2 yA0[4], yA1[4], yB0[4], yB1[4];
        int nrb_ = 0;
#pragma unroll
        for (int e = 0; e < NEXP; ++e) nrb_ += (__builtin_amdgcn_readfirstlane(P_CNT[e]) + 255) >> 8;
        const int tot_ = nrb_ * (D / 256), nfr_ = tot_ / G, Sp = splitk_factor(tot_ - nfr_ * G, G);
        const int split_lo = Sp > 1 ? nfr_ * (G / (D / 256)) * 256 : 0x7fffffff;
        const unsigned char* ypart = ws + WS_R + YPART_OFF;
#define CMB_PART(Yv, p_) do { float s_[4][4]; _Pragma("unroll") for (int j = 0; j < 4; ++j) _Pragma("unroll") for (int q = 0; q < 4; ++q) s_[j][q] = 0.f; \
            for (int k0 = 0; k0 < Sp; k0 += 7) { u32x2 t_[7][4]; \
                _Pragma("unroll") for (int kk = 0; kk < 7; ++kk) { const int k_ = min(k0 + kk, Sp - 1); const u32x2* q_ = (const u32x2*)(ypart + (size_t)k_ * YPART_STRIDE + (size_t)((p_) - split_lo) * (D * 2)); \
                    _Pragma("unroll") for (int j = 0; j < 4; ++j) t_[kk][j] = q_[lane + 64 * j]; } \
                _Pragma("unroll") for (int kk = 0; kk < 7; ++kk) { const bool on_ = k0 + kk < Sp; \
                    _Pragma("unroll") for (int j = 0; j < 4; ++j) { s_[j][0] += on_ ? bf_lo(t_[kk][j].x) : 0.f; s_[j][1] += on_ ? bf_hi(t_[kk][j].x) : 0.f; s_[j][2] += on_ ? bf_lo(t_[kk][j].y) : 0.f; s_[j][3] += on_ ? bf_hi(t_[kk][j].y) : 0.f; } } } \
            _Pragma("unroll") for (int j = 0; j < 4; ++j) { Yv[j].x = pk_bf16(s_[j][0], s_[j][1]); Yv[j].y = pk_bf16(s_[j][2], s_[j][3]); } } while (0)
#define CMB_LOAD(mm, H, Y0, Y1) do { const int p0_ = __builtin_amdgcn_readfirstlane(P_POS[2 * (mm)]), p1_ = __builtin_amdgcn_readfirstlane(P_POS[2 * (mm) + 1]); \
            const u32x2* o_ = (const u32x2*)(Hb + (size_t)(mm) * D); const u32x2* y0_ = (const u32x2*)(Yb + (size_t)p0_ * D); const u32x2* y1_ = (const u32x2*)(Yb + (size_t)p1_ * D); \
            _Pragma("unroll") for (int j = 0; j < 4; ++j) { const int ch = lane + 64 * j; { const u32x2 r_ = o_[ch]; H[j] = (f32x4){bf_lo(r_.x), bf_hi(r_.x), bf_lo(r_.y), bf_hi(r_.y)}; } if (p0_ < split_lo) Y0[j] = y0_[ch]; if (p1_ < split_lo) Y1[j] = y1_[ch]; } \
            if (p0_ >= split_lo) CMB_PART(Y0, p0_); if (p1_ >= split_lo) CMB_PART(Y1, p1_); } while (0)
        int m = gw;
        if (m < NTOK) CMB_LOAD(m, hA, yA0, yA1);
        for (; m < NTOK; m += NGW) {
            const int mn = m + NGW;
            if (mn < NTOK) CMB_LOAD(mn, hB, yB0, yB1);
            f32x4* o = (f32x4*)(a.out + (size_t)m * D);
#pragma unroll
            for (int j = 0; j < 4; ++j) { f32x4 h = hA[j]; const u32x2 a0 = yA0[j], a1 = yA1[j];
                h[0] += bf_lo(a0.x) + bf_lo(a1.x); h[1] += bf_hi(a0.x) + bf_hi(a1.x); h[2] += bf_lo(a0.y) + bf_lo(a1.y); h[3] += bf_hi(a0.y) + bf_hi(a1.y); o[lane + 64 * j] = h; }
#pragma unroll
            for (int j = 0; j < 4; ++j) { hA[j] = hB[j]; yA0[j] = yB0[j]; yA1[j] = yB1[j]; }
        }
#undef CMB_LOAD
#undef CMB_PART
    }
#undef IN
#undef SEAM
#undef GRID_BAR
}

extern "C" void kernel_launch(void* const* d_in, const int* in_sizes, int n_in, void* d_out, int out_size, void* d_ws, size_t ws_size, hipStream_t stream) {
    static int grid = 0;
    if (grid == 0) {
        if (n_in != 20 || out_size != NTOK * D || ws_size < WS_END) { fprintf(stderr, "kernel_launch: unexpected shapes (n_in %d out %d ws %zu need %zu)\n", n_in, out_size, ws_size, (size_t)WS_END); grid = -1; return; }
        int dev = 0, cus = 0, per_cu = 0;
        (void)hipGetDevice(&dev); (void)hipDeviceGetAttribute(&cus, hipDeviceAttributeMultiprocessorCount, dev);
        if (hipFuncSetAttribute((const void*)mk_fwd, hipFuncAttributeMaxDynamicSharedMemorySize, LDS_BYTES) != hipSuccess) { fprintf(stderr, "kernel_launch: hipFuncSetAttribute failed\n"); grid = -1; return; }
        (void)hipOccupancyMaxActiveBlocksPerMultiprocessor(&per_cu, (const void*)mk_fwd, 512, LDS_BYTES);
        (void)hipGetLastError();
        if (per_cu < 1) { fprintf(stderr, "kernel_launch: occupancy query says %d blocks per CU\n", per_cu); per_cu = 1; }
        grid = cus;
    }
    if (grid < 0) return;
    (void)hipMemsetAsync((char*)d_ws + WS_CTL, 0, CTL_BYTES, stream);
    Args a{};
    a.x = (const float*)d_in[0]; a.mem = (const float*)d_in[1]; a.g_attn = (const float*)d_in[2]; a.w_in = (const float*)d_in[3]; a.g_qk_na = (const float*)d_in[4]; a.rpb_na = (const float*)d_in[5];
    a.g_qk_dil = (const float*)d_in[6]; a.g_mem = (const float*)d_in[7]; a.w_mem_kv = (const float*)d_in[8]; a.g_qk_mem = (const float*)d_in[9]; a.g_out = (const float*)d_in[10]; a.w_out = (const float*)d_in[11];
    a.g_ffn = (const float*)d_in[12]; a.w_gate_d = (const float*)d_in[13]; a.w_up_d = (const float*)d_in[14]; a.w_down_d = (const float*)d_in[15]; a.w_router = (const float*)d_in[16];
    a.w_gate_m = (const float*)d_in[17]; a.w_up_m = (const float*)d_in[18]; a.w_down_m = (const float*)d_in[19];
    a.out = (float*)d_out; a.ws = (unsigned char*)d_ws;
#if MK_N_LAUNCHES == 1
    a.ph_lo = 0; a.ph_hi = NPHASE;
    void* args[] = {&a};
    hipError_t e = hipLaunchCooperativeKernel((const void*)mk_fwd, dim3(grid), dim3(512), args, LDS_BYTES, stream);
    if (e != hipSuccess) fprintf(stderr, "cooperative launch failed: %s (grid %d)\n", hipGetErrorString(e), grid);
#else
    for (int p = 0; p < NPHASE; ++p) { a.ph_lo = p; a.ph_hi = p + 1; hipLaunchKernelGGL(mk_fwd, dim3(grid), dim3(512), LDS_BYTES, stream, a); }
#endif
}
```

```cpp
#include <hip/hip_runtime.h>
#include <hip/hip_cooperative_groups.h>
#include <cstdio>
#include <cstdint>
namespace cg = cooperative_groups;

#ifndef MK_N_LAUNCHES
#define MK_N_LAUNCHES 1
#endif
#ifndef DENSE_FP8_UP
#define DENSE_FP8_UP 1
#endif
#ifndef DENSE_FP8_DN
#define DENSE_FP8_DN 1
#endif

constexpr int D = 1024, SEQ = 8192, NTOK = 16384, MEMLEN = 256, NMEM = 512;
constexpr int HD = 64;
constexpr int IN_W = 2560;
constexpr int DFF = 2816, NEXP = 8, DFFE = 3584;
constexpr int PMAX = 34816;
constexpr int YPART_ROWS = PMAX - 2 * NTOK;
constexpr size_t YPART_STRIDE = (size_t)YPART_ROWS * 1024 * 2, YPART_OFF = (size_t)128 << 20;
constexpr int QKV_QA = 0, QKV_KA = 384, QKV_VA = 768, QKV_QB = 1152, QKV_KB = 1536, QKV_VB = 1920, QKV_QM = 2304;
constexpr float RMS_EPS = 1e-6f;
constexpr float LOG2E = 1.4426950408889634f;
constexpr float QSCALE = 0.125f * LOG2E;
constexpr float W8_UP = 64.f, W8_DN = 128.f, H8_SC = 8.f;

#define LAS __attribute__((address_space(3)))
#define GAS __attribute__((address_space(1)))
typedef unsigned short bf16_t;
typedef short bf16x8 __attribute__((ext_vector_type(8)));
typedef float f32x4 __attribute__((ext_vector_type(4)));
typedef float f32x2 __attribute__((ext_vector_type(2)));
typedef unsigned u32x4 __attribute__((ext_vector_type(4)));
typedef unsigned u32x2 __attribute__((ext_vector_type(2)));
typedef __bf16 bf16x2_t __attribute__((ext_vector_type(2)));

__device__ __forceinline__ unsigned pk_bf16(float lo, float hi) { f32x2 v = {lo, hi}; bf16x2_t b = __builtin_convertvector(v, bf16x2_t); return __builtin_bit_cast(unsigned, b); }
__device__ __forceinline__ unsigned pk4_fp8(float a, float b, float c, float d) { int w = 0; w = __builtin_amdgcn_cvt_pk_fp8_f32(a, b, w, false); w = __builtin_amdgcn_cvt_pk_fp8_f32(c, d, w, true); return (unsigned)w; }
__device__ __forceinline__ void st16_wt(void* p, u32x4 v) { asm volatile("global_store_dwordx4 %0, %1, off sc1\n\ts_nop 1" :: "v"(p), "v"(v) : "memory"); }
__device__ __forceinline__ float bf_lo(unsigned u) { return __uint_as_float(u << 16); }
__device__ __forceinline__ float bf_hi(unsigned u) { return __uint_as_float(u & 0xffff0000u); }
__device__ __forceinline__ float sum_x32(float v) { auto r = __builtin_amdgcn_permlane32_swap(__float_as_uint(v), __float_as_uint(v), false, false); return __uint_as_float(r[0]) + __uint_as_float(r[1]); }
__device__ __forceinline__ float sum_x16(float v) { auto r = __builtin_amdgcn_permlane16_swap(__float_as_uint(v), __float_as_uint(v), false, false); return __uint_as_float(r[0]) + __uint_as_float(r[1]); }
template <int K> __device__ __forceinline__ float swz_xor(float v) { return __uint_as_float((unsigned)__builtin_amdgcn_ds_swizzle((int)__float_as_uint(v), (K << 10) | 0x1f)); }
__device__ __forceinline__ float wave_sum(float v) { v += swz_xor<1>(v); v += swz_xor<2>(v); v += swz_xor<4>(v); v += swz_xor<8>(v); v = sum_x16(v); return sum_x32(v); }
__device__ __forceinline__ float ssq16(const float* p) {
    const f32x4* q = (const f32x4*)p; const f32x4 a = q[0], b = q[1], c = q[2], d = q[3];
    const f32x4 s = (a + b) + (c + d); return (s[0] + s[1]) + (s[2] + s[3]);
}

__device__ __forceinline__ int lane_id_now() { int l; asm volatile("v_mbcnt_lo_u32_b32 %0, -1, 0\n\tv_mbcnt_hi_u32_b32 %0, -1, %0" : "=v"(l)); return l; }
constexpr size_t al256(size_t x) { return (x + 255) & ~(size_t)255; }
constexpr size_t WS_CTL = 0, CTL_BYTES = 1u << 16;
constexpr size_t SSQ_BYTES = al256((size_t)(NTOK + 1) * 4 * 4);
constexpr size_t WS_SSQ = WS_CTL + CTL_BYTES;
constexpr size_t WS_SSQMEM = WS_SSQ + 4 * SSQ_BYTES;
constexpr size_t WS_SSQH = WS_SSQMEM + al256((size_t)NMEM * 4 * 4);
constexpr size_t WS_ROPE = WS_SSQH + al256((size_t)NTOK * 16 * 4);
constexpr size_t WS_MEMBF = WS_ROPE + al256((size_t)SEQ * 64 * 4);
constexpr size_t WS_MEMKV = WS_MEMBF + al256((size_t)NMEM * D * 2);
constexpr size_t WS_EIDX = WS_MEMKV + al256((size_t)2 * NMEM * 512 * 2);
constexpr size_t WS_GATE = WS_EIDX + al256((size_t)NTOK * 4);
constexpr size_t WS_POS = WS_GATE + al256((size_t)NTOK * 8);
constexpr size_t WS_ROWTOK = WS_POS + al256((size_t)NTOK * 8);
constexpr size_t WS_ROWGATE = WS_ROWTOK + al256((size_t)PMAX * 4);
constexpr size_t WS_CNT = WS_ROWGATE + al256((size_t)PMAX * 4);
constexpr size_t WS_RSTD3 = al256(WS_CNT + 256);
constexpr size_t WS_ROWRSTD = WS_RSTD3 + al256((size_t)NTOK * 4);
constexpr size_t WS_WGU_M = WS_ROWRSTD + al256((size_t)PMAX * 4);
constexpr size_t WS_WD_M = WS_WGU_M + (size_t)NEXP * 2 * DFFE * D;
constexpr size_t WS_HB = WS_WD_M + (size_t)NEXP * D * DFFE;
constexpr size_t WS_HB8 = WS_HB + al256((size_t)(NTOK + 1) * D * 2);
constexpr size_t WS_Y = WS_HB8 + al256((size_t)(NTOK + 1) * D);
constexpr size_t WS_R = WS_Y + (size_t)PMAX * D * 2;
constexpr size_t WS_WIN = WS_R;
constexpr size_t WS_WMEM = WS_WIN + (size_t)2 * IN_W * D * 2;
constexpr size_t WS_WOUT = WS_WMEM + (size_t)2 * 512 * D * 2;
constexpr size_t WS_WGU_D = WS_WOUT + (size_t)2 * D * D * 2;
constexpr size_t WS_WD_D = WS_WGU_D + (size_t)2 * DFF * D * 2;
constexpr size_t WS_QKV = WS_WD_D + (size_t)D * DFF * 2;
constexpr size_t WS_O = WS_QKV + (size_t)NTOK * IN_W * 2;
constexpr size_t WS_HD = WS_O + (size_t)NTOK * D * 2;
constexpr size_t WS_R_END1 = WS_HD + (size_t)NTOK * DFF * 2;
constexpr size_t WS_HM = WS_R;
constexpr size_t WS_R_END2 = WS_HM + (size_t)PMAX * DFFE;
constexpr size_t WS_END = WS_R_END1 > WS_R_END2 ? WS_R_END1 : WS_R_END2;
static_assert(WS_END <= (size_t)469762048, "workspace map exceeds 4 x the largest input tensor");

constexpr int RING_BYTES = 131072;
constexpr int LDS_BYTES = 163840;

namespace pg8 {
constexpr int BM = 256, BK = 64, HALF = 128, HTB = HALF * BK * 2, NXCD = 8, WGM = 8;
__host__ __device__ __forceinline__ int lds_byte(int r, int c) { const int st = (r >> 4) * 2 + (c >> 5), rr = r & 15, cc = c & 31, ob = rr * 64 + cc * 2; return st * 1024 + (ob ^ (((ob >> 9) & 1) << 5)); }
__host__ __device__ __forceinline__ void stage_rc(int b, int& R, int& C) { const int st = b / 1024, sb = b % 1024, swz = sb ^ (((sb >> 9) & 1) << 5); R = (st >> 1) * 16 + swz / 64; C = (st & 1) * 32 + (swz % 64) / 2; }
__host__ __device__ __forceinline__ int perm32(int rho) { const int n = rho >> 4, i = rho & 15; return 8 * (i >> 2) + 4 * n + (i & 3); }

struct Unit { int pm, pn, kind, aux; const char* A; const char* B; const int* rows; int nt2, part; };

__device__ __forceinline__ void tile_order(int L, int nM, int nN, int& pm, int& pn) {
    const int nwg = nM * nN; int wgid = L;
    { const int q = nwg / NXCD, r = nwg % NXCD, xcd = wgid % NXCD, off = wgid / NXCD; wgid = (xcd < r ? xcd * (q + 1) : r * (q + 1) + (xcd - r) * q) + off; }
    const int nig = WGM * nN, gid = wgid / nig, fm = gid * WGM, gsz = (nM - fm) < WGM ? (nM - fm) : WGM;
    pm = fm + ((wgid % nig) % gsz); pn = (wgid % nig) / gsz;
}

__host__ __device__ __forceinline__ int g8(int r) { return ((r >> 1) & 7) ^ ((((r >> 2) ^ (r >> 3)) & 1) << 1); }
__host__ __device__ __forceinline__ void stage_rc8(int b, int& R, int& C) { const int p = b >> 4, row = p >> 3, phys = p & 7; R = row; C = (phys ^ g8(row & 15)) * 8; }
typedef int v8i_t __attribute__((ext_vector_type(8)));
typedef int v4i_t __attribute__((ext_vector_type(4)));
template <class Epi, class Sched, bool GATHER, bool ALIGN_EPI, bool FP8 = false, bool SK = false, bool PUB = false>
__device__ __forceinline__ void gemm_phase(LAS unsigned char* lds, const int K, const Sched& S, const Epi& E, const int wave_in) {
    int tid = wave_in * 64 + lane_id_now(); asm volatile("" : "+v"(tid));
    const int wid = __builtin_amdgcn_readfirstlane(tid >> 6), lane = tid & 63, wr = wid >> 2, wc = wid & 3, fr = lane & 15, fq = lane >> 4;
    const int nt = K / BK;
    int RA[2], CA[2]; unsigned voffB[2];
#pragma unroll
    for (int i = 0; i < 2; ++i) { int R, C; if constexpr (FP8) stage_rc8(tid * 16 + i * 8192, R, C); else stage_rc(tid * 16 + i * 8192, R, C); const int Rb = Epi::PERM ? ((R & ~31) + perm32(R & 31)) : R;
        RA[i] = R; CA[i] = C; voffB[i] = (unsigned)(Rb * K + C) * 2u; }
    const size_t kstep = (size_t)(BK * 2);
    const size_t hstep = (size_t)HALF * K * 2;
    const unsigned ldsw = (unsigned)wid * 1024u;
    int aoffk[2], boffk[2];
    if constexpr (FP8) { const int gx = g8(fr);
        aoffk[0] = (wr * 64 + fr) * 128 + (((2 * fq) ^ gx) << 4); aoffk[1] = (wr * 64 + fr) * 128 + (((2 * fq + 1) ^ gx) << 4);
        boffk[0] = (wc * 32 + fr) * 128 + (((2 * fq) ^ gx) << 4); boffk[1] = (wc * 32 + fr) * 128 + (((2 * fq + 1) ^ gx) << 4); }
    else { aoffk[0] = lds_byte(wr * 64 + fr, fq * 8); aoffk[1] = aoffk[0] + 1024; boffk[0] = lds_byte(wc * 32 + fr, fq * 8); boffk[1] = boffk[0] + 1024; }
#define PG8_SA(b, h) (((b) * 2 + (h)) * HTB)
#define PG8_SB(b, h) ((4 + (b) * 2 + (h)) * HTB)
#define PG8_STAGE(bufoff, gbase, voff) do { _Pragma("unroll") for (int _i = 0; _i < 2; ++_i) \
        __builtin_amdgcn_global_load_lds((const unsigned*)((const char*)(gbase) + (voff)[_i]), (LAS unsigned*)(lds + (bufoff) + ldsw + _i * 8192), 16, 0, 0); } while (0)
#define PG8_LDA(dst, dst8, b, h) do { _Pragma("unroll") for (int m = 0; m < 4; ++m) { \
        if constexpr (FP8) { const v4i_t lo_ = *(const LAS v4i_t*)(lds + PG8_SA(b, h) + aoffk[0] + m * 2048), hi_ = *(const LAS v4i_t*)(lds + PG8_SA(b, h) + aoffk[1] + m * 2048); dst8[m] = __builtin_shufflevector(lo_, hi_, 0, 1, 2, 3, 4, 5, 6, 7); } \
        else { _Pragma("unroll") for (int k = 0; k < 2; ++k) dst[m][k] = *(const LAS bf16x8*)(lds + PG8_SA(b, h) + aoffk[k] + m * 2048); } } } while (0)
#define PG8_LDB(dst, dst8, b, h) do { _Pragma("unroll") for (int n = 0; n < 2; ++n) { \
        if constexpr (FP8) { const v4i_t lo_ = *(const LAS v4i_t*)(lds + PG8_SB(b, h) + boffk[0] + n * 2048), hi_ = *(const LAS v4i_t*)(lds + PG8_SB(b, h) + boffk[1] + n * 2048); dst8[n] = __builtin_shufflevector(lo_, hi_, 0, 1, 2, 3, 4, 5, 6, 7); } \
        else { _Pragma("unroll") for (int k = 0; k < 2; ++k) dst[n][k] = *(const LAS bf16x8*)(lds + PG8_SB(b, h) + boffk[k] + n * 2048); } } } while (0)
#define PG8_MMA(ai, bj, At, Bt, At8, Bt8) do { __builtin_amdgcn_s_setprio(1); _Pragma("unroll") for (int m = 0; m < 4; ++m) _Pragma("unroll") for (int n = 0; n < 2; ++n) { \
        if constexpr (FP8) asm volatile("v_mfma_scale_f32_16x16x128_f8f6f4 %0, %1, %2, %0, %3, %3 op_sel_hi:[0,0,0]" : "+v"(acc[ai][bj][m][n]) : "v"(Bt8[n]), "v"(At8[m]), "v"(sc8));   \
        else { _Pragma("unroll") for (int k = 0; k < 2; ++k) acc[ai][bj][m][n] = __builtin_amdgcn_mfma_f32_16x16x32_bf16(Bt[n][k], At[m][k], acc[ai][bj][m][n], 0, 0, 0); } } \
        __builtin_amdgcn_s_setprio(0); } while (0)
#define PG8_WAIT_V(n) asm volatile("s_waitcnt vmcnt(" #n ")" ::: "memory")
#define PG8_WAIT_L(n) asm volatile("s_waitcnt lgkmcnt(" #n ")" ::: "memory")
#define PG8_BAR __builtin_amdgcn_s_barrier()
#define PG8_SCHED __builtin_amdgcn_sched_barrier(0)
#define PG8_OFFS(u, off) do { _Pragma("unroll") for (int _h = 0; _h < 2; ++_h) _Pragma("unroll") for (int _i = 0; _i < 2; ++_i) { \
        if constexpr (GATHER) off[_h][_i] = (unsigned)(u).rows[_h * HALF + RA[_i]] * (unsigned)(K * 2) + (unsigned)(CA[_i] * 2); \
        else off[_h][_i] = (unsigned)((_h * HALF + RA[_i]) * K + CA[_i]) * 2u; } } while (0)
    constexpr int AB = Epi::AUX_BYTES; constexpr int ROWS_OFF = 131072 + 6144, AUX_OFF = 131072 + 9216;
#define PG8_AUX(u, slot) do { if constexpr (AB != 0) { if (wid < 4) { const int t_ = wave_in * 64 + lane_id_now();   const char* src_ = E.aux_src(u) + (size_t)t_ * AB; LAS unsigned* dst_ = (LAS unsigned*)(lds + AUX_OFF + (slot) * 4096 + wid * (64 * AB)); \
        if constexpr (AB == 16) __builtin_amdgcn_global_load_lds((const unsigned*)src_, dst_, 16, 0, 0); else __builtin_amdgcn_global_load_lds((const unsigned*)src_, dst_, 4, 0, 0); } } } while (0)
#define PG8_ROWS(u, slot) do { if constexpr (GATHER) { if (wid < 4) { const int t_ = wave_in * 64 + lane_id_now(); __builtin_amdgcn_global_load_lds((const unsigned*)((u).rows + t_), (LAS unsigned*)(lds + ROWS_OFF + (slot) * 1024 + wid * 256), 4, 0, 0); } } } while (0)
    int cs = 0, ns = 1;
    Unit cur, nxt; int ui = 0;
    if (!S.next(0, cur)) return;
    f32x4 acc[2][2][4][2];
#pragma unroll
    for (int a = 0; a < 2; ++a)
#pragma unroll
        for (int b = 0; b < 2; ++b)
#pragma unroll
            for (int m = 0; m < 4; ++m)
#pragma unroll
                for (int n = 0; n < 2; ++n) acc[a][b][m][n] = (f32x4){0.f, 0.f, 0.f, 0.f};
    bf16x8 At[4][2], B0[2][2], B1[2][2];
    v8i_t At8[4], B08[2], B18[2];
    int sc8 = 0x7f7f7f7f; asm volatile("" : "+v"(sc8));
    unsigned coff[2][2], noff[2][2];
    PG8_OFFS(cur, coff);
    const char* cA = cur.A; const char* cB = cur.B;
    PG8_AUX(cur, 0);
    PG8_STAGE(PG8_SB(0, 0), cB, voffB); PG8_STAGE(PG8_SB(0, 1), cB + hstep, voffB); PG8_STAGE(PG8_SA(0, 0), cA, coff[0]); PG8_STAGE(PG8_SA(0, 1), cA, coff[1]);
    if (wr == 1) PG8_BAR;
    PG8_WAIT_V(2); PG8_BAR;
    PG8_STAGE(PG8_SB(1, 0), cB + kstep, voffB); PG8_STAGE(PG8_SA(1, 0), cA + kstep, coff[0]); PG8_STAGE(PG8_SB(1, 1), cB + hstep + kstep, voffB);
    PG8_WAIT_V(6); PG8_BAR;
    for (;;) {
        const bool has_next = S.next(ui + 1, nxt);
        ns = cs == 2 ? 0 : cs + 1;
#pragma unroll
        for (int h = 0; h < 2; ++h)
#pragma unroll
            for (int i = 0; i < 2; ++i) noff[h][i] = coff[h][i];
        if (has_next) { PG8_AUX(nxt, ns); if constexpr (GATHER) { PG8_ROWS(nxt, ns); } else { PG8_OFFS(nxt, noff); } }
        const char* nA = has_next ? nxt.A : cA; const char* nB = has_next ? nxt.B : cB;
        const int ntc = (SK && cur.nt2) ? 2 * cur.nt2 : nt;
        for (int t = 0; t < ntc; t += 2) {
            const bool last = (t == ntc - 2);
            const char* a1 = cA + (size_t)(t + 1) * kstep;
            const char* a2 = last ? nA : cA + (size_t)(t + 2) * kstep; const char* b2 = last ? nB : cB + (size_t)(t + 2) * kstep;
            const char* a3 = a2 + kstep; const char* b3 = b2 + kstep;
            if constexpr (GATHER) { if (last && has_next) { const LAS int* rt_ = (const LAS int*)(lds + ROWS_OFF + ns * 1024);
#pragma unroll
                for (int h = 0; h < 2; ++h)
#pragma unroll
                    for (int i = 0; i < 2; ++i) noff[h][i] = (unsigned)rt_[h * HALF + RA[i]] * (unsigned)(K * 2) + (unsigned)(CA[i] * 2); } }
            unsigned o2[2][2];
#pragma unroll
            for (int h = 0; h < 2; ++h)
#pragma unroll
                for (int i = 0; i < 2; ++i) o2[h][i] = last ? noff[h][i] : coff[h][i];
            PG8_LDB(B0, B08, 0, 0); PG8_LDB(B1, B18, 0, 1); PG8_SCHED; PG8_LDA(At, At8, 0, 0); PG8_STAGE(PG8_SA(1, 1), a1, coff[1]);
            PG8_WAIT_V(8); PG8_WAIT_L(0); PG8_BAR; PG8_MMA(0, 0, At, B0, At8, B08); PG8_MMA(0, 1, At, B1, At8, B18); PG8_BAR; PG8_SCHED;
            PG8_LDA(At, At8, 0, 1); PG8_STAGE(PG8_SB(0, 0), b2, voffB); PG8_STAGE(PG8_SB(0, 1), b2 + hstep, voffB); PG8_STAGE(PG8_SA(0, 0), a2, o2[0]);
            PG8_WAIT_V(8); PG8_WAIT_L(0); PG8_BAR; PG8_MMA(1, 0, At, B0, At8, B08); PG8_MMA(1, 1, At, B1, At8, B18); PG8_BAR; PG8_SCHED;
            PG8_LDB(B0, B08, 1, 0); PG8_LDB(B1, B18, 1, 1); PG8_SCHED; PG8_LDA(At, At8, 1, 0); PG8_STAGE(PG8_SA(0, 1), a2, o2[1]);
            PG8_WAIT_V(8); PG8_WAIT_L(0); PG8_BAR; PG8_MMA(0, 0, At, B0, At8, B08); PG8_MMA(0, 1, At, B1, At8, B18); PG8_BAR; PG8_SCHED;
            PG8_LDA(At, At8, 1, 1); PG8_STAGE(PG8_SB(1, 0), b3, voffB); PG8_STAGE(PG8_SB(1, 1), b3 + hstep, voffB); PG8_STAGE(PG8_SA(1, 0), a3, o2[0]);
            PG8_WAIT_V(8); PG8_WAIT_L(0); PG8_BAR; PG8_MMA(1, 0, At, B0, At8, B08); PG8_MMA(1, 1, At, B1, At8, B18); PG8_BAR; PG8_SCHED;
        }
        if constexpr (FP8) asm volatile("s_nop 15\n\ts_nop 15" ::: "memory");
        if constexpr (ALIGN_EPI) { if (wr == 0) PG8_BAR; }
        E(acc, cur, wr, wc, fr, fq, (const LAS unsigned char*)(lds + AUX_OFF + cs * 4096));
        if constexpr (PUB) { const int pi_ = S.pub_index(cur); if (pi_ >= 0) {
            asm volatile("s_waitcnt vmcnt(0)" ::: "memory"); __syncthreads();
            if (wid == 0 && lane_id_now() == 0) __hip_atomic_store(S.pub + pi_, 1u, __ATOMIC_RELAXED, __HIP_MEMORY_SCOPE_AGENT); } }
        cs = ns;
        if (!has_next) break;
#pragma unroll
        for (int a = 0; a < 2; ++a)
#pragma unroll
            for (int b = 0; b < 2; ++b)
#pragma unroll
                for (int m = 0; m < 4; ++m)
#pragma unroll
                    for (int n = 0; n < 2; ++n) acc[a][b][m][n] = (f32x4){0.f, 0.f, 0.f, 0.f};
        cur = nxt; cA = nA; cB = nB; ++ui;
#pragma unroll
        for (int h = 0; h < 2; ++h)
#pragma unroll
            for (int i = 0; i < 2; ++i) coff[h][i] = noff[h][i];
        if constexpr (ALIGN_EPI) { if (wr == 1) PG8_BAR; }
    }
    PG8_WAIT_V(0);
    if constexpr (!ALIGN_EPI) { if (wr == 0) PG8_BAR; }
    PG8_BAR;
#undef PG8_SA
#undef PG8_SB
#undef PG8_STAGE
#undef PG8_LDA
#undef PG8_LDB
#undef PG8_MMA
#undef PG8_WAIT_V
#undef PG8_WAIT_L
#undef PG8_BAR
#undef PG8_SCHED
#undef PG8_OFFS
#undef PG8_AUX
#undef PG8_ROWS
}
}
using pg8::Unit;

struct SchedReg {
    const char* A; const char* B; int nM, nN, K, G, c; int nExtra; const char* memA; const char* memB;
    bool memfirst; unsigned* pub;
    __device__ __forceinline__ bool next(int i, Unit& u) const {
        const int L0 = i * G + c, nwg = nM * nN;
        if (memfirst ? (L0 >= nExtra && L0 < nExtra + nwg) : (L0 < nwg)) { const int L = memfirst ? L0 - nExtra : L0; int pm, pn; pg8::tile_order(L, nM, nN, pm, pn);
            if (memfirst) pn = pn == 0 ? nN - 1 : pn - 1;
            u.pm = pm; u.pn = pn; u.kind = 0; u.aux = 0;
            u.A = A + (size_t)pm * 256 * K * 2; u.B = B + (size_t)pn * 256 * K * 2; u.rows = nullptr; u.nt2 = 0; u.part = 0; return true; }
        const int x = memfirst ? L0 : L0 - nwg; if (x < 0 || x >= nExtra) return false;
        const int layer = x >> 2, pm = (x >> 1) & 1, pn = x & 1;
        u.pm = pm; u.pn = pn; u.kind = 1; u.aux = layer; u.A = memA + (size_t)pm * 256 * K * 2; u.B = memB + ((size_t)layer * 512 + (size_t)pn * 256) * K * 2; u.rows = nullptr; u.nt2 = 0; u.part = 0; return true;
    }
    __device__ __forceinline__ int pub_index(const Unit& u) const { return u.kind == 1 ? 64 + u.aux * 4 + u.pm * 2 + u.pn : (u.pn == nN - 1 ? u.pm : -1); }
};
#ifndef SKEW_CONV
#define SKEW_CONV 1
#endif
#ifndef TEST_S4_MIN_IDLE
#define TEST_S4_MIN_IDLE 32
#endif
#ifndef TEST_FORCE_SP
#define TEST_FORCE_SP 0
#endif
__device__ __forceinline__ int splitk_factor(int Rn, int G) { if (TEST_FORCE_SP) return G != 256 ? 1 : TEST_FORCE_SP; return G != 256 ? 1 : (Rn * 14 <= G ? 14 : (Rn * 7 <= G ? 7 : (Rn * 2 <= G ? 2 : 1))); }
struct SchedMoE {
    const char* A; const char* B; const int* rowtok; int K, G, c, nN; size_t bstride;
    int bstart[NEXP + 1];
    bool gather; bool streamk; int cx;
    __device__ __forceinline__ void init(const int* cnt) { int s = 0;
#pragma unroll
        for (int e = 0; e < NEXP; ++e) { bstart[e] = s; s += (__builtin_amdgcn_readfirstlane(cnt[e]) + 255) >> 8; } bstart[NEXP] = s; }
    __device__ __forceinline__ bool next(int i, Unit& u) const {
        const int total = bstart[NEXP] * nN; int L, t0 = 0, len = 0, part = 0, kd = 0;
        if (streamk) {
            const int nfr = total / G, Rn = total - nfr * G;
            if (i < nfr) L = i * G + ((G & 7) == 0 ? (c & 7) * (G >> 3) + (c >> 3) : c);
            else { const int NT2 = K / 128, Sp = splitk_factor(Rn, G);
                const int q_ = (i - nfr) * G + cx; if (q_ >= Rn * Sp) return false;
                const int ku = q_ / Rn; L = nfr * G + (q_ - ku * Rn); len = NT2 / Sp; t0 = ku * len; part = Sp > 1 ? 1 : 0; kd = ku; }
        } else { L = i * G + ((G & 7) == 0 ? (c & 7) * (G >> 3) + (c >> 3) : c); if (L >= total) return false; }
        int e = 0, bs = bstart[0], be = bstart[1];
#pragma unroll
        for (int k = 1; k < NEXP; ++k) if (L >= bstart[k] * nN) { e = k; bs = bstart[k]; be = bstart[k + 1]; }
        const int r = L - bs * nN, nb = be - bs;
        const int pg = r / (nb * 4), rem = r - pg * (nb * 4);
        const int pn = 4 * pg + (rem & 3), rb = bs + (rem >> 2);
        u.pm = rb; u.pn = pn; u.kind = kd; u.aux = e;
        u.A = (gather ? A : A + (size_t)rb * 256 * K * 2) + (size_t)t0 * 256; u.B = B + (size_t)e * bstride + (size_t)pn * 256 * K * 2 + (size_t)t0 * 256; u.rows = rowtok + rb * 256; u.nt2 = len; u.part = part; return true;
    }
};

#define SCHED_FENCE() __builtin_amdgcn_sched_barrier(0)
constexpr int EPI_LDS_OFF = RING_BYTES + 1024;
__device__ __forceinline__ void rows_rstd(float (&rs)[8], const LAS unsigned char* aux, const int (&rl)[8]) {
    f32x4 t[8];
#pragma unroll
    for (int g = 0; g < 8; ++g) t[g] = *(const LAS f32x4*)(aux + rl[g] * 16);
#pragma unroll
    for (int g = 0; g < 8; ++g) rs[g] = rsqrtf(((t[g][0] + t[g][1]) + (t[g][2] + t[g][3])) * (1.f / D) + RMS_EPS);
}
struct EpiQKV {
    static constexpr bool PERM = true; static constexpr int AUX_BYTES = 16;
    int wt_pn;
    long mem_delta;
    __device__ __forceinline__ const char* aux_src(const Unit& u) const { return (const char*)ssq + (u.kind == 0 ? 0L : mem_delta) + (size_t)u.pm * 256 * 16; }
    bf16_t* qkv; const float* ssq; const float* g_na; const float* g_dil; const float* g_mem;
    const float* rope; bf16_t* memkv; const float* ssqmem; const float* g_mem_all;
    LAS unsigned char* lds;
    __device__ __forceinline__ void operator()(f32x4 (&acc)[2][2][4][2], const Unit& u, int wr, int wc, int fr, int fq, const LAS unsigned char* aux) const {
        const float* gain = nullptr; bool do_rope = false; float sc = 1.f; bf16_t* out; int ldc, col0; const float* sq;
        if (u.kind == 0) {
            const int head = 4 * u.pn + wc; out = qkv + (size_t)head * NTOK * 64; ldc = 64; col0 = 0; sq = ssq;
            if (head < 6) { gain = g_na; sc = QSCALE; }
            else if (head < 12) { gain = g_na + 64; }
            else if (head < 18) { }
            else if (head < 24) { gain = g_dil; do_rope = true; sc = QSCALE; }
            else if (head < 30) { gain = g_dil + 64; do_rope = true; }
            else if (head < 36) { }
            else { gain = g_mem; sc = QSCALE; }
        } else {
            out = memkv + (size_t)u.aux * NMEM * 512; ldc = 512; col0 = 256 * u.pn + 64 * wc; sq = ssqmem;
            if (u.pn == 0) gain = g_mem_all + u.aux * 128 + 64;
        }
        int tok[8], rl[8]; (void)sq;
#pragma unroll
        for (int g = 0; g < 8; ++g) { rl[g] = (g >> 2) * 128 + wr * 64 + (g & 3) * 16 + fr; tok[g] = u.pm * 256 + rl[g]; }
        float rs[8]; rows_rstd(rs, aux, rl);
        f32x4 gv[2][2];
#pragma unroll
        for (int bj = 0; bj < 2; ++bj)
#pragma unroll
            for (int n = 0; n < 2; ++n) gv[bj][n] = gain ? *(const f32x4*)(gain + 32 * bj + 8 * fq + 4 * n) * sc : (f32x4){sc, sc, sc, sc};
#pragma unroll
        for (int g = 0; g < 8; ++g) {
            const int ai = g >> 2, m = g & 3; float r2 = rs[g];
            if (gain) {
                float ms = 0.f;
#pragma unroll
                for (int bj = 0; bj < 2; ++bj)
#pragma unroll
                    for (int n = 0; n < 2; ++n) { const f32x4 x = acc[ai][bj][m][n]; ms += (x[0] * x[0] + x[1] * x[1]) + (x[2] * x[2] + x[3] * x[3]); }
                ms = sum_x16(ms); ms = sum_x32(ms);
                r2 = rs[g] * rsqrtf(ms * rs[g] * rs[g] * (1.f / HD) + RMS_EPS);
            }
#pragma unroll
            for (int bj = 0; bj < 2; ++bj)
#pragma unroll
                for (int n = 0; n < 2; ++n) acc[ai][bj][m][n] = acc[ai][bj][m][n] * r2 * gv[bj][n];
        }
        u32x4 P[8][2];
        if (do_rope) {
            f32x4 rc[2][4];
#define ROPE_LD(g, slot) do { const float* rp_ = rope + (size_t)(tok[g] & (SEQ - 1)) * 64 + 8 * fq; rc[slot][0] = *(const f32x4*)(rp_); rc[slot][1] = *(const f32x4*)(rp_ + 4); rc[slot][2] = *(const f32x4*)(rp_ + 32); rc[slot][3] = *(const f32x4*)(rp_ + 36); } while (0)
            ROPE_LD(0, 0); ROPE_LD(1, 1);
#pragma unroll
            for (int g = 0; g < 8; ++g) { const int ai = g >> 2, m = g & 3;
#pragma unroll
                for (int n = 0; n < 2; ++n) { const f32x4 cs = rc[g & 1][n], sn = rc[g & 1][2 + n]; const f32x4 x1 = acc[ai][0][m][n], x2 = acc[ai][1][m][n];
                    acc[ai][0][m][n] = x1 * cs - x2 * sn; acc[ai][1][m][n] = x1 * sn + x2 * cs; }
                SCHED_FENCE();
                if (g + 2 < 8) { ROPE_LD(g + 2, g & 1); }
                SCHED_FENCE();
            }
#undef ROPE_LD
        }
#pragma unroll
        for (int g = 0; g < 8; ++g) { const int ai = g >> 2, m = g & 3;
#pragma unroll
            for (int bj = 0; bj < 2; ++bj) { const f32x4 a = acc[ai][bj][m][0], b = acc[ai][bj][m][1];
                P[g][bj].x = pk_bf16(a[0], a[1]); P[g][bj].y = pk_bf16(a[2], a[3]); P[g][bj].z = pk_bf16(b[0], b[1]); P[g][bj].w = pk_bf16(b[2], b[3]); } }
        if (u.kind == 1 || u.pn == wt_pn) {
#pragma unroll
            for (int g = 0; g < 8; ++g) { bf16_t* rowp = out + (size_t)tok[g] * ldc + col0 + 8 * fq; st16_wt(rowp, P[g][0]); st16_wt(rowp + 32, P[g][1]); }
        } else {
#pragma unroll
            for (int g = 0; g < 8; ++g) { bf16_t* rowp = out + (size_t)tok[g] * ldc + col0 + 8 * fq; *(u32x4*)(rowp) = P[g][0]; *(u32x4*)(rowp + 32) = P[g][1]; }
        }
    }
};
struct EpiResid {
    static constexpr bool PERM = true; static constexpr int AUX_BYTES = 0;
    __device__ __forceinline__ const char* aux_src(const Unit&) const { return nullptr; }
    bf16_t* hb; float* ssq_out; LAS unsigned char* lds; unsigned char* hb8; float asc;
    __device__ __forceinline__ void operator()(f32x4 (&acc)[2][2][4][2], const Unit& u, int wr, int wc, int fr, int fq, const LAS unsigned char*) const {
        const int col0 = u.pn * 256 + wc * 32 + 8 * fq;
        u32x4 rb[4][2];
#define RES_LD(g, slot) do { const bf16_t* p_ = hb + (size_t)(u.pm * 256 + ((g) >> 2) * 128 + wr * 64 + ((g) & 3) * 16 + fr) * D + col0; rb[slot][0] = *(const u32x4*)p_; rb[slot][1] = *(const u32x4*)(p_ + 128); } while (0)
        RES_LD(0, 0); RES_LD(1, 1); RES_LD(2, 2); RES_LD(3, 3);
        LAS float* red = (LAS float*)(lds + EPI_LDS_OFF);
#pragma unroll
        for (int g = 0; g < 8; ++g) { const int ai = g >> 2, m = g & 3; float s = 0.f;
#pragma unroll
            for (int bj = 0; bj < 2; ++bj) { const u32x4 r = rb[g & 3][bj];
                f32x4 h0 = acc[ai][bj][m][0] * asc, h1 = acc[ai][bj][m][1] * asc;
                h0[0] += bf_lo(r.x); h0[1] += bf_hi(r.x); h0[2] += bf_lo(r.y); h0[3] += bf_hi(r.y); h1[0] += bf_lo(r.z); h1[1] += bf_hi(r.z); h1[2] += bf_lo(r.w); h1[3] += bf_hi(r.w);
                acc[ai][bj][m][0] = h0; acc[ai][bj][m][1] = h1;
                s += ((h0[0] * h0[0] + h0[1] * h0[1]) + (h0[2] * h0[2] + h0[3] * h0[3])) + ((h1[0] * h1[0] + h1[1] * h1[1]) + (h1[2] * h1[2] + h1[3] * h1[3])); }
            SCHED_FENCE();
            if (g + 4 < 8) { RES_LD(g + 4, g & 3); }
            SCHED_FENCE();
            s = sum_x16(s); s = sum_x32(s);
            if (fq == 0) red[(ai * 128 + wr * 64 + m * 16 + fr) * 4 + wc] = s; }
#undef RES_LD
        asm volatile("s_waitcnt lgkmcnt(0)" ::: "memory"); __builtin_amdgcn_s_barrier(); asm volatile("" ::: "memory");
        { const int t = (wr * 4 + wc) * 64 + fq * 16 + fr; if (t < 256) { const f32x4 p = *(const LAS f32x4*)(red + t * 4); ssq_out[(size_t)(u.pm * 256 + t) * 4 + u.pn] = (p[0] + p[1]) + (p[2] + p[3]); } }
#pragma unroll
        for (int g = 0; g < 8; ++g) { const int ai = g >> 2, m = g & 3; const size_t off = (size_t)(u.pm * 256 + ai * 128 + wr * 64 + m * 16 + fr) * D + col0;
#pragma unroll
            for (int bj = 0; bj < 2; ++bj) { const f32x4 h0 = acc[ai][bj][m][0], h1 = acc[ai][bj][m][1];
                u32x4 w; w.x = pk_bf16(h0[0], h0[1]); w.y = pk_bf16(h0[2], h0[3]); w.z = pk_bf16(h1[0], h1[1]); w.w = pk_bf16(h1[2], h1[3]); *(u32x4*)(hb + off + bj * 128) = w;
                if (hb8) { u32x2 w8; w8.x = pk4_fp8(h0[0], h0[1], h0[2], h0[3]); w8.y = pk4_fp8(h1[0], h1[1], h1[2], h1[3]); *(u32x2*)(hb8 + off + bj * 128) = w8; } } }
        asm volatile("s_waitcnt lgkmcnt(0)" ::: "memory"); __builtin_amdgcn_s_barrier(); asm volatile("" ::: "memory");
    }
};
template <bool MOE> struct EpiSwiGLU {
    static constexpr bool PERM = true; static constexpr int AUX_BYTES = MOE ? 4 : 16;
    bf16_t* H; int ldh; const float* ssq; const float* rowrstd; unsigned char* H8; float ascale, oscale;
    __device__ __forceinline__ const char* aux_src(const Unit& u) const { return MOE ? (const char*)(rowrstd + (size_t)u.pm * 256) : (const char*)(ssq + (size_t)u.pm * 256 * 4); }
    __device__ __forceinline__ void operator()(f32x4 (&acc)[2][2][4][2], const Unit& u, int wr, int wc, int fr, int fq, const LAS unsigned char* aux) const {
        const int col0 = u.pn * 128 + wc * 32 + 8 * fq;
        int rl[8];
#pragma unroll
        for (int g = 0; g < 8; ++g) rl[g] = (g >> 2) * 128 + wr * 64 + (g & 3) * 16 + fr;
        float rs[8];
        if constexpr (MOE) {
#pragma unroll
            for (int g = 0; g < 8; ++g) rs[g] = *(const LAS float*)(aux + rl[g] * 4);
        } else rows_rstd(rs, aux, rl);
#pragma unroll
        for (int g = 0; g < 8; ++g) { const int ai = g >> 2, m = g & 3; unsigned wv[4];
            const float a_ = rs[g] * ascale, ic_ = __builtin_amdgcn_rcpf(a_ * a_ * (H8 ? oscale : 1.f)); const f32x2 aL2 = {-a_ * LOG2E, -a_ * LOG2E}, ic2 = {ic_, ic_};
#pragma unroll
            for (int n = 0; n < 2; ++n) { const f32x4 G4 = acc[ai][0][m][n], U4 = acc[ai][1][m][n]; float o[4];
#pragma unroll
                for (int h = 0; h < 2; ++h) { const f32x2 Gh = {G4[2 * h], G4[2 * h + 1]}, Uh = {U4[2 * h], U4[2 * h + 1]}; const f32x2 p = Gh * Uh, x = Gh * aL2;
                    f32x2 e; e.x = __builtin_amdgcn_exp2f(x.x); e.y = __builtin_amdgcn_exp2f(x.y); const f32x2 d = e * ic2 + ic2;
                    f32x2 r; r.x = __builtin_amdgcn_rcpf(d.x); r.y = __builtin_amdgcn_rcpf(d.y); const f32x2 q = p * r; o[2 * h] = q.x; o[2 * h + 1] = q.y; }
                if (H8) { wv[n] = pk4_fp8(__builtin_amdgcn_fmed3f(o[0], -448.f, 448.f), __builtin_amdgcn_fmed3f(o[1], -448.f, 448.f), __builtin_amdgcn_fmed3f(o[2], -448.f, 448.f), __builtin_amdgcn_fmed3f(o[3], -448.f, 448.f)); }
                else { wv[2 * n] = pk_bf16(o[0], o[1]); wv[2 * n + 1] = pk_bf16(o[2], o[3]); } }
            if (H8) { u32x2 w2; w2.x = wv[0]; w2.y = wv[1]; *(u32x2*)(H8 + (size_t)(u.pm * 256 + rl[g]) * ldh + col0) = w2; }
            else { u32x4 w4; w4.x = wv[0]; w4.y = wv[1]; w4.z = wv[2]; w4.w = wv[3]; *(u32x4*)(H + (size_t)(u.pm * 256 + rl[g]) * ldh + col0) = w4; }
            SCHED_FENCE(); }
    }
};
struct EpiMoEDown {
    static constexpr bool PERM = true; static constexpr int AUX_BYTES = 4, STORES = 16;
    __device__ __forceinline__ const char* aux_src(const Unit& u) const { return (const char*)(rowgate + (size_t)u.pm * 256); }
    bf16_t* Y; const float* rowgate; float sc; long pdelta;
    __device__ __forceinline__ void operator()(f32x4 (&acc)[2][2][4][2], const Unit& u, int wr, int wc, int fr, int fq, const LAS unsigned char* aux) const {
        const int col0 = u.pn * 256 + wc * 32 + 8 * fq;
        float gt[8];
#pragma unroll
        for (int g = 0; g < 8; ++g) gt[g] = *(const LAS float*)(aux + ((g >> 2) * 128 + wr * 64 + (g & 3) * 16 + fr) * 4) * sc;
        u32x4 W[8][2];
#pragma unroll
        for (int g = 0; g < 8; ++g) { const int ai = g >> 2, m = g & 3;
#pragma unroll
            for (int bj = 0; bj < 2; ++bj) { const f32x4 a = acc[ai][bj][m][0] * gt[g], b = acc[ai][bj][m][1] * gt[g];
                W[g][bj].x = pk_bf16(a[0], a[1]); W[g][bj].y = pk_bf16(a[2], a[3]); W[g][bj].z = pk_bf16(b[0], b[1]); W[g][bj].w = pk_bf16(b[2], b[3]); } }
        char* yo = (char*)Y + (u.part == 1 ? pdelta + (long)u.kind * (long)YPART_STRIDE : 0L);
#pragma unroll
        for (int g = 0; g < 8; ++g) { const int row = u.pm * 256 + (g >> 2) * 128 + wr * 64 + (g & 3) * 16 + fr; bf16_t* yp = (bf16_t*)yo + (size_t)row * D + col0; *(u32x4*)yp = W[g][0]; *(u32x4*)(yp + 128) = W[g][1]; }
    }
};

#define XB_TMO      128
#define XB_XCNT(j)  (256  + 64 * (j))
#define XB_XSUB(j)  (1280 + 64 * (j))
#define XB_XGEN(j)  (2304 + 64 * (j))
#define XB_TOP      3328
#define XB_TOPGEN   3392
#define XCD_BAR_WORDS 3456
#define XB_SPIN_CAP (1u << 20)
__device__ __forceinline__ unsigned xb_ld(unsigned* p)              { return __hip_atomic_load(p, __ATOMIC_RELAXED, __HIP_MEMORY_SCOPE_AGENT); }
__device__ __forceinline__ unsigned xb_add(unsigned* p, unsigned v) { return __hip_atomic_fetch_add(p, v, __ATOMIC_RELAXED, __HIP_MEMORY_SCOPE_AGENT); }
__device__ __forceinline__ unsigned xb_xcc_id() { return (unsigned)__builtin_amdgcn_s_getreg((3 << 11) | 20) & 0xFu; }
#define XB_SPIN(cond, bar) do { unsigned _sp = 0; while (cond) { __builtin_amdgcn_s_sleep(1); \
    if ((++_sp & 255u) == 0u) { if (xb_ld(&(bar)[XB_TMO])) break; if (_sp > XB_SPIN_CAP) { atomicAdd(&(bar)[XB_TMO], 1u); break; } } } } while (0)
struct XcdBarrier { unsigned* bar; unsigned x; volatile LAS unsigned* st; int w; };
__device__ __forceinline__ XcdBarrier xcd_barrier_post(unsigned* bar, volatile LAS unsigned* st, int wave) {
    XcdBarrier b; b.bar = bar; b.x = xb_xcc_id(); b.st = st; b.w = wave;
    if (wave == 0 && lane_id_now() == 0) (void)xb_add(&bar[XB_XCNT(b.x)], 1u);
    return b;
}
__device__ __forceinline__ void xcd_barrier_complete(unsigned* bar, unsigned x, unsigned& nloc, unsigned& nx) {
    const unsigned G = gridDim.x * gridDim.y * gridDim.z;
    unsigned sum, cnt, mine, sp = 0u;
    for (;;) {
        sum = 0u; cnt = 0u; mine = 0u;
#pragma unroll
        for (unsigned j = 0; j < 16; ++j) { const unsigned c = xb_ld(&bar[XB_XCNT(j)]); sum += c; cnt += (c > 0u) ? 1u : 0u; mine = (j == x) ? c : mine; }
        if (sum == G) break;
        __builtin_amdgcn_s_sleep(1);
        if ((++sp & 255u) == 0u) { if (xb_ld(&bar[XB_TMO])) break; if (sp > XB_SPIN_CAP) { atomicAdd(&bar[XB_TMO], 1u); break; } }
    }
    nloc = mine > 0u ? mine : 1u; nx = cnt > 0u ? cnt : 1u;
}
__device__ __forceinline__ void xcd_barrier(const XcdBarrier& b) {
    asm volatile("s_waitcnt vmcnt(0)" ::: "memory");
    __syncthreads();
    if (b.w == 0 && lane_id_now() == 0) {
        unsigned* bar = b.bar;
        __builtin_amdgcn_s_waitcnt(0);
        unsigned nloc = b.st[0], nx = b.st[1];
        if (nloc == 0u) { xcd_barrier_complete(bar, b.x, nloc, nx); b.st[0] = nloc; b.st[1] = nx; }
        const unsigned old = xb_add(&bar[XB_XSUB(b.x)], 1u);
        const unsigned gen = old / nloc;
        if (old + 1u == (gen + 1u) * nloc) {
            __builtin_amdgcn_fence(__ATOMIC_RELEASE, "agent");
            asm volatile("s_waitcnt vmcnt(0)" ::: "memory");
            __builtin_amdgcn_fence(__ATOMIC_ACQUIRE, "agent");
            const unsigned og = xb_add(&bar[XB_TOP], 1u);
            const unsigned tg = og / nx;
            if (og + 1u == (tg + 1u) * nx) xb_add(&bar[XB_TOPGEN], 1u);
            else XB_SPIN(xb_ld(&bar[XB_TOPGEN]) == tg, bar);
            xb_add(&bar[XB_XGEN(b.x)], 1u);
            asm volatile("s_waitcnt vmcnt(0)" ::: "memory");
        } else {
            __builtin_amdgcn_fence(__ATOMIC_ACQUIRE, "agent");
            XB_SPIN(xb_ld(&bar[XB_XGEN(b.x)]) == gen, bar);
            asm volatile("s_waitcnt vmcnt(0)" ::: "memory");
        }
    }
    __syncthreads();
}
constexpr int CW_BAR = 1024;
constexpr int MISC_OFF = RING_BYTES + 320;
static_assert((CW_BAR + XCD_BAR_WORDS) * 4 <= (int)CTL_BYTES, "barrier words inside the memset region");

struct Args {
    const float* x; const float* mem; const float* g_attn; const float* w_in; const float* g_qk_na; const float* rpb_na; const float* g_qk_dil; const float* g_mem;
    const float* w_mem_kv; const float* g_qk_mem; const float* g_out; const float* w_out; const float* g_ffn; const float* w_gate_d; const float* w_up_d; const float* w_down_d;
    const float* w_router; const float* w_gate_m; const float* w_up_m; const float* w_down_m;
    float* out; unsigned char* ws; int ph_lo, ph_hi;
};

__device__ __forceinline__ void conv_item(const float* W, int K, int N, const float* gain, bf16_t* WT, int k0, int n0, int dst_row0, LAS float* scr, int lane) {
    const int r8 = lane >> 3, c4 = (lane & 7) * 4;
#pragma unroll
    for (int i = 0; i < 8; ++i) { const int kk = 8 * i + r8; const f32x4 v = *(const f32x4*)(W + (size_t)(k0 + kk) * N + n0 + c4);
        const float g = gain ? gain[k0 + kk] : 1.f; LAS float* s = scr + kk * 33 + c4; s[0] = v[0] * g; s[1] = v[1] * g; s[2] = v[2] * g; s[3] = v[3] * g; }
    asm volatile("s_waitcnt lgkmcnt(0)" ::: "memory");
    const int c = lane & 7;
#pragma unroll
    for (int j = 0; j < 4; ++j) { const int n = (lane >> 3) + 8 * j; const LAS float* s = scr + (8 * c) * 33 + n;
        u32x4 o; o.x = pk_bf16(s[0 * 33], s[1 * 33]); o.y = pk_bf16(s[2 * 33], s[3 * 33]); o.z = pk_bf16(s[4 * 33], s[5 * 33]); o.w = pk_bf16(s[6 * 33], s[7 * 33]);
        *(u32x4*)(WT + (size_t)(dst_row0 + n) * K + k0 + 8 * c) = o; }
    asm volatile("s_waitcnt lgkmcnt(0)" ::: "memory");
}
__device__ __forceinline__ void conv_item8(const float* W, int K, int N, const float* gain, float scale, unsigned char* WT, int k0, int n0, int dst_row0, LAS float* scr, int lane) {
    const int r8 = lane >> 3, c4 = (lane & 7) * 4;
#pragma unroll
    for (int i = 0; i < 8; ++i) { const int kk = 8 * i + r8; const f32x4 v = *(const f32x4*)(W + (size_t)(k0 + kk) * N + n0 + c4);
        const float g = (gain ? gain[k0 + kk] : 1.f) * scale; LAS float* s = scr + kk * 33 + c4; s[0] = v[0] * g; s[1] = v[1] * g; s[2] = v[2] * g; s[3] = v[3] * g; }
    asm volatile("s_waitcnt lgkmcnt(0)" ::: "memory");
    const int c = lane & 7;
#pragma unroll
    for (int j = 0; j < 4; ++j) { const int n = (lane >> 3) + 8 * j; const LAS float* s = scr + (8 * c) * 33 + n;
        u32x2 o; o.x = pk4_fp8(s[0 * 33], s[1 * 33], s[2 * 33], s[3 * 33]); o.y = pk4_fp8(s[4 * 33], s[5 * 33], s[6 * 33], s[7 * 33]);
        *(u32x2*)(WT + (size_t)(dst_row0 + n) * K + k0 + 8 * c) = o; }
    asm volatile("s_waitcnt lgkmcnt(0)" ::: "memory");
}
__device__ __forceinline__ int map_head(int n) { const int head = n >> 6, d = n & 63; return 256 * (head >> 2) + 128 * (d >> 5) + 32 * (head & 3) + (d & 31); }
__device__ __forceinline__ int map_gate(int n) { return 256 * (n >> 7) + (n & 127); }
__device__ __forceinline__ int map_up(int n) { return 256 * (n >> 7) + 128 + (n & 127); }

__device__ __forceinline__ void attn_key(const bf16_t* kp, const bf16_t* vp, const float (&q)[64], float bias, float& m, float& l, float (&o)[64]) {
    float s = bias;
#pragma unroll
    for (int c = 0; c < 8; ++c) { const u32x4 kk = *(const u32x4*)(kp + 8 * c);
        s += q[8 * c + 0] * bf_lo(kk.x) + q[8 * c + 1] * bf_hi(kk.x) + q[8 * c + 2] * bf_lo(kk.y) + q[8 * c + 3] * bf_hi(kk.y)
           + q[8 * c + 4] * bf_lo(kk.z) + q[8 * c + 5] * bf_hi(kk.z) + q[8 * c + 6] * bf_lo(kk.w) + q[8 * c + 7] * bf_hi(kk.w); }
    const float mn = fmaxf(m, s), a = exp2f(m - mn), p = exp2f(s - mn);
    l = l * a + p; m = mn;
#pragma unroll
    for (int c = 0; c < 8; ++c) { const u32x4 vv = *(const u32x4*)(vp + 8 * c);
        o[8 * c + 0] = o[8 * c + 0] * a + p * bf_lo(vv.x); o[8 * c + 1] = o[8 * c + 1] * a + p * bf_hi(vv.x);
        o[8 * c + 2] = o[8 * c + 2] * a + p * bf_lo(vv.y); o[8 * c + 3] = o[8 * c + 3] * a + p * bf_hi(vv.y);
        o[8 * c + 4] = o[8 * c + 4] * a + p * bf_lo(vv.z); o[8 * c + 5] = o[8 * c + 5] * a + p * bf_hi(vv.z);
        o[8 * c + 6] = o[8 * c + 6] * a + p * bf_lo(vv.w); o[8 * c + 7] = o[8 * c + 7] * a + p * bf_hi(vv.w); }
}
__device__ __forceinline__ void attn_scalar_phase(const bf16_t* qkv, const bf16_t* memkv, const float* rpb, bf16_t* O, float* ssqh, int G) {
    int tidp = threadIdx.x; asm volatile("" : "+v"(tidp));
    for (int idx = blockIdx.x * 512 + tidp; idx < NTOK * 16; idx += G * 512) {
        const int head = idx / NTOK, tok = idx % NTOK, b = tok / SEQ, t = tok % SEQ;
        int qcol; if (head < 6) qcol = QKV_QA + 64 * head; else if (head < 12) qcol = QKV_QB + 64 * (head - 6); else qcol = QKV_QM + 64 * (head - 12);
        float q[64], o[64];
        { const bf16_t* qp = qkv + (size_t)tok * IN_W + qcol;
#pragma unroll
          for (int c = 0; c < 8; ++c) { const u32x4 kk = *(const u32x4*)(qp + 8 * c); q[8 * c + 0] = bf_lo(kk.x); q[8 * c + 1] = bf_hi(kk.x); q[8 * c + 2] = bf_lo(kk.y); q[8 * c + 3] = bf_hi(kk.y);
              q[8 * c + 4] = bf_lo(kk.z); q[8 * c + 5] = bf_hi(kk.z); q[8 * c + 6] = bf_lo(kk.w); q[8 * c + 7] = bf_hi(kk.w); } }
#pragma unroll
        for (int d = 0; d < 64; ++d) o[d] = 0.f;
        float m = -1e30f, l = 0.f;
        if (head < 6) {
            const int r = t >> 6, c = t & 63; int rs = r - 4; rs = rs < 0 ? 0 : (rs > 120 ? 120 : rs); int cs = c - 8; cs = cs < 0 ? 0 : (cs > 48 ? 48 : cs);
            const float* bp = rpb + head * 465;
            for (int i = 0; i < 8; ++i) for (int j = 0; j < 16; ++j) {
                const int kt = b * SEQ + (rs + i) * 64 + cs + j; const float bias = bp[(rs + i - r + 7) * 31 + (cs + j - c + 15)] * LOG2E;
                attn_key(qkv + (size_t)kt * IN_W + QKV_KA + 64 * head, qkv + (size_t)kt * IN_W + QKV_VA + 64 * head, q, bias, m, l, o); }
        } else if (head < 12) {
            const int hh = head - 6;
            for (int g = 0; g < 3; ++g) { const int dd = g == 0 ? 1 : (g == 1 ? 4 : 16);
                for (int j = -64; j <= 64; ++j) { const int pos = t + dd * j; if (pos < 0 || pos >= SEQ) continue; const int kt = b * SEQ + pos;
                    attn_key(qkv + (size_t)kt * IN_W + QKV_KB + 64 * hh, qkv + (size_t)kt * IN_W + QKV_VB + 64 * hh, q, 0.f, m, l, o); } }
        } else {
            const int hh = head - 12;
            for (int j = 0; j < MEMLEN; ++j) { const bf16_t* kp = memkv + (size_t)(b * MEMLEN + j) * 512 + 64 * hh; attn_key(kp, kp + 256, q, 0.f, m, l, o); }
        }
        const float il = 1.f / l; float ss = 0.f; bf16_t* op = O + (size_t)tok * D + 64 * head;
#pragma unroll
        for (int c = 0; c < 8; ++c) { float v[8];
#pragma unroll
            for (int e = 0; e < 8; ++e) { v[e] = o[8 * c + e] * il; ss += v[e] * v[e]; }
            u32x4 w; w.x = pk_bf16(v[0], v[1]); w.y = pk_bf16(v[2], v[3]); w.z = pk_bf16(v[4], v[5]); w.w = pk_bf16(v[6], v[7]); *(u32x4*)(op + 8 * c) = w; }
        ssqh[(size_t)tok * 16 + head] = ss;
    }
}

typedef float f32x16 __attribute__((ext_vector_type(16)));
typedef short s16x4 __attribute__((ext_vector_type(4)));
typedef short v4i16_t __attribute__((ext_vector_type(4)));
#define MFMA32(a, b, c) __builtin_amdgcn_mfma_f32_32x32x16_bf16((a), (b), (c), 0, 0, 0)
__device__ __forceinline__ s16x4 tr_read(const LAS unsigned char* p) { return __builtin_bit_cast(s16x4, __builtin_amdgcn_ds_read_tr16_b64_v4i16((LAS v4i16_t*)p)); }
constexpr int ATT_TAB_OFF = 139264;
struct AttnSt { f32x16 o0, o1; float m, l; bf16x8 q[4]; };

template <int MODE, bool LDSRES = false, bool ONESET = false>
__device__ __forceinline__ void attn_blocks(AttnSt& st, LAS unsigned char* vbuf, const bf16_t* kb, const bf16_t* vb, const int pitch, const int tokbase,
                                            const int t0, const int blockstep, const int dstep, const int tmax, const int nblk, const int lane_in,
                                            const int p0, const int p1, const int p2, const LAS float* tab) {
    int lane_o = lane_in; asm volatile("" : "+v"(lane_o)); const int lane = lane_o;
    const int r32 = lane & 31, hi = lane >> 5;
    const int vkey = lane >> 3, vch = lane & 7;
    const int w0 = vkey * 128 + (((vch >> 2) ^ ((lane >> 4) & 1)) << 6) + (vch & 3) * 16;
    const int q4 = (lane & 15) >> 2;
    const int rb0 = (4 * hi + q4) * 128 + (((q4 >> 1) & 1) << 6) + 32 * ((lane >> 4) & 1) + 8 * (lane & 3);
    u32x4 kA[4], kB[4], vA[4], vB[4];
    const int wk0 = vkey * 128 + ((vch ^ (vkey >> 1)) << 4), wk1 = vkey * 128 + ((vch ^ (vkey >> 1) ^ 4) << 4);
    const int kx = (r32 >> 1) & 7;
    const int rk0 = r32 * 128 + (((0 + hi) ^ kx) << 4), rk1 = r32 * 128 + (((2 + hi) ^ kx) << 4), rk2 = r32 * 128 + (((4 + hi) ^ kx) << 4), rk3 = r32 * 128 + (((6 + hi) ^ kx) << 4);
#define ATT_TOK(j, i) (tokbase + min(max(t0 + (j) * blockstep + (i) * dstep, 0), tmax))
#define ATT_LOAD(j, KR, VR) do { \
        _Pragma("unroll") for (int i_ = 0; i_ < 4; ++i_) { const size_t ro_ = (size_t)ATT_TOK(j, vkey + 8 * i_) * pitch + 8 * vch; KR[i_] = *(const u32x4*)(kb + ro_); VR[i_] = *(const u32x4*)(vb + ro_); } } while (0)
#define ATT_QK(S, ks_) do { \
        const bf16x8 kf0 = *(const LAS bf16x8*)((ks_) + rk0), kf1 = *(const LAS bf16x8*)((ks_) + rk1), kf2 = *(const LAS bf16x8*)((ks_) + rk2), kf3 = *(const LAS bf16x8*)((ks_) + rk3); \
        _Pragma("unroll") for (int r = 0; r < 16; ++r) S[r] = 0.f; \
        S = MFMA32(kf0, st.q[0], S); S = MFMA32(kf1, st.q[1], S); S = MFMA32(kf2, st.q[2], S); S = MFMA32(kf3, st.q[3], S); } while (0)
#define ATT_MASK(S, j) do { \
        int mlo = 0, mcnt = 32; \
        if (MODE == 0) { mlo = -p1; mcnt = ((unsigned)(p0 + (j)) < 8u) ? 16 : 0; } \
        else if (MODE == 1) { const int b0_ = p0 + 32 * (j); mlo = max(p2 - 64, 0) - b0_; mcnt = max(min(p2 + 64, p1 - 1) - b0_ - mlo + 1, 0); } \
        const bool allv = (MODE == 2) || __all(mlo <= 0 && mlo + mcnt >= 32); \
        if (MODE == 0) { _Pragma("unroll") for (int r = 0; r < 16; ++r) S[r] += tab[p2 + 64 * (j) + (r & 3) + 8 * (r >> 2) + 4 * hi]; } \
        if (!allv) { const int e0_ = 4 * hi - mlo; \
            _Pragma("unroll") for (int r = 0; r < 16; ++r) S[r] = ((unsigned)(e0_ + (r & 3) + 8 * (r >> 2)) < (unsigned)mcnt) ? S[r] : -INFINITY; } } while (0)
#define ATT_MAX16(S) fmaxf(fmaxf(fmaxf(fmaxf(S[0], S[1]), fmaxf(S[2], S[3])), fmaxf(fmaxf(S[4], S[5]), fmaxf(S[6], S[7]))), fmaxf(fmaxf(fmaxf(S[8], S[9]), fmaxf(S[10], S[11])), fmaxf(fmaxf(S[12], S[13]), fmaxf(S[14], S[15]))))
#define ATT_SUM16(S) ((((S[0] + S[1]) + (S[2] + S[3])) + ((S[4] + S[5]) + (S[6] + S[7]))) + (((S[8] + S[9]) + (S[10] + S[11])) + ((S[12] + S[13]) + (S[14] + S[15]))))
#define ATT_PV(S, vs_) do { \
        bf16x8 pb[2]; \
        _Pragma("unroll") for (int s = 0; s < 2; ++s) { u32x4 w; w.x = pk_bf16(S[8 * s + 0], S[8 * s + 1]); w.y = pk_bf16(S[8 * s + 2], S[8 * s + 3]); w.z = pk_bf16(S[8 * s + 4], S[8 * s + 5]); w.w = pk_bf16(S[8 * s + 6], S[8 * s + 7]); \
            pb[s] = __builtin_bit_cast(bf16x8, w); } \
        _Pragma("unroll") for (int s = 0; s < 2; ++s) { \
            const s16x4 a0 = tr_read((vs_) + rb0 + s * 2048), a1 = tr_read((vs_) + rb0 + s * 2048 + 1024); \
            const s16x4 b0 = tr_read((vs_) + (rb0 ^ 64) + s * 2048), b1 = tr_read((vs_) + (rb0 ^ 64) + s * 2048 + 1024); \
            const bf16x8 va = (bf16x8){a0[0], a0[1], a0[2], a0[3], a1[0], a1[1], a1[2], a1[3]}; \
            const bf16x8 vb8 = (bf16x8){b0[0], b0[1], b0[2], b0[3], b1[0], b1[1], b1[2], b1[3]}; \
            st.o0 = MFMA32(va, pb[s], st.o0); st.o1 = MFMA32(vb8, pb[s], st.o1); } } while (0)
#define ATT_BODY(j, KR, VR) do { \
        LAS unsigned char* ks = LDSRES ? vbuf + (j) * 8192 : vbuf; LAS unsigned char* vs = ks + 4096; \
        if constexpr (!LDSRES) { \
        *(LAS u32x4*)(ks + wk0) = KR[0]; *(LAS u32x4*)(ks + wk1 + 1024) = KR[1]; *(LAS u32x4*)(ks + wk0 + 2048) = KR[2]; *(LAS u32x4*)(ks + wk1 + 3072) = KR[3]; \
        _Pragma("unroll") for (int i = 0; i < 4; ++i) *(LAS u32x4*)(vs + w0 + i * 1024) = VR[i]; \
        if ((j) + (ONESET ? 1 : 2) < nblk) { ATT_LOAD((j) + (ONESET ? 1 : 2), KR, VR); } } \
        f32x16 S; ATT_QK(S, ks); ATT_MASK(S, (j)); \
        float bm = ATT_MAX16(S); \
        { auto rr_ = __builtin_amdgcn_permlane32_swap(__float_as_uint(bm), __float_as_uint(bm), false, false); bm = fmaxf(__uint_as_float(rr_[0]), __uint_as_float(rr_[1])); } \
        const float mn = fmaxf(st.m, bm), alpha = __builtin_amdgcn_exp2f(st.m - mn); st.m = mn; \
        _Pragma("unroll") for (int r = 0; r < 16; ++r) S[r] = __builtin_amdgcn_exp2f(S[r] - mn); \
        st.l = st.l * alpha + ATT_SUM16(S); \
        if (__any(alpha != 1.f)) { _Pragma("unroll") for (int r = 0; r < 16; ++r) { st.o0[r] *= alpha; st.o1[r] *= alpha; } } \
        ATT_PV(S, vs); \
    } while (0)
#define ATT_BODY2(j) do { \
        LAS unsigned char* ks0 = vbuf + (j) * 8192; LAS unsigned char* ks1 = ks0 + 8192; \
        f32x16 S0, S1; ATT_QK(S0, ks0); ATT_QK(S1, ks1); ATT_MASK(S0, (j)); ATT_MASK(S1, (j) + 1); \
        float bm = fmaxf(ATT_MAX16(S0), ATT_MAX16(S1)); \
        { auto rr_ = __builtin_amdgcn_permlane32_swap(__float_as_uint(bm), __float_as_uint(bm), false, false); bm = fmaxf(__uint_as_float(rr_[0]), __uint_as_float(rr_[1])); } \
        const float mn = fmaxf(st.m, bm), alpha = __builtin_amdgcn_exp2f(st.m - mn); st.m = mn; \
        _Pragma("unroll") for (int r = 0; r < 16; ++r) { S0[r] = __builtin_amdgcn_exp2f(S0[r] - mn); S1[r] = __builtin_amdgcn_exp2f(S1[r] - mn); } \
        st.l = st.l * alpha + (ATT_SUM16(S0) + ATT_SUM16(S1)); \
        if (__any(alpha != 1.f)) { _Pragma("unroll") for (int r = 0; r < 16; ++r) { st.o0[r] *= alpha; st.o1[r] *= alpha; } } \
        ATT_PV(S0, ks0 + 4096); ATT_PV(S1, ks1 + 4096); \
    } while (0)
    if constexpr (LDSRES) {
        for (int j = 0; j < nblk; ++j) ATT_BODY(j, kA, vA);
    } else if constexpr (ONESET) {
        ATT_LOAD(0, kA, vA);
        for (int j = 0; j < nblk; ++j) ATT_BODY(j, kA, vA);
    } else {
        ATT_LOAD(0, kA, vA); if (nblk > 1) { ATT_LOAD(1, kB, vB); }
        for (int j = 0; j < nblk; j += 2) {
            ATT_BODY(j, kA, vA);
            if (j + 1 < nblk) ATT_BODY(j + 1, kB, vB);
        }
    }
#undef ATT_BODY
#undef ATT_BODY2
#undef ATT_QK
#undef ATT_MASK
#undef ATT_MAX16
#undef ATT_SUM16
#undef ATT_PV
#undef ATT_TOK
#undef ATT_LOAD
}

constexpr int COOP_MEM = 256, COOP_DIL = 1152, COOP_NA = 384;
constexpr int ATT_Q_NA = 384;
constexpr int ATT_STG_OFF = 98304;
struct TileQ { int tb, sa, sb, headg, pat; const bf16_t* qbase; };
__device__ __forceinline__ void coop_tile(int it, int wave, const bf16_t* qkv, TileQ& t, int& decq0, int& dd) {
    if (it < COOP_MEM) { const int b = it >> 7, h = (it >> 5) & 3, grp = it & 31; t.tb = b * SEQ + 256 * grp + 32 * wave; t.sa = 16; t.sb = 1; t.headg = 12 + h; t.pat = -1; t.qbase = qkv + (size_t)(QKV_QM / 64 + h) * NTOK * 64; decq0 = 0; dd = 1; }
    else if (it >= COOP_MEM + COOP_DIL) { const int x = 8 * (it - COOP_MEM - COOP_DIL) + wave, b = x / 1536, rem = x % 1536, h = rem >> 8, rp = (rem >> 2) & 63, cgp = rem & 3;
        t.tb = b * SEQ + 2 * rp * 64 + 16 * cgp; t.sa = 64; t.sb = 1; t.headg = h; t.pat = -1; t.qbase = qkv + (size_t)(QKV_QA / 64 + h) * NTOK * 64; decq0 = x; dd = 1; }
    else { const int x = it - COOP_MEM, hb = x / 96, r = x % 96, grp = r & 31, b = hb / 6, h = hb % 6, pat = r >> 5;
        const int d = pat == 0 ? 1 : (pat == 1 ? 4 : 16), cls = pat == 0 ? 0 : (pat == 1 ? (grp >> 3) : (grp >> 1)), g0 = pat == 0 ? 256 * grp : (pat == 1 ? 256 * (grp & 7) : 256 * (grp & 1));
        decq0 = g0 + 32 * wave; dd = d; t.tb = b * SEQ + cls + d * decq0; t.sa = 16 * d; t.sb = d; t.headg = 6 + h; t.pat = pat; t.qbase = qkv + (size_t)(QKV_QB / 64 + h) * NTOK * 64; }
}
__device__ __forceinline__ void attn_epilogue(const AttnSt& st, const TileQ& t, LAS unsigned char* stg, bf16_t* O, bf16_t* PO, float* Pml, int lane_in) {
    int lane = lane_in; asm volatile("" : "+v"(lane));
    const int r32 = lane & 31, hi = lane >> 5;
    const float lt = sum_x32(st.l), inv = t.pat < 0 ? 1.f / lt : 1.f;
    LAS unsigned char* wrow = stg + r32 * 128; const int sx = r32 & 15;
#pragma unroll
    for (int g = 0; g < 4; ++g) {
        u32x2 w0v; w0v.x = pk_bf16(st.o0[4 * g] * inv, st.o0[4 * g + 1] * inv); w0v.y = pk_bf16(st.o0[4 * g + 2] * inv, st.o0[4 * g + 3] * inv); *(LAS u32x2*)(wrow + (((2 * g + hi) ^ sx) << 3)) = w0v;
        u32x2 w1v; w1v.x = pk_bf16(st.o1[4 * g] * inv, st.o1[4 * g + 1] * inv); w1v.y = pk_bf16(st.o1[4 * g + 2] * inv, st.o1[4 * g + 3] * inv); *(LAS u32x2*)(wrow + (((8 + 2 * g + hi) ^ sx) << 3)) = w1v;
    }
    if (t.pat >= 0 && hi == 0) { const int tok = t.tb + t.sa * (r32 >> 4) + t.sb * (r32 & 15); f32x2 ml; ml[0] = st.m; ml[1] = lt; *(f32x2*)(Pml + (((size_t)t.pat * NTOK + tok) * 6 + (t.headg - 6)) * 2) = ml; }
    const int c = lane & 7;
#pragma unroll
    for (int i = 0; i < 4; ++i) {
        const int row = 8 * i + (lane >> 3), sr = row & 15, p0 = (2 * c) ^ sr;
        u32x4 v = *(const LAS u32x4*)(stg + row * 128 + ((p0 & ~1) << 3));
        if (sr & 1) { const unsigned tx = v.x, ty = v.y; v.x = v.z; v.y = v.w; v.z = tx; v.w = ty; }
        const int tok = t.tb + t.sa * (row >> 4) + t.sb * (row & 15);
        bf16_t* dst = t.pat < 0 ? O + (size_t)tok * D + 64 * t.headg + 8 * c : PO + ((size_t)t.pat * NTOK + tok) * 384 + 64 * (t.headg - 6) + 8 * c;
        *(u32x4*)dst = v;
    }
}
__device__ __forceinline__ void attn_mem_items(LAS unsigned char* lds, const bf16_t* qkv, const bf16_t* memkv, bf16_t* O, unsigned* pub, const int nkvflags, int wave, int first, int stride) {
    int tid = wave * 64 + lane_id_now(); asm volatile("" : "+v"(tid));
    const int lane = tid & 63, r32 = lane & 31, hi = lane >> 5;
    LAS unsigned char* stg = lds + ATT_STG_OFF + wave * 4096;
    const int ckey = (tid >> 3) & 31, cwhich = tid >> 8, cdch = tid & 7;
    const int cdst = cwhich ? 4096 + ckey * 128 + (((cdch >> 2) ^ ((ckey >> 1) & 1)) << 6) + (cdch & 3) * 16 : ckey * 128 + ((cdch ^ ((ckey >> 1) & 7)) << 4);
    for (int it = first; it < COOP_MEM; it += stride) {
        const int b_ = it >> 7, h_ = (it >> 5) & 3, panel = b_ * (SEQ / 256) + (it & 31);
        if (wave == 0 && lane_id_now() == 0) { unsigned sp_ = 0;
            while (__hip_atomic_load(pub + panel, __ATOMIC_RELAXED, __HIP_MEMORY_SCOPE_AGENT) == 0u) { __builtin_amdgcn_s_sleep(2); if (++sp_ > (1u << 22)) break; }
            for (int f = 0; f < nkvflags; ++f) { sp_ = 0; while (__hip_atomic_load(pub + 64 + f, __ATOMIC_RELAXED, __HIP_MEMORY_SCOPE_AGENT) == 0u) { __builtin_amdgcn_s_sleep(2); if (++sp_ > (1u << 22)) break; } }
            __builtin_amdgcn_fence(__ATOMIC_ACQUIRE, "agent"); asm volatile("s_waitcnt vmcnt(0)" ::: "memory"); }
        __syncthreads();
        u32x4 pre[8]; bf16x8 qn[4]; TileQ tq; int decq0 = 0, dd = 1;
        { const bf16_t* src_ = memkv + (cwhich ? 256 : 0) + 64 * h_ + 8 * cdch;
#pragma unroll
          for (int jb = 0; jb < 8; ++jb) pre[jb] = *(const u32x4*)(src_ + (size_t)(b_ * MEMLEN + 32 * jb + ckey) * 512); }
        coop_tile(it, wave, qkv, tq, decq0, dd);
        { const bf16_t* qp_ = tq.qbase + (size_t)(tq.tb + tq.sa * (r32 >> 4) + tq.sb * (r32 & 15)) * 64 + 8 * hi;
#pragma unroll
          for (int s_ = 0; s_ < 4; ++s_) qn[s_] = *(const bf16x8*)(qp_ + 16 * s_); }
#pragma unroll
        for (int jb = 0; jb < 8; ++jb) *(LAS u32x4*)(lds + jb * 8192 + cdst) = pre[jb];
        AttnSt st;
#pragma unroll
        for (int r = 0; r < 16; ++r) { st.o0[r] = 0.f; st.o1[r] = 0.f; }
        st.m = -1e30f; st.l = 0.f;
#pragma unroll
        for (int s = 0; s < 4; ++s) st.q[s] = qn[s];
        __syncthreads();
        attn_blocks<2, true>(st, lds, nullptr, nullptr, 0, 0, 0, 0, 0, 0, 8, lane, 0, 0, 0, nullptr);
        attn_epilogue(st, tq, stg, O, nullptr, nullptr, lane);
    }
    __syncthreads();
}
__device__ __forceinline__ void attn_mfma_phase(LAS unsigned char* lds, const bf16_t* qkv, const bf16_t* memkv, const float* rpb, bf16_t* O, bf16_t* PO, float* Pml, unsigned* qctr, int wave, int vcu, int G, bool skip_mem) {
    int tid = wave * 64 + lane_id_now(); asm volatile("" : "+v"(tid));
    const int lane = tid & 63, r32 = lane & 31, hi = lane >> 5;
    { LAS float* tab = (LAS float*)(lds + ATT_TAB_OFF);
      for (int i = tid; i < 6 * 15 * 64; i += 512) { const int c = i & 63, rr = (i >> 6) % 15, h = i / (15 * 64); tab[i] = (c >= 16 && c <= 46) ? rpb[h * 465 + rr * 31 + (c - 16)] * LOG2E : 0.f; } }
    __syncthreads();
    LAS unsigned char* stg = lds + ATT_STG_OFF + wave * 4096;
    {
        const int ckey = (tid >> 3) & 31, cwhich = tid >> 8, cdch = tid & 7;
        const int cdst = cwhich ? 4096 + ckey * 128 + (((cdch >> 2) ^ ((ckey >> 1) & 1)) << 6) + (cdch & 3) * 16 : ckey * 128 + ((cdch ^ ((ckey >> 1) & 7)) << 4);
        constexpr int NIT = COOP_MEM + COOP_DIL + COOP_NA;
        u32x4 pre[12]; bf16x8 qn[4]; TileQ tq; int decq0 = 0, dd = 1;
#define COOP_LOAD(it) do { \
            if ((it) < COOP_MEM) { const int b_ = (it) >> 7, h_ = ((it) >> 5) & 3; const bf16_t* src_ = memkv + (cwhich ? 256 : 0) + 64 * h_ + 8 * cdch; \
                _Pragma("unroll") for (int jb = 0; jb < 8; ++jb) pre[jb] = *(const u32x4*)(src_ + (size_t)(b_ * MEMLEN + 32 * jb + ckey) * 512); } \
            else if ((it) < COOP_MEM + COOP_DIL) { const int x_ = (it) - COOP_MEM, hb_ = x_ / 96, r_ = x_ % 96, pat_ = r_ >> 5, grp_ = r_ & 31, b_ = hb_ / 6, h_ = hb_ % 6; \
                const int d_ = pat_ == 0 ? 1 : (pat_ == 1 ? 4 : 16), cls_ = pat_ == 0 ? 0 : (pat_ == 1 ? (grp_ >> 3) : (grp_ >> 1)), g0_ = pat_ == 0 ? 256 * grp_ : (pat_ == 1 ? 256 * (grp_ & 7) : 256 * (grp_ & 1)); \
                const bf16_t* src_ = qkv + (size_t)((cwhich ? QKV_VB : QKV_KB) / 64 + h_) * NTOK * 64 + 8 * cdch; \
                _Pragma("unroll") for (int jb = 0; jb < 12; ++jb) { const int t_ = min(max(cls_ + d_ * (g0_ - 64 + 32 * jb + ckey), 0), SEQ - 1); pre[jb] = *(const u32x4*)(src_ + (size_t)(b_ * SEQ + t_) * 64); } } \
            coop_tile((it), wave, qkv, tq, decq0, dd); \
            { const bf16_t* qp_ = tq.qbase + (size_t)(tq.tb + tq.sa * (r32 >> 4) + tq.sb * (r32 & 15)) * 64 + 8 * hi; _Pragma("unroll") for (int s_ = 0; s_ < 4; ++s_) qn[s_] = *(const bf16x8*)(qp_ + 16 * s_); } } while (0)
        int it = vcu;
        if (skip_mem) { while (it < COOP_MEM) it += G; }
        if (it < NIT) COOP_LOAD(it);
        for (; it < NIT; it += G) {
            __syncthreads();
            const int nb = it < COOP_MEM ? 8 : (it < COOP_MEM + COOP_DIL ? 12 : 0);
#pragma unroll
            for (int jb = 0; jb < 12; ++jb) if (jb < nb) *(LAS u32x4*)(lds + jb * 8192 + cdst) = pre[jb];
            AttnSt st;
#pragma unroll
            for (int r = 0; r < 16; ++r) { st.o0[r] = 0.f; st.o1[r] = 0.f; }
            st.m = -1e30f; st.l = 0.f;
#pragma unroll
            for (int s = 0; s < 4; ++s) st.q[s] = qn[s];
            const TileQ tc = tq; const int cdecq0 = decq0, cd = dd;
            const bool cur_na = it >= COOP_MEM + COOP_DIL;
            if (cur_na) {
#pragma unroll
                for (int jb = 0; jb < 12; ++jb) asm volatile("" : "=v"(pre[jb]));
#pragma unroll
                for (int s_ = 0; s_ < 4; ++s_) asm volatile("" : "=v"(qn[s_]));
            }
            if (!cur_na && it + G < NIT) COOP_LOAD(it + G);
            __syncthreads();
            if (it < COOP_MEM) attn_blocks<2, true>(st, lds, nullptr, nullptr, 0, 0, 0, 0, 0, 0, 8, lane, 0, 0, 0, nullptr);
            else if (it < COOP_MEM + COOP_DIL) attn_blocks<1, true>(st, lds + wave * 8192, nullptr, nullptr, 0, 0, 0, 0, 0, 0, 5, lane, cdecq0 - 64, SEQ / cd, cdecq0 + r32, nullptr);
            else { const int x = cdecq0, b = x / 1536, rem = x % 1536, h = rem >> 8, rp = (rem >> 2) & 63, cgp = rem & 3;
                const int r0 = 2 * rp, c0 = 16 * cgp, qrow = r0 + (r32 >> 4), qcol = c0 + (r32 & 15);
                const int kr0 = min(max(r0 - 4, 0), 120), kr1 = min(max(r0 - 3, 0), 120), nrows = kr1 + 8 - kr0;
                const int rsq = min(max(qrow - 4, 0), 120), csq = min(max(qcol - 8, 0), 48), cw0 = min(max(c0 - 8, 0), 32);
                attn_blocks<0, false, true>(st, lds + wave * 8192, qkv + (size_t)(QKV_KA / 64 + h) * NTOK * 64, qkv + (size_t)(QKV_VA / 64 + h) * NTOK * 64, 64, b * SEQ, kr0 * 64 + cw0, 64, 1, SEQ - 1, nrows, lane,
                               kr0 - rsq, cw0 - csq, (kr0 - qrow + 7) * 64 + (cw0 - qcol + 31), (const LAS float*)(lds + ATT_TAB_OFF) + h * 15 * 64); }
            attn_epilogue(st, tc, stg, O, PO, Pml, lane);
            if (cur_na && it + G < NIT) COOP_LOAD(it + G);
        }
#undef COOP_LOAD
        __syncthreads();
    }
    (void)qctr;
    __syncthreads();
}

constexpr int DEF_S1 = 1920, DEF_S2 = 5120, DEF_S3 = 2048, DM_ITEMS = NEXP * 56 * 32, DEF_S4 = DM_ITEMS - DEF_S1 - DEF_S2 - DEF_S3, DEF_TOTAL = DEF_S1 + DEF_S2 + DEF_S3 + DEF_S4;
__device__ __forceinline__ void conv_down_m(const float* w_down_m, unsigned char* wd_m, LAS unsigned char* lds, int wave, int q0, int q1, int worker, int nworkers) {
    const int lane = lane_id_now(); LAS float* scr = (LAS float*)(lds + wave * 16384);
    const int r8 = lane >> 3, c4 = (lane & 7) * 4, cc = lane & 7;
    f32x4 cv[8];
#define CDM_LOAD(q) do { const int e_ = (q) / 1792, r_ = (q) % 1792, kb_ = r_ >> 5, nb_ = r_ & 31; const float* W_ = w_down_m + (size_t)e_ * DFFE * D + (size_t)(64 * kb_) * D + 32 * nb_ + c4; \
        _Pragma("unroll") for (int i = 0; i < 8; ++i) cv[i] = __builtin_nontemporal_load((const f32x4*)(W_ + (size_t)(8 * i + r8) * D)); } while (0)
    int q = q0 + worker;
    if (q < q1) CDM_LOAD(q);
    for (; q < q1; q += nworkers) {
#pragma unroll
        for (int i = 0; i < 8; ++i) { LAS float* sp = scr + (8 * i + r8) * 33 + c4; sp[0] = cv[i][0] * W8_DN; sp[1] = cv[i][1] * W8_DN; sp[2] = cv[i][2] * W8_DN; sp[3] = cv[i][3] * W8_DN; }
        if (q + nworkers < q1) CDM_LOAD(q + nworkers);
        asm volatile("s_waitcnt lgkmcnt(0)" ::: "memory");
        const int e = q / 1792, r = q % 1792, kb = r >> 5, nb = r & 31; unsigned char* dst = wd_m + (size_t)e * D * DFFE;
#pragma unroll
        for (int j = 0; j < 4; ++j) { const int n = (lane >> 3) + 8 * j; const LAS float* sp = scr + (8 * cc) * 33 + n;
            u32x2 o; o.x = pk4_fp8(sp[0 * 33], sp[1 * 33], sp[2 * 33], sp[3 * 33]); o.y = pk4_fp8(sp[4 * 33], sp[5 * 33], sp[6 * 33], sp[7 * 33]);
            __builtin_nontemporal_store(o, (u32x2*)(dst + (size_t)(32 * nb + n) * DFFE + 64 * kb + 8 * cc)); }
        asm volatile("s_waitcnt lgkmcnt(0)" ::: "memory");
    }
#undef CDM_LOAD
}

constexpr int GU_ITEMS = NEXP * 2 * 16 * 112, GU_SPLIT = 11072;
__device__ __forceinline__ void conv_gu_m(const float* w_gate_m, const float* w_up_m, const float* gain, unsigned char* wgu_m, LAS unsigned char* lds, int wave, int q0, int q1, int worker, int nworkers) {
    const int lane = lane_id_now(); LAS float* scr = (LAS float*)(lds + wave * 16384);
    const int r8 = lane >> 3, c4 = (lane & 7) * 4, cc = lane & 7;
    f32x4 cv[8]; float cg[8];
#define CGU_LOAD(q) do { const int e_ = (q) / 3584, q2_ = (q) % 3584, up_ = q2_ / 1792, r_ = q2_ % 1792, kb_ = r_ / 112, nb_ = r_ % 112; \
        const float* W_ = (up_ ? w_up_m : w_gate_m) + (size_t)e_ * D * DFFE + (size_t)(64 * kb_) * DFFE + 32 * nb_ + c4; \
        _Pragma("unroll") for (int i = 0; i < 8; ++i) { cv[i] = __builtin_nontemporal_load((const f32x4*)(W_ + (size_t)(8 * i + r8) * DFFE)); cg[i] = gain[64 * kb_ + 8 * i + r8] * W8_UP; } } while (0)
    int q = q0 + worker;
    if (q < q1) CGU_LOAD(q);
    for (; q < q1; q += nworkers) {
#pragma unroll
        for (int i = 0; i < 8; ++i) { LAS float* sp = scr + (8 * i + r8) * 33 + c4; sp[0] = cv[i][0] * cg[i]; sp[1] = cv[i][1] * cg[i]; sp[2] = cv[i][2] * cg[i]; sp[3] = cv[i][3] * cg[i]; }
        if (q + nworkers < q1) CGU_LOAD(q + nworkers);
        asm volatile("s_waitcnt lgkmcnt(0)" ::: "memory");
        const int e = q / 3584, q2 = q % 3584, up = q2 / 1792, r = q2 % 1792, kb = r / 112, nb = r % 112; unsigned char* dst = wgu_m + (size_t)e * 2 * DFFE * D; const int drow = up ? map_up(32 * nb) : map_gate(32 * nb);
#pragma unroll
        for (int j = 0; j < 4; ++j) { const int n = (lane >> 3) + 8 * j; const LAS float* sp = scr + (8 * cc) * 33 + n;
            u32x2 o; o.x = pk4_fp8(sp[0 * 33], sp[1 * 33], sp[2 * 33], sp[3 * 33]); o.y = pk4_fp8(sp[4 * 33], sp[5 * 33], sp[6 * 33], sp[7 * 33]);
            __builtin_nontemporal_store(o, (u32x2*)(dst + (size_t)(drow + n) * D + 64 * kb + 8 * cc)); }
        asm volatile("s_waitcnt lgkmcnt(0)" ::: "memory");
    }
#undef CGU_LOAD
    __syncthreads();
}

constexpr int NPHASE = 16;
__global__ void __launch_bounds__(512, 2) mk_fwd(Args a) {
    extern __shared__ __attribute__((aligned(16))) unsigned char lds_raw[];
    LAS unsigned char* lds = (LAS unsigned char*)lds_raw;
    const int tid0 = threadIdx.x, wave = __builtin_amdgcn_readfirstlane(tid0 >> 6);
    const int G = gridDim.x, bx = blockIdx.x;
#define PHASE_LOCALS int tid = wave * 64 + lane_id_now(); asm volatile("" : "+v"(tid)); const int lane = tid & 63; (void)lane;
    const int vcu = (G % 8 == 0) ? (bx % 8) * (G / 8) + bx / 8 : bx;
    const int gw = vcu * 8 + wave, NGW = G * 8;
    unsigned char* const ws0 = a.ws;
#define WS_LOCAL int wsz_ = 0; asm volatile("" : "+s"(wsz_)); unsigned char* ws = ws0 + wsz_;
#define SSQV(i) ((float*)(ws + WS_SSQ + (size_t)(i) * SSQ_BYTES))
#define P_SSQMEM ((float*)(ws + WS_SSQMEM))
#define P_ROPE ((float*)(ws + WS_ROPE))
#define P_MEMBF ((bf16_t*)(ws + WS_MEMBF))
#define P_MEMKV ((bf16_t*)(ws + WS_MEMKV))
#define P_EIDX ((int*)(ws + WS_EIDX))
#define P_GATE ((float*)(ws + WS_GATE))
#define P_POS ((int*)(ws + WS_POS))
#define P_ROWTOK ((int*)(ws + WS_ROWTOK))
#define P_ROWGATE ((float*)(ws + WS_ROWGATE))
#define P_CNT ((int*)(ws + WS_CNT))
#define P_RSTD3 ((float*)(ws + WS_RSTD3))
#define P_ROWRSTD ((float*)(ws + WS_ROWRSTD))
#define Wgu_m (ws + WS_WGU_M)
#define Wd_m (ws + WS_WD_M)
#define Hb ((bf16_t*)(ws + WS_HB))
#define Hb8 (ws + WS_HB8)
#define Win ((bf16_t*)(ws + WS_WIN))
#define Wmem ((bf16_t*)(ws + WS_WMEM))
#define Wout ((bf16_t*)(ws + WS_WOUT))
#define Wgu_d ((bf16_t*)(ws + WS_WGU_D))
#define Wd_d ((bf16_t*)(ws + WS_WD_D))
#define QKV ((bf16_t*)(ws + WS_QKV))
#define Ob ((bf16_t*)(ws + WS_O))
#define Hd ((bf16_t*)(ws + WS_HD))
#define Hm (ws + WS_HM)
#define Yb ((bf16_t*)(ws + WS_Y))

#if MK_N_LAUNCHES == 1
    volatile LAS unsigned* MISC = (volatile LAS unsigned*)(lds + MISC_OFF);
    if (tid0 < 32) MISC[tid0] = 0u;
    __syncthreads();
    const XcdBarrier bar = xcd_barrier_post((unsigned*)(ws0 + WS_CTL) + CW_BAR, MISC + 8, wave);
#define GRID_BAR() xcd_barrier(bar)
#else
#define GRID_BAR() do { } while (0)
#endif
    const int lo = a.ph_lo, hi = a.ph_hi;
#ifndef PHMASK
#define PHMASK 0xffffffu
#endif
#ifndef PROBE_DUP
#define PROBE_DUP 0
#endif
#define DUPN(k) (1 + ((PROBE_DUP >> (k)) & 1))
#define IN(k) (((PHMASK >> ((k) > 6 && (k) < 11 ? (k) - 6 : (k))) & 1u) && lo <= (k) && (k) < hi)
#define SEAM(k) do { if (IN(k) && IN((k) + 1)) GRID_BAR(); } while (0)

        constexpr int I_IN = 16 * 80, I_MEM = 16 * 16, I_OUT = 16 * 32, I_GD = 16 * 88, I_DD = 44 * 32, I_GM = 16 * 112, I_DM = 56 * 32;
        constexpr int T0 = 2 * I_IN, T1 = T0 + 2 * I_MEM, T2 = T1 + 2 * I_OUT, T3 = T2 + 2 * I_GD, T4 = T3 + I_DD, T5 = T4 + 2 * NEXP * I_GM, T6 = T5 + NEXP * I_DM;
        struct ConvP { const float* W; const float* gain; unsigned char* dst; int K, N, k0, n0, drow; float scale; bool f8; };
#define CONV_DECODE(it, P) do { \
            if ((it) < T0) { const int l = (it) / I_IN, r = (it) % I_IN, kb = r / 80, nb = r % 80; \
                P.W = a.w_in + (size_t)l * D * IN_W; P.K = D; P.N = IN_W; P.gain = a.g_attn + l * D; P.scale = 1.f; P.dst = (unsigned char*)(Win + (size_t)l * IN_W * D); P.k0 = 64 * kb; P.n0 = 32 * nb; P.drow = map_head(32 * nb); P.f8 = false; } \
            else if ((it) < T1) { const int q = (it) - T0, l = q / I_MEM, r = q % I_MEM, kb = r / 16, nb = r % 16; \
                P.W = a.w_mem_kv + (size_t)l * D * 512; P.K = D; P.N = 512; P.gain = a.g_mem + l * D; P.scale = 1.f; P.dst = (unsigned char*)(Wmem + (size_t)l * 512 * D); P.k0 = 64 * kb; P.n0 = 32 * nb; P.drow = map_head(32 * nb); P.f8 = false; } \
            else if ((it) < T2) { const int q = (it) - T1, l = q / I_OUT, r = q % I_OUT, kb = r / 32, nb = r % 32; \
                P.W = a.w_out + (size_t)l * D * D; P.K = D; P.N = D; P.gain = a.g_out + l * D; P.scale = 1.f; P.dst = (unsigned char*)(Wout + (size_t)l * D * D); P.k0 = 64 * kb; P.n0 = 32 * nb; P.drow = 32 * nb; P.f8 = false; } \
            else if ((it) < T3) { const int q = (it) - T2, up = q / I_GD, r = q % I_GD, kb = r / 88, nb = r % 88; \
                P.W = up ? a.w_up_d : a.w_gate_d; P.K = D; P.N = DFF; P.gain = a.g_ffn; P.scale = DENSE_FP8_UP ? W8_UP : 1.f; P.dst = (unsigned char*)Wgu_d; P.k0 = 64 * kb; P.n0 = 32 * nb; P.drow = up ? map_up(32 * nb) : map_gate(32 * nb); P.f8 = DENSE_FP8_UP != 0; } \
            else if ((it) < T4) { const int r = (it) - T3, kb = r / 32, nb = r % 32; \
                P.W = a.w_down_d; P.K = DFF; P.N = D; P.gain = nullptr; P.scale = DENSE_FP8_DN ? W8_DN : 1.f; P.dst = (unsigned char*)Wd_d; P.k0 = 64 * kb; P.n0 = 32 * nb; P.drow = 32 * nb; P.f8 = DENSE_FP8_DN != 0; } \
            else if ((it) < T5) { const int q = (it) - T4, e = q / (2 * I_GM), q2 = q % (2 * I_GM), up = q2 / I_GM, r = q2 % I_GM, kb = r / 112, nb = r % 112; \
                P.W = (up ? a.w_up_m : a.w_gate_m) + (size_t)e * D * DFFE; P.K = D; P.N = DFFE; P.gain = a.g_ffn + D; P.scale = W8_UP; P.dst = Wgu_m + (size_t)e * 2 * DFFE * D; P.k0 = 64 * kb; P.n0 = 32 * nb; P.drow = up ? map_up(32 * nb) : map_gate(32 * nb); P.f8 = true; } \
            else { const int q = (it) - T5, e = q / I_DM, r = q % I_DM, kb = r / 32, nb = r % 32; \
                P.W = a.w_down_m + (size_t)e * DFFE * D; P.K = DFFE; P.N = D; P.gain = nullptr; P.scale = W8_DN; P.dst = Wd_m + (size_t)e * D * DFFE; P.k0 = 64 * kb; P.n0 = 32 * nb; P.drow = 32 * nb; P.f8 = true; } } while (0)
    constexpr int N_ESS = I_IN + 2 * I_MEM, N_SKW = I_IN + (T4 - T1);
#define MAP_ESS(s_) ((s_) < I_IN ? (s_) : T0 + ((s_) - I_IN))
#define MAP_SKW(s_) ((s_) < I_IN ? I_IN + (s_) : T1 + ((s_) - I_IN))
#define CONV_LOAD(P) do { _Pragma("unroll") for (int i = 0; i < 8; ++i) { const int kk = 8 * i + r8; cv[i] = __builtin_nontemporal_load((const f32x4*)(P.W + (size_t)(P.k0 + kk) * P.N + P.n0 + c4)); cg[i] = (P.gain ? P.gain[P.k0 + kk] : 1.f) * P.scale; } } while (0)
#define CONV_RUN(NITEMS, MAP, WIDX, NW) do { LAS float* scr = (LAS float*)(lds + wave * 16384); const int ln_ = lane_id_now(); const int r8 = ln_ >> 3, c4 = (ln_ & 7) * 4, cc = ln_ & 7; \
        f32x4 cv[8]; float cg[8]; ConvP pc, pn; int s_ = (WIDX); \
        if (s_ < (NITEMS)) { const int it_ = MAP(s_); CONV_DECODE(it_, pc); CONV_LOAD(pc); } \
        for (; s_ < (NITEMS); s_ += (NW)) { \
            _Pragma("unroll") for (int i = 0; i < 8; ++i) { LAS float* sp = scr + (8 * i + r8) * 33 + c4; sp[0] = cv[i][0] * cg[i]; sp[1] = cv[i][1] * cg[i]; sp[2] = cv[i][2] * cg[i]; sp[3] = cv[i][3] * cg[i]; } \
            const bool more = s_ + (NW) < (NITEMS); \
            if (more) { const int itn_ = MAP(s_ + (NW)); CONV_DECODE(itn_, pn); CONV_LOAD(pn); } \
            asm volatile("s_waitcnt lgkmcnt(0)" ::: "memory"); \
            _Pragma("unroll") for (int j = 0; j < 4; ++j) { const int n = (ln_ >> 3) + 8 * j; const LAS float* sp = scr + (8 * cc) * 33 + n; \
                const float v0 = sp[0 * 33], v1 = sp[1 * 33], v2 = sp[2 * 33], v3 = sp[3 * 33], v4 = sp[4 * 33], v5 = sp[5 * 33], v6 = sp[6 * 33], v7 = sp[7 * 33]; \
                if (pc.f8) { u32x2 o; o.x = pk4_fp8(v0, v1, v2, v3); o.y = pk4_fp8(v4, v5, v6, v7); __builtin_nontemporal_store(o, (u32x2*)(pc.dst + (size_t)(pc.drow + n) * pc.K + pc.k0 + 8 * cc)); } \
                else { u32x4 o; o.x = pk_bf16(v0, v1); o.y = pk_bf16(v2, v3); o.z = pk_bf16(v4, v5); o.w = pk_bf16(v6, v7); *(u32x4*)((bf16_t*)pc.dst + (size_t)(pc.drow + n) * pc.K + pc.k0 + 8 * cc) = o; } } \
            asm volatile("s_waitcnt lgkmcnt(0)" ::: "memory"); \
            if (more) pc = pn; } } while (0)

    if (IN(0)) for (int rep = 0; rep < DUPN(0); ++rep) {
        WS_LOCAL
        PHASE_LOCALS
        { const bool sk_ = SKEW_CONV && G == 256; const int n_ = sk_ ? N_ESS : T5;
#define MAP_P0(s_) (sk_ ? MAP_ESS(s_) : (s_))
          CONV_RUN(n_, MAP_P0, gw, NGW);
#undef MAP_P0
        }
        if (G != 256) { __syncthreads(); conv_down_m(a.w_down_m, Wd_m, lds, wave, 0, DM_ITEMS, gw, NGW); }
        for (int m = gw; m < NTOK + NMEM; m += NGW) {
            const bool isx = m < NTOK; const float* src = isx ? a.x + (size_t)m * D : a.mem + (size_t)(m - NTOK) * D;
            bf16_t* dst = isx ? Hb + (size_t)m * D : P_MEMBF + (size_t)(m - NTOK) * D; float* sq = isx ? SSQV(0) + (size_t)m * 4 : P_SSQMEM + (size_t)(m - NTOK) * 4;
            const f32x4* xr = (const f32x4*)src + lane; float s = 0.f; f32x4 v[4];
#pragma unroll
            for (int j = 0; j < 4; ++j) { v[j] = __builtin_nontemporal_load(xr + 64 * j); s += (v[j][0] * v[j][0] + v[j][1] * v[j][1]) + (v[j][2] * v[j][2] + v[j][3] * v[j][3]); }
            s = wave_sum(s);
#pragma unroll
            for (int j = 0; j < 4; ++j) { u32x2 w; w.x = pk_bf16(v[j][0], v[j][1]); w.y = pk_bf16(v[j][2], v[j][3]); ((u32x2*)dst)[lane + 64 * j] = w; }
            if (lane < 4) sq[lane] = lane == 0 ? s : 0.f;
        }
        if (gw == 0) { for (int j = lane; j < D / 2; j += 64) ((unsigned*)(Hb + (size_t)NTOK * D))[j] = 0u; for (int j = lane; j < D / 4; j += 64) ((unsigned*)(Hb8 + (size_t)NTOK * D))[j] = 0u;
            if (lane < 4) for (int v = 0; v < 4; ++v) SSQV(v)[(size_t)NTOK * 4 + lane] = lane == 0 ? (float)D : 0.f; }
        for (int i = bx * 512 + tid; i < SEQ * 32; i += G * 512) { const int t = i >> 5, f = i & 31;
            const float inv = powf(10000.0f, -(2.0f / 64.0f) * (float)f); const float ang = (float)t * inv;
            P_ROPE[(size_t)t * 64 + f] = (float)cos((double)ang); P_ROPE[(size_t)t * 64 + 32 + f] = (float)sin((double)ang); }
    }
    SEAM(0);
    if (SKEW_CONV && G == 256 && IN(1) && (bx & 4)) { WS_LOCAL CONV_RUN(N_SKW, MAP_SKW, (((bx >> 3) << 2) | (bx & 3)) * 8 + wave, 128 * 8); __syncthreads(); }

#pragma unroll
    for (int layer = 0; layer < 2; ++layer) {
        const int pb = 1 + 6 * layer;
#define ssq_in SSQV(layer == 0 ? 0 : 2)
#define ssq_mid SSQV(layer == 0 ? 1 : 3)
        if (IN(pb)) for (int rep = 0; rep < DUPN(1); ++rep) {
            WS_LOCAL
            SchedReg S; S.A = (const char*)Hb; S.B = (const char*)(Win + (size_t)layer * IN_W * D); S.nM = NTOK / 256; S.nN = IN_W / 256; S.K = D; S.G = G; S.c = bx;
            S.nExtra = layer == 0 ? 8 : 0; S.memA = (const char*)P_MEMBF; S.memB = (const char*)Wmem;
            const int units_ = (NTOK / 256) * (IN_W / 256) + S.nExtra, busy_last = units_ - ((units_ - 1) / G) * G, nidle = G - busy_last; const bool mem_early = nidle >= 32;
            S.memfirst = mem_early; S.pub = (unsigned*)(ws + WS_CTL) + 8192 + 128 * layer;
            const int wt_pn_ = mem_early ? IN_W / 256 - 1 : -1;
            EpiQKV E; E.qkv = QKV; E.ssq = ssq_in; E.g_na = a.g_qk_na + layer * 128; E.g_dil = a.g_qk_dil + layer * 128; E.g_mem = a.g_qk_mem + layer * 128;
            E.rope = P_ROPE; E.memkv = P_MEMKV; E.ssqmem = P_SSQMEM; E.g_mem_all = a.g_qk_mem; E.lds = lds; E.wt_pn = wt_pn_; E.mem_delta = (long)((const char*)P_SSQMEM - (const char*)ssq_in);
            const bool skew_ = SKEW_CONV && G == 256 && layer == 0;
            const int hw_ = (((bx >> 3) << 2) | (bx & 3)) * 8 + wave;
            if (skew_ && (bx & 4)) conv_gu_m(a.w_gate_m, a.w_up_m, a.g_ffn + D, Wgu_m, lds, wave, 0, GU_SPLIT, hw_, 128 * 8);
            pg8::gemm_phase<EpiQKV, SchedReg, false, true, false, false, true>(lds, D, S, E, wave);
            if (skew_ && !(bx & 4)) conv_gu_m(a.w_gate_m, a.w_up_m, a.g_ffn + D, Wgu_m, lds, wave, GU_SPLIT, GU_ITEMS, hw_, 128 * 8);
            if (mem_early && bx >= busy_last) attn_mem_items(lds, QKV, P_MEMKV + (size_t)layer * NMEM * 512, Ob, S.pub, layer == 0 ? 4 : 0, wave, bx - busy_last, nidle);
            if (G == 256 && bx >= busy_last) { const int qa = DM_ITEMS - DEF_TOTAL + (layer == 0 ? 0 : DEF_S1 + DEF_S2);
                conv_down_m(a.w_down_m, Wd_m, lds, wave, qa, qa + (layer == 0 ? DEF_S1 : DEF_S3), (bx - busy_last) * 8 + wave, nidle * 8); }
        }
        SEAM(pb);
#ifdef ATTN_SCALAR
        if (IN(pb + 1)) attn_scalar_phase(QKV, P_MEMKV + (size_t)layer * NMEM * 512, a.rpb_na + layer * 6 * 465, Ob, ssqh, G);
#else
        if (IN(pb + 1)) for (int rep = 0; rep < DUPN(2); ++rep) { WS_LOCAL attn_mfma_phase(lds, QKV, P_MEMKV + (size_t)layer * NMEM * 512, a.rpb_na + layer * 6 * 465, Ob, (bf16_t*)(ws + WS_HD), (float*)(ws + WS_HD + (size_t)3 * NTOK * 384 * 2), (unsigned*)(ws + WS_CTL) + 128 * layer + 256 * rep, wave, vcu, G, (G - (((NTOK / 256) * (IN_W / 256) + (layer == 0 ? 8 : 0)) - ((((NTOK / 256) * (IN_W / 256) + (layer == 0 ? 8 : 0)) - 1) / G) * G)) >= 32); }
#endif
        SEAM(pb + 1);
        if (IN(pb + 2)) for (int rep = 0; rep < DUPN(3); ++rep) {
            WS_LOCAL
            PHASE_LOCALS
            const bf16_t* PO = (const bf16_t*)(ws + WS_HD); const float* Pml = (const float*)(ws + WS_HD + (size_t)3 * NTOK * 384 * 2);
            const bool isdil = lane >= 24 && lane < 48; const int dcol = 16 * (lane - 24), hh = (lane - 24) >> 2;
            u32x4 rA[3][2], rB[3][2]; f32x2 mA[3], mB[3];
#define MRG_LOAD(mm, R, ML) do { \
                if (isdil) { _Pragma("unroll") for (int g = 0; g < 3; ++g) { ML[g] = *(const f32x2*)(Pml + (((size_t)g * NTOK + (mm)) * 6 + hh) * 2); const u32x4* pp = (const u32x4*)(PO + ((size_t)g * NTOK + (mm)) * 384 + dcol); R[g][0] = pp[0]; R[g][1] = pp[1]; } } \
                else { const u32x4* pp = (const u32x4*)(Ob + (size_t)(mm) * D + 16 * lane); R[0][0] = pp[0]; R[0][1] = pp[1]; } } while (0)
#pragma unroll
            for (int g = 0; g < 3; ++g) { mA[g] = (f32x2){0.f, 0.f}; mB[g] = (f32x2){0.f, 0.f};
#pragma unroll
                for (int j = 0; j < 2; ++j) { rA[g][j] = (u32x4){0u, 0u, 0u, 0u}; rB[g][j] = (u32x4){0u, 0u, 0u, 0u}; } }
            int m = gw;
            if (m < NTOK) MRG_LOAD(m, rA, mA);
            for (; m < NTOK; m += NGW) {
                const int mnx = m + NGW;
                if (mnx < NTOK) MRG_LOAD(mnx, rB, mB);
                float v[16];
                if (isdil) {
                    const float M = fmaxf(fmaxf(mA[0][0], mA[1][0]), mA[2][0]);
                    const float w0 = __builtin_amdgcn_exp2f(mA[0][0] - M), w1 = __builtin_amdgcn_exp2f(mA[1][0] - M), w2 = __builtin_amdgcn_exp2f(mA[2][0] - M);
                    const float il = 1.f / (w0 * mA[0][1] + w1 * mA[1][1] + w2 * mA[2][1]);
                    const float c0 = w0 * il, c1 = w1 * il, c2 = w2 * il;
#pragma unroll
                    for (int j = 0; j < 2; ++j) {
                        const unsigned a0[4] = {rA[0][j].x, rA[0][j].y, rA[0][j].z, rA[0][j].w}, a1[4] = {rA[1][j].x, rA[1][j].y, rA[1][j].z, rA[1][j].w}, a2[4] = {rA[2][j].x, rA[2][j].y, rA[2][j].z, rA[2][j].w};
#pragma unroll
                        for (int e = 0; e < 4; ++e) { v[8 * j + 2 * e] = c0 * bf_lo(a0[e]) + c1 * bf_lo(a1[e]) + c2 * bf_lo(a2[e]); v[8 * j + 2 * e + 1] = c0 * bf_hi(a0[e]) + c1 * bf_hi(a1[e]) + c2 * bf_hi(a2[e]); }
                    }
                } else {
#pragma unroll
                    for (int j = 0; j < 2; ++j) { const u32x4 w = rA[0][j]; v[8 * j + 0] = bf_lo(w.x); v[8 * j + 1] = bf_hi(w.x); v[8 * j + 2] = bf_lo(w.y); v[8 * j + 3] = bf_hi(w.y); v[8 * j + 4] = bf_lo(w.z); v[8 * j + 5] = bf_hi(w.z); v[8 * j + 6] = bf_lo(w.w); v[8 * j + 7] = bf_hi(w.w); }
                }
                float ss = 0.f;
#pragma unroll
                for (int e = 0; e < 16; ++e) ss += v[e] * v[e];
                float s0 = lane < 24 ? ss : 0.f, s1 = isdil ? ss : 0.f, s2 = lane >= 48 ? ss : 0.f;
                s0 = wave_sum(s0); s1 = wave_sum(s1); s2 = wave_sum(s2);
                const float r0 = rsqrtf(s0 * (1.f / 384.f) + RMS_EPS), r1 = rsqrtf(s1 * (1.f / 384.f) + RMS_EPS), r2 = rsqrtf(s2 * (1.f / 256.f) + RMS_EPS);
                const float r = lane < 24 ? r0 : (lane < 48 ? r1 : r2);
                u32x4* po = (u32x4*)(Ob + (size_t)m * D + 16 * lane);
#pragma unroll
                for (int j = 0; j < 2; ++j) { u32x4 w; w.x = pk_bf16(v[8 * j] * r, v[8 * j + 1] * r); w.y = pk_bf16(v[8 * j + 2] * r, v[8 * j + 3] * r); w.z = pk_bf16(v[8 * j + 4] * r, v[8 * j + 5] * r); w.w = pk_bf16(v[8 * j + 6] * r, v[8 * j + 7] * r); po[j] = w; }
#pragma unroll
                for (int g = 0; g < 3; ++g) { mA[g] = mB[g]; rA[g][0] = rB[g][0]; rA[g][1] = rB[g][1]; }
            }
#undef MRG_LOAD
        }
        SEAM(pb + 2);
        if (IN(pb + 3)) for (int rep = 0; rep < (layer == 0 ? DUPN(4) : 1); ++rep) {
            WS_LOCAL
            SchedReg S; S.memfirst = false; S.pub = nullptr; S.A = (const char*)Ob; S.B = (const char*)(Wout + (size_t)layer * D * D); S.nM = NTOK / 256; S.nN = D / 256; S.K = D; S.G = G; S.c = bx; S.nExtra = 0; S.memA = nullptr; S.memB = nullptr;
            EpiResid E; E.hb = Hb; E.ssq_out = ssq_mid; E.lds = lds; E.hb8 = (layer == 1 || DENSE_FP8_UP) ? Hb8 : nullptr; E.asc = 1.f;
            pg8::gemm_phase<EpiResid, SchedReg, false, true>(lds, D, S, E, wave);
        }
        SEAM(pb + 3);
        if (layer == 0) {
            if (IN(5)) for (int rep = 0; rep < DUPN(5); ++rep) {
                WS_LOCAL
#if DENSE_FP8_UP
                SchedReg S; S.memfirst = false; S.pub = nullptr; S.A = (const char*)Hb8; S.B = (const char*)Wgu_d; S.nM = NTOK / 256; S.nN = 2 * DFF / 256; S.K = D / 2; S.G = G; S.c = bx; S.nExtra = 0; S.memA = nullptr; S.memB = nullptr;
                EpiSwiGLU<false> E; E.H = Hd; E.ldh = DFF; E.ssq = ssq_mid; E.rowrstd = nullptr; E.H8 = DENSE_FP8_DN ? (unsigned char*)Hd : nullptr; E.ascale = 1.f / W8_UP; E.oscale = H8_SC;
                pg8::gemm_phase<EpiSwiGLU<false>, SchedReg, false, true, true>(lds, D / 2, S, E, wave);
                if (G == 256 && bx >= 128) conv_down_m(a.w_down_m, Wd_m, lds, wave, DM_ITEMS - DEF_TOTAL + DEF_S1, DM_ITEMS - DEF_TOTAL + DEF_S1 + DEF_S2, (bx - 128) * 8 + wave, 128 * 8);
#else
                SchedReg S; S.memfirst = false; S.pub = nullptr; S.A = (const char*)Hb; S.B = (const char*)Wgu_d; S.nM = NTOK / 256; S.nN = 2 * DFF / 256; S.K = D; S.G = G; S.c = bx; S.nExtra = 0; S.memA = nullptr; S.memB = nullptr;
                EpiSwiGLU<false> E; E.H = Hd; E.ldh = DFF; E.ssq = ssq_mid; E.rowrstd = nullptr; E.H8 = DENSE_FP8_DN ? (unsigned char*)Hd : nullptr; E.ascale = 1.f; E.oscale = H8_SC;
                pg8::gemm_phase<EpiSwiGLU<false>, SchedReg, false, true>(lds, D, S, E, wave);
                if (G == 256 && bx >= 128) conv_down_m(a.w_down_m, Wd_m, lds, wave, DM_ITEMS - DEF_TOTAL + DEF_S1, DM_ITEMS - DEF_TOTAL + DEF_S1 + DEF_S2, (bx - 128) * 8 + wave, 128 * 8);
#endif
            }
            SEAM(5);
            if (IN(6)) {
                WS_LOCAL
                SchedReg S; S.memfirst = false; S.pub = nullptr; S.A = (const char*)Hd; S.B = (const char*)Wd_d; S.nM = NTOK / 256; S.nN = D / 256; S.K = DENSE_FP8_DN ? DFF / 2 : DFF; S.G = G; S.c = bx; S.nExtra = 0; S.memA = nullptr; S.memB = nullptr;
                EpiResid E; E.hb = Hb; E.ssq_out = SSQV(2); E.lds = lds; E.hb8 = nullptr; E.asc = DENSE_FP8_DN ? 1.f / (W8_DN * H8_SC) : 1.f;
                pg8::gemm_phase<EpiResid, SchedReg, false, true, DENSE_FP8_DN != 0>(lds, DENSE_FP8_DN ? DFF / 2 : DFF, S, E, wave);
            }
            SEAM(6);
        }
    }
    if (IN(11)) for (int rep = 0; rep < DUPN(11); ++rep) {
        WS_LOCAL
        PHASE_LOCALS
        constexpr int RSTR = 2048 + 16;
        LAS unsigned char* wt = lds;
        for (int k = tid; k < D; k += 512) { const float g = a.g_ffn[D + k]; const f32x4 w0 = *(const f32x4*)(a.w_router + (size_t)k * 8), w1 = *(const f32x4*)(a.w_router + (size_t)k * 8 + 4);
            const float wv[8] = {w0[0] * g, w0[1] * g, w0[2] * g, w0[3] * g, w1[0] * g, w1[1] * g, w1[2] * g, w1[3] * g};
#pragma unroll
            for (int e = 0; e < 8; ++e) { const unsigned hb_ = pk_bf16(wv[e], 0.f) & 0xffffu; const float hf = __uint_as_float(hb_ << 16); const unsigned lb_ = pk_bf16(wv[e] - hf, 0.f) & 0xffffu;
                *(LAS unsigned short*)(wt + e * RSTR + k * 2) = (unsigned short)hb_; *(LAS unsigned short*)(wt + (8 + e) * RSTR + k * 2) = (unsigned short)lb_; } }
        __syncthreads();
        const int r32 = lane & 31, hi = lane >> 5, kq = wave & 3, tl = wave >> 2;
        LAS float* red = (LAS float*)(lds + 40960);
        const float* ssq3 = SSQV(3);
        for (int T = bx * 2 + tl; T < NTOK / 32; T += 2 * G) {
            const int tok0 = 32 * T;
            bf16x8 hbv[16]; { const bf16_t* hp = Hb + (size_t)(tok0 + r32) * D + 256 * kq + 8 * hi;
#pragma unroll
              for (int sI = 0; sI < 16; ++sI) hbv[sI] = *(const bf16x8*)(hp + 16 * sI); }
            f32x16 acc;
#pragma unroll
            for (int r = 0; r < 16; ++r) acc[r] = 0.f;
            const LAS unsigned char* wrow = wt + (r32 & 7) * RSTR + (256 * kq + 8 * hi) * 2;
#pragma unroll
            for (int sI = 0; sI < 16; ++sI) { bf16x8 ah = *(const LAS bf16x8*)(wrow + 32 * sI), al = *(const LAS bf16x8*)(wrow + 8 * RSTR + 32 * sI);
                if (r32 >= 8) { ah = (bf16x8){0, 0, 0, 0, 0, 0, 0, 0}; al = ah; }
                acc = MFMA32(ah, hbv[sI], acc); acc = MFMA32(al, hbv[sI], acc); }
            { f32x4 pv; pv[0] = acc[0]; pv[1] = acc[1]; pv[2] = acc[2]; pv[3] = acc[3]; *(LAS f32x4*)(red + ((tl * 4 + kq) * 32 + r32) * 8 + 4 * hi) = pv; }
            __syncthreads();
            if (kq == 0 && hi == 0) { const int mtok = tok0 + r32; float lg[8];
#pragma unroll
                for (int e = 0; e < 8; ++e) lg[e] = 0.f;
#pragma unroll
                for (int q = 0; q < 4; ++q) { const f32x4 p0 = *(const LAS f32x4*)(red + ((tl * 4 + q) * 32 + r32) * 8), p1 = *(const LAS f32x4*)(red + ((tl * 4 + q) * 32 + r32) * 8 + 4);
                    lg[0] += p0[0]; lg[1] += p0[1]; lg[2] += p0[2]; lg[3] += p0[3]; lg[4] += p1[0]; lg[5] += p1[1]; lg[6] += p1[2]; lg[7] += p1[3]; }
                const f32x4 sq = *(const f32x4*)(ssq3 + (size_t)mtok * 4); const float rs = rsqrtf(((sq[0] + sq[1]) + (sq[2] + sq[3])) * (1.f / D) + RMS_EPS);
#pragma unroll
                for (int e = 0; e < 8; ++e) lg[e] *= rs;
                int e1 = 0; float l1 = lg[0];
#pragma unroll
                for (int e = 1; e < 8; ++e) if (lg[e] > l1) { l1 = lg[e]; e1 = e; }
                int e2 = -1; float l2 = -3.0e38f;
#pragma unroll
                for (int e = 0; e < 8; ++e) if (e != e1 && lg[e] > l2) { l2 = lg[e]; e2 = e; }
                const float p2 = expf(l2 - l1), g1 = 1.f / (1.f + p2), g2 = p2 * g1;
                P_EIDX[mtok] = e1 | (e2 << 8); f32x2 gg; gg[0] = g1; gg[1] = g2; *(f32x2*)(P_GATE + 2 * mtok) = gg; P_RSTD3[mtok] = rs; }
            __syncthreads();
        }
    }
    SEAM(11);
    if (IN(12)) for (int rep = 0; rep < DUPN(12); ++rep) {
        WS_LOCAL
        PHASE_LOCALS
        LAS int* sh = (LAS int*)lds;
        int c8[8];
#pragma unroll
        for (int e = 0; e < 8; ++e) c8[e] = 0;
        const int t0 = tid * 32;
        { pg8::v4i_t ev4[8];
#pragma unroll
          for (int q = 0; q < 8; ++q) ev4[q] = *(const pg8::v4i_t*)(P_EIDX + t0 + 4 * q);
#pragma unroll
          for (int q = 0; q < 8; ++q)
#pragma unroll
            for (int z = 0; z < 4; ++z) { const int ev = ev4[q][z]; const int e1 = ev & 255, e2 = ev >> 8;
#pragma unroll
                for (int e = 0; e < 8; ++e) c8[e] += (e1 == e) + (e2 == e); } }
        LAS int* cnts = (LAS int*)lds;
        LAS int* wtot = cnts + 8 * 512;
#pragma unroll
        for (int e = 0; e < 8; ++e) cnts[e * 512 + tid] = c8[e];
        __syncthreads();
        {
            LAS int* row = cnts + wave * 512; LAS int* part = wtot + wave * 64;
            int v8[8]; int sl = 0;
#pragma unroll
            for (int k = 0; k < 8; ++k) { v8[k] = row[8 * lane + k]; sl += v8[k]; }
            part[lane] = sl;
            asm volatile("s_waitcnt lgkmcnt(0)" ::: "memory");
            int before = 0, all = 0;
            for (int k = 0; k < 64; ++k) { const int v = part[k]; all += v; before += (k < lane) ? v : 0; }
#pragma unroll
            for (int k = 0; k < 8; ++k) { row[8 * lane + k] = before; before += v8[k]; }
            if (lane == 0) wtot[512 + wave] = all;
        }
        __syncthreads();
        int pre[8], tot[8], pstart[8];
#pragma unroll
        for (int e = 0; e < 8; ++e) { pre[e] = cnts[e * 512 + tid]; tot[e] = wtot[512 + e]; }
        { int s = 0;
#pragma unroll
          for (int e = 0; e < 8; ++e) { pstart[e] = s; s += ((tot[e] + 255) >> 8) << 8; } }
        for (int rbase = bx + wave * 2 * G; rbase < 512; rbase += 16 * G) {
            const int rt = rbase + (lane >> 5) * G; const bool on = rt < 512; const int t = (on ? rt : 0) * 32 + (lane & 31);
            const int ev = on ? P_EIDX[t] : 0xffff; const int e1 = ev & 255, e2 = ev >> 8;
            const float rt3 = P_RSTD3[t], ga = P_GATE[2 * t], gb = P_GATE[2 * t + 1];
            const unsigned long long below = (lane & 31) == 0 ? 0ull : ((1ull << (lane & 31)) - 1ull) << (lane & 32);
            int d1 = 0, d2 = 0;
#pragma unroll
            for (int e = 0; e < 8; ++e) { const unsigned long long mk = __ballot(e1 == e || e2 == e); const int rank = __popcll(mk & below);
                const int base_e = pstart[e] + cnts[e * 512 + (on ? rt : 0)] + rank; if (e1 == e) d1 = base_e; if (e2 == e) d2 = base_e; }
            if (on) { P_ROWTOK[d1] = t; P_ROWGATE[d1] = ga; P_ROWRSTD[d1] = rt3; P_ROWTOK[d2] = t; P_ROWGATE[d2] = gb; P_ROWRSTD[d2] = rt3;
                u32x2 pp; pp.x = (unsigned)d1; pp.y = (unsigned)d2; *(u32x2*)(P_POS + 2 * t) = pp; }
        }
        if (bx < 8) { const int e = bx; int te = 0, ps = 0;
#pragma unroll
            for (int k = 0; k < 8; ++k) if (k == e) { te = tot[k]; ps = pstart[k]; }
            const int padded = ((te + 255) >> 8) << 8;
            for (int r = te + tid; r < padded; r += 512) { P_ROWTOK[ps + r] = NTOK; P_ROWGATE[ps + r] = 0.f; P_ROWRSTD[ps + r] = 0.f; } }
        if (bx == 0 && tid == 0) {
#pragma unroll
            for (int e = 0; e < 8; ++e) P_CNT[e] = tot[e]; }
        __syncthreads();
    }
    SEAM(12);
    if (IN(13)) for (int rep = 0; rep < DUPN(13); ++rep) {
        WS_LOCAL
        SchedMoE S; S.A = (const char*)Hb8; S.B = (const char*)Wgu_m; S.rowtok = P_ROWTOK; S.K = D / 2; S.G = G; S.c = bx; S.nN = 2 * DFFE / 256; S.bstride = (size_t)2 * DFFE * D; S.gather = true; S.streamk = false; S.cx = 0; S.init(P_CNT);
        EpiSwiGLU<true> E; E.H = nullptr; E.ldh = DFFE; E.ssq = nullptr; E.rowrstd = P_ROWRSTD; E.H8 = Hm; E.ascale = 1.f / W8_UP; E.oscale = H8_SC;
        pg8::gemm_phase<EpiSwiGLU<true>, SchedMoE, true, true, true>(lds, D / 2, S, E, wave);
        if (G == 256) {
            const int tot_ = S.bstart[NEXP] * S.nN, busy_ = tot_ - ((tot_ - 1) / G) * G, nidle_ = G - busy_; const int qa = DM_ITEMS - DEF_S4;
            if (nidle_ >= TEST_S4_MIN_IDLE) { if (vcu >= busy_) conv_down_m(a.w_down_m, Wd_m, lds, wave, qa, DM_ITEMS, (vcu - busy_) * 8 + wave, nidle_ * 8); }
            else conv_down_m(a.w_down_m, Wd_m, lds, wave, qa, DM_ITEMS, bx * 8 + wave, G * 8); }
    }
    SEAM(13);
    if (IN(14)) for (int rep = 0; rep < DUPN(14); ++rep) {
        WS_LOCAL
        SchedMoE S; S.A = (const char*)Hm; S.B = (const char*)Wd_m; S.rowtok = P_ROWTOK; S.K = DFFE / 2; S.G = G; S.c = bx; S.cx = bx; S.nN = D / 256; S.bstride = (size_t)D * DFFE; S.gather = false; S.streamk = true; S.init(P_CNT);
        EpiMoEDown E; E.Y = Yb; E.rowgate = P_ROWGATE; E.sc = 1.f / (W8_DN * H8_SC); E.pdelta = (long)((const char*)(ws + WS_R + YPART_OFF) - (const char*)Yb) - (long)2 * NTOK * D * 2;
        pg8::gemm_phase<EpiMoEDown, SchedMoE, false, true, true, true>(lds, DFFE / 2, S, E, wave);
    }
    SEAM(14);
    if (IN(15)) for (int rep = 0; rep < DUPN(15); ++rep) {
        WS_LOCAL
        PHASE_LOCALS
        f32x4 hA[4], hB[4]; u32x2 yA0[4], yA1[4], yB0[4], yB1[4];
        int nrb_ = 0;
#pragma unroll
        for (int e = 0; e < NEXP; ++e) nrb_ += (__builtin_amdgcn_readfirstlane(P_CNT[e]) + 255) >> 8;
        const int tot_ = nrb_ * (D / 256), nfr_ = tot_ / G, Sp = splitk_factor(tot_ - nfr_ * G, G);
        const int split_lo = Sp > 1 ? nfr_ * (G / (D / 256)) * 256 : 0x7fffffff;
        const unsigned char* ypart = ws + WS_R + YPART_OFF;
#define CMB_PART(Yv, p_) do { float s_[4][4]; _Pragma("unroll") for (int j = 0; j < 4; ++j) _Pragma("unroll") for (int q = 0; q < 4; ++q) s_[j][q] = 0.f; \
            for (int k0 = 0; k0 < Sp; k0 += 7) { u32x2 t_[7][4]; \
                _Pragma("unroll") for (int kk = 0; kk < 7; ++kk) { const int k_ = min(k0 + kk, Sp - 1); const u32x2* q_ = (const u32x2*)(ypart + (size_t)k_ * YPART_STRIDE + (size_t)((p_) - split_lo) * (D * 2)); \
                    _Pragma("unroll") for (int j = 0; j < 4; ++j) t_[kk][j] = q_[lane + 64 * j]; } \
                _Pragma("unroll") for (int kk = 0; kk < 7; ++kk) { const bool on_ = k0 + kk < Sp; \
                    _Pragma("unroll") for (int j = 0; j < 4; ++j) { s_[j][0] += on_ ? bf_lo(t_[kk][j].x) : 0.f; s_[j][1] += on_ ? bf_hi(t_[kk][j].x) : 0.f; s_[j][2] += on_ ? bf_lo(t_[kk][j].y) : 0.f; s_[j][3] += on_ ? bf_hi(t_[kk][j].y) : 0.f; } } } \
            _Pragma("unroll") for (int j = 0; j < 4; ++j) { Yv[j].x = pk_bf16(s_[j][0], s_[j][1]); Yv[j].y = pk_bf16(s_[j][2], s_[j][3]); } } while (0)
#define CMB_LOAD(mm, H, Y0, Y1) do { const int p0_ = __builtin_amdgcn_readfirstlane(P_POS[2 * (mm)]), p1_ = __builtin_amdgcn_readfirstlane(P_POS[2 * (mm) + 1]); \
            const u32x2* o_ = (const u32x2*)(Hb + (size_t)(mm) * D); const u32x2* y0_ = (const u32x2*)(Yb + (size_t)p0_ * D); const u32x2* y1_ = (const u32x2*)(Yb + (size_t)p1_ * D); \
            _Pragma("unroll") for (int j = 0; j < 4; ++j) { const int ch = lane + 64 * j; { const u32x2 r_ = o_[ch]; H[j] = (f32x4){bf_lo(r_.x), bf_hi(r_.x), bf_lo(r_.y), bf_hi(r_.y)}; } if (p0_ < split_lo) Y0[j] = y0_[ch]; if (p1_ < split_lo) Y1[j] = y1_[ch]; } \
            if (p0_ >= split_lo) CMB_PART(Y0, p0_); if (p1_ >= split_lo) CMB_PART(Y1, p1_); } while (0)
        int m = gw;
        if (m < NTOK) CMB_LOAD(m, hA, yA0, yA1);
        for (; m < NTOK; m += NGW) {
            const int mn = m + NGW;
            if (mn < NTOK) CMB_LOAD(mn, hB, yB0, yB1);
            f32x4* o = (f32x4*)(a.out + (size_t)m * D);
#pragma unroll
            for (int j = 0; j < 4; ++j) { f32x4 h = hA[j]; const u32x2 a0 = yA0[j], a1 = yA1[j];
                h[0] += bf_lo(a0.x) + bf_lo(a1.x); h[1] += bf_hi(a0.x) + bf_hi(a1.x); h[2] += bf_lo(a0.y) + bf_lo(a1.y); h[3] += bf_hi(a0.y) + bf_hi(a1.y); o[lane + 64 * j] = h; }
#pragma unroll
            for (int j = 0; j < 4; ++j) { hA[j] = hB[j]; yA0[j] = yB0[j]; yA1[j] = yB1[j]; }
        }
#undef CMB_LOAD
#undef CMB_PART
    }
#undef IN
#undef SEAM
#undef GRID_BAR
}

extern "C" void kernel_launch(void* const* d_in, const int* in_sizes, int n_in, void* d_out, int out_size, void* d_ws, size_t ws_size, hipStream_t stream) {
    static int grid = 0;
    if (grid == 0) {
        if (n_in != 20 || out_size != NTOK * D || ws_size < WS_END) { fprintf(stderr, "kernel_launch: unexpected shapes (n_in %d out %d ws %zu need %zu)\n", n_in, out_size, ws_size, (size_t)WS_END); grid = -1; return; }
        int dev = 0, cus = 0, per_cu = 0;
        (void)hipGetDevice(&dev); (void)hipDeviceGetAttribute(&cus, hipDeviceAttributeMultiprocessorCount, dev);
        if (hipFuncSetAttribute((const void*)mk_fwd, hipFuncAttributeMaxDynamicSharedMemorySize, LDS_BYTES) != hipSuccess) { fprintf(stderr, "kernel_launch: hipFuncSetAttribute failed\n"); grid = -1; return; }
        (void)hipOccupancyMaxActiveBlocksPerMultiprocessor(&per_cu, (const void*)mk_fwd, 512, LDS_BYTES);
        (void)hipGetLastError();
        if (per_cu < 1) { fprintf(stderr, "kernel_launch: occupancy query says %d blocks per CU\n", per_cu); per_cu = 1; }
        grid = cus;
    }
    if (grid < 0) return;
    (void)hipMemsetAsync((char*)d_ws + WS_CTL, 0, CTL_BYTES, stream);
    Args a{};
    a.x = (const float*)d_in[0]; a.mem = (const float*)d_in[1]; a.g_attn = (const float*)d_in[2]; a.w_in = (const float*)d_in[3]; a.g_qk_na = (const float*)d_in[4]; a.rpb_na = (const float*)d_in[5];
    a.g_qk_dil = (const float*)d_in[6]; a.g_mem = (const float*)d_in[7]; a.w_mem_kv = (const float*)d_in[8]; a.g_qk_mem = (const float*)d_in[9]; a.g_out = (const float*)d_in[10]; a.w_out = (const float*)d_in[11];
    a.g_ffn = (const float*)d_in[12]; a.w_gate_d = (const float*)d_in[13]; a.w_up_d = (const float*)d_in[14]; a.w_down_d = (const float*)d_in[15]; a.w_router = (const float*)d_in[16];
    a.w_gate_m = (const float*)d_in[17]; a.w_up_m = (const float*)d_in[18]; a.w_down_m = (const float*)d_in[19];
    a.out = (float*)d_out; a.ws = (unsigned char*)d_ws;
#if MK_N_LAUNCHES == 1
    a.ph_lo = 0; a.ph_hi = NPHASE;
    void* args[] = {&a};
    hipError_t e = hipLaunchCooperativeKernel((const void*)mk_fwd, dim3(grid), dim3(512), args, LDS_BYTES, stream);
    if (e != hipSuccess) fprintf(stderr, "cooperative launch failed: %s (grid %d)\n", hipGetErrorString(e), grid);
#else
    for (int p = 0; p < NPHASE; ++p) { a.ph_lo = p; a.ph_hi = p + 1; hipLaunchKernelGGL(mk_fwd, dim3(grid), dim3(512), LDS_BYTES, stream, a); }
#endif
}
```
